# Optimizing an MI355X kernel written in HIP

```python
import jax, jax.numpy as jnp
from jax import lax
import numpy as np

D_MODEL = 1024
BATCH = 2
SEQ = 8192
DEPTH = 2

CHUNK = 64
POOL_WIDTH = D_MODEL // 2
POOL_WINDOWS = (2, 4, 8, 16)
POOL_GROUPS = len(POOL_WINDOWS)
POOL_GROUP_DIM = POOL_WIDTH // POOL_GROUPS
HGRN_HEAD_DIM = 128
HGRN_HEADS = (D_MODEL // 2) // HGRN_HEAD_DIM
HGRN_WIDTH = HGRN_HEADS * HGRN_HEAD_DIM
N_BRANCHES = 2
IN_COLS = POOL_WIDTH + 4 * HGRN_WIDTH + N_BRANCHES * D_MODEL
D_FF = 128 * ((8 * D_MODEL // 3 + 127) // 128)
CONV_WIDTH = 3
EPS = 1e-6

kernel_name = "hybrid_pool_hgrn2_convglu_trunk"


def rmsnorm(x, g):
    xf = x.astype(jnp.float32)
    y = xf * lax.rsqrt(jnp.mean(xf * xf, axis=-1, keepdims=True) + EPS) * g.astype(jnp.float32)
    return y.astype(x.dtype)


def pool_mixer(u, pool_w, pool_scale):
    B, S, _ = u.shape
    ug = u.reshape(B, S, POOL_GROUPS, POOL_GROUP_DIM).astype(jnp.float32)
    cs = jnp.cumsum(ug, axis=1)
    t = jnp.arange(1, S + 1, dtype=jnp.float32)
    outs = []
    for g, w in enumerate(POOL_WINDOWS):
        c_pad = jnp.pad(cs[:, :, g], ((0, 0), (w, 0), (0, 0)))
        win_sum = c_pad[:, w:] - c_pad[:, :S]
        count = jnp.minimum(t, float(w))[None, :, None]
        outs.append(win_sum / count - ug[:, :, g])
    pooled = jnp.stack(outs, axis=2).astype(u.dtype)
    mixed = jnp.einsum('bsgc,gcd->bsgd', pooled, pool_w).reshape(B, S, POOL_WIDTH)
    return mixed * pool_scale


def hgrn2_mixer(zq, zf, zi, zo, lb, norm_g):
    B, S, _ = zq.shape
    n_chunks = S // CHUNK
    H, Dh = HGRN_HEADS, HGRN_HEAD_DIM

    def heads(a):
        return a.reshape(B, S, H, Dh).astype(jnp.float32)

    q = jax.nn.silu(heads(zq))
    lbh = lb.reshape(H, Dh).astype(jnp.float32)
    f = lbh + (1.0 - lbh) * jax.nn.sigmoid(heads(zf))
    log_f = jnp.log(f)
    k = 1.0 - f
    v = heads(zi)

    def to_chunks(a):
        return a.reshape(B, n_chunks, CHUNK, H, Dh).transpose(1, 0, 3, 2, 4)

    causal = jnp.tril(jnp.ones((CHUNK, CHUNK), dtype=bool))

    def step(state, xs):
        qc, kc, vc, gc = xs
        b = jnp.cumsum(gc, axis=2)
        diff = b[:, :, :, None, :] - b[:, :, None, :, :]
        decay = jnp.exp(jnp.where(causal[:, :, None], diff, -jnp.inf))
        attn = jnp.einsum('bhtk,bhtsk,bhsk->bhts', qc, decay, kc)
        o = (jnp.einsum('bhts,bhsv->bhtv', attn, vc)
             + jnp.einsum('bhtk,bhkv->bhtv', qc * jnp.exp(b), state))
        b_last = b[:, :, -1:, :]
        new_state = (jnp.exp(b_last[:, :, 0, :])[..., None] * state
                     + jnp.einsum('bhsk,bhsv->bhkv', kc * jnp.exp(b_last - b), vc))
        return new_state, o

    s0 = jnp.zeros((B, H, Dh, Dh), jnp.float32)
    _, o = lax.scan(step, s0, (to_chunks(q), to_chunks(k), to_chunks(v), to_chunks(log_f)))
    o = o.transpose(1, 0, 3, 2, 4).reshape(B, S, H, Dh)
    o = o * lax.rsqrt(jnp.mean(o * o, axis=-1, keepdims=True) + EPS) * norm_g.astype(jnp.float32)
    o = o * jax.nn.silu(heads(zo))
    return o.reshape(B, S, HGRN_WIDTH).astype(zq.dtype)


def conv_glu_ffn(x, w_up, conv_w, conv_b, w_down):
    S = x.shape[1]
    h = x @ w_up
    hp = jnp.pad(h, ((0, 0), (CONV_WIDTH - 1, 0), (0, 0)))
    hc = sum(conv_w[j] * hp[:, j:j + S] for j in range(CONV_WIDTH)) + conv_b
    val, gate = jnp.split(hc, 2, axis=-1)
    return (jax.nn.silu(gate) * val) @ w_down


def setup_inputs(seed: int = 0) -> dict:
    key = jax.random.key(seed)
    ks = jax.random.split(key, 20)
    f32 = jnp.float32
    nrm = lambda k, shape, scale: (jax.random.normal(k, shape, f32) * scale).astype(f32)
    L = DEPTH
    return {
        "x": nrm(ks[0], (BATCH, SEQ, D_MODEL), 1.0),
        "norm1_g": 1.0 + nrm(ks[1], (L, D_MODEL), 0.02),
        "w_in": nrm(ks[2], (L, D_MODEL, IN_COLS), D_MODEL ** -0.5),
        "b_gate": nrm(ks[3], (L, N_BRANCHES * D_MODEL), 0.01),
        "pool_w": nrm(ks[4], (L, POOL_GROUPS, POOL_GROUP_DIM, POOL_GROUP_DIM), POOL_GROUP_DIM ** -0.5),
        "pool_scale": 1.0 + nrm(ks[5], (L, POOL_WIDTH), 0.02),
        "lb_logits": nrm(ks[6], (L, HGRN_WIDTH), 1.0),
        "hgrn_norm_g": 1.0 + nrm(ks[7], (L, HGRN_HEAD_DIM), 0.02),
        "w_pa": nrm(ks[8], (L, POOL_WIDTH, D_MODEL), POOL_WIDTH ** -0.5),
        "w_pb": nrm(ks[9], (L, HGRN_WIDTH, D_MODEL), HGRN_WIDTH ** -0.5),
        "w_o": nrm(ks[10], (L, D_MODEL, D_MODEL), D_MODEL ** -0.5),
        "norm2_g": 1.0 + nrm(ks[11], (L, D_MODEL), 0.02),
        "w_up": nrm(ks[12], (L, D_MODEL, 2 * D_FF), D_MODEL ** -0.5),
        "conv_w": nrm(ks[13], (L, CONV_WIDTH, 2 * D_FF), CONV_WIDTH ** -0.5),
        "conv_b": nrm(ks[14], (L, 2 * D_FF), 0.01),
        "w_down": nrm(ks[15], (L, D_FF, D_MODEL), D_FF ** -0.5),
        "final_g": 1.0 + nrm(ks[16], (D_MODEL,), 0.02),
    }


def reference(x, norm1_g, w_in, b_gate, pool_w, pool_scale, lb_logits, hgrn_norm_g,
              w_pa, w_pb, w_o, norm2_g, w_up, conv_w, conv_b, w_down, final_g):
    B, S, _ = x.shape
    lb_soft = jax.nn.softmax(lb_logits.astype(jnp.float32), axis=0)
    lb_cum = jnp.cumsum(lb_soft, axis=0)
    lower_bounds = lb_cum - lb_cum[0:1]

    splits = np.cumsum([POOL_WIDTH, HGRN_WIDTH, HGRN_WIDTH, HGRN_WIDTH, HGRN_WIDTH]).tolist()
    for l in range(DEPTH):
        xn = rmsnorm(x, norm1_g[l])
        z = xn @ w_in[l]
        u_pool, zq, zf, zi, zo, zg = jnp.split(z, splits, axis=-1)
        gates = jax.nn.sigmoid(zg + b_gate[l]).reshape(B, S, N_BRANCHES, D_MODEL)
        ya = pool_mixer(u_pool, pool_w[l], pool_scale[l]) @ w_pa[l]
        yb = hgrn2_mixer(zq, zf, zi, zo, lower_bounds[l], hgrn_norm_g[l]) @ w_pb[l]
        merged = gates[:, :, 0] * ya + gates[:, :, 1] * yb
        x = x + merged @ w_o[l]
        x = x + conv_glu_ffn(rmsnorm(x, norm2_g[l]), w_up[l], conv_w[l], conv_b[l], w_down[l])
    return rmsnorm(x, final_g)
```

```cpp
#include <hip/hip_runtime.h>
#include <hip/hip_cooperative_groups.h>
#include <cstdio>
#include <cstdint>
namespace cg = cooperative_groups;
namespace pg8 {
#define PG8_LAS __attribute__((address_space(3)))
typedef unsigned short bf16_t;
typedef short bf16x8 __attribute__((ext_vector_type(8)));
typedef float f32x4 __attribute__((ext_vector_type(4)));
typedef unsigned u32x4 __attribute__((ext_vector_type(4)));
constexpr int BM = 256, BK = 64, HALF = 128, HTB = HALF * BK * 2  , STAGE_BYTES = 8 * HTB, NXCD = 8, WGM = 8;

__host__ __device__ __forceinline__ int lds_byte(int r, int c) { const int st = (r >> 4) * 2 + (c >> 5), rr = r & 15, cc = c & 31, ob = rr * 64 + cc * 2; return st * 1024 + (ob ^ (((ob >> 9) & 1) << 5)); }
__host__ __device__ __forceinline__ void stage_rc(int b, int& R, int& C) { const int st = b / 1024, sb = b % 1024, swz = sb ^ (((sb >> 9) & 1) << 5); R = (st >> 1) * 16 + swz / 64; C = (st & 1) * 32 + (swz % 64) / 2; }
__host__ __device__ __forceinline__ int perm32(int rho) { const int n = rho >> 4, i = rho & 15; return 8 * (i >> 2) + 4 * n + (i & 3); }

struct Unit { int pm, pn; };
struct Gemm { const bf16_t* A; const bf16_t* Bt; int M, N, K; };

struct StaticOrder {
    int nM, nN, nwg, G, c;
    __host__ __device__ void init(int M, int N, int G_, int c_) { nM = M / BM; nN = N / BM; nwg = nM * nN; G = G_; c = c_; }
    __host__ __device__ bool next(int i, Unit& u) const {
        const long L = (long)i * G + c; if (L >= nwg) return false;
        int wgid = (int)L; { const int q = nwg / NXCD, r = nwg % NXCD, xcd = wgid % NXCD, off = wgid / NXCD; wgid = (xcd < r ? xcd * (q + 1) : r * (q + 1) + (xcd - r) * q) + off; }
        const int nig = WGM * nN, gid = wgid / nig, fm = gid * WGM, gsz = (nM - fm) < WGM ? (nM - fm) : WGM;
        u.pm = fm + ((wgid % nig) % gsz); u.pn = (wgid % nig) / gsz; return true;
    }
    __device__ __forceinline__ void a_ready(const Unit&) const {}
    __device__ __forceinline__ void done(const Unit&) const {}
};

__device__ __forceinline__ unsigned cvt_pk_bf16(float lo, float hi) { unsigned r; asm volatile("v_cvt_pk_bf16_f32 %0, %1, %2" : "=v"(r) : "v"(lo), "v"(hi)); return r; }
typedef float f32x2 __attribute__((ext_vector_type(2)));
template <class Epi, class Sched, bool ALIGN_EPI = false, bool SP2 = false, bool ROWPERM = false>
__device__ __forceinline__ void gemm_phase(PG8_LAS unsigned char* lds, const Gemm g, const Sched& S, const Epi& E) {
    int tid = threadIdx.x; asm volatile("" : "+v"(tid));
    const int wid = __builtin_amdgcn_readfirstlane(tid >> 6), lane = tid & 63, wr = wid >> 2, wc = wid & 3, fr = lane & 15, fq = lane >> 4;
    const int K = g.K, nt = K / BK;
    unsigned voffA[2], voffB[2];
#pragma unroll
    for (int i = 0; i < 2; ++i) { int R, C; stage_rc(tid * 16 + i * 8192, R, C); const int Rb = Epi::PERM ? ((R & ~31) + perm32(R & 31)) : R;
        const int Ra = ROWPERM ? (128 * (R >> 6) + 8 * (R & 15) + ((R >> 4) & 3)) : R;
        voffA[i] = (unsigned)(Ra * K + C) * 2u; voffB[i] = (unsigned)(Rb * K + C) * 2u; }
    const size_t kstep = (size_t)(BK * 2);
    const size_t hstep = (size_t)HALF * K * 2;
    const size_t hstepA = ROWPERM ? (size_t)4 * K * 2 : hstep;
    const size_t tstep = 2 * hstep;
    const unsigned ldsw = (unsigned)wid * 1024u;
    const int aoff = lds_byte(wr * 64 + fr, fq * 8), boff = lds_byte(wc * 32 + fr, fq * 8);
#define PG8_SA(b, h) (((b) * 2 + (h)) * HTB)
#define PG8_SB(b, h) ((4 + (b) * 2 + (h)) * HTB)
#define PG8_STAGE(bufoff, gbase, voff) do { _Pragma("unroll") for (int _i = 0; _i < 2; ++_i) \
        __builtin_amdgcn_global_load_lds((const unsigned*)((const char*)(gbase) + (voff)[_i]), (PG8_LAS unsigned*)(lds + (bufoff) + ldsw + _i * 8192), 16, 0, 0); } while (0)
#define PG8_LDA(dst, b, h) do { _Pragma("unroll") for (int m = 0; m < 4; ++m) _Pragma("unroll") for (int k = 0; k < 2; ++k) dst[m][k] = *(const PG8_LAS bf16x8*)(lds + PG8_SA(b, h) + aoff + m * 2048 + k * 1024); } while (0)
#define PG8_LDB(dst, b, h) do { _Pragma("unroll") for (int n = 0; n < 2; ++n) _Pragma("unroll") for (int k = 0; k < 2; ++k) dst[n][k] = *(const PG8_LAS bf16x8*)(lds + PG8_SB(b, h) + boff + n * 2048 + k * 1024); } while (0)
#define PG8_MMA(ai, bj, At, Bt) do { __builtin_amdgcn_s_setprio(1); _Pragma("unroll") for (int m = 0; m < 4; ++m) _Pragma("unroll") for (int n = 0; n < 2; ++n) _Pragma("unroll") for (int k = 0; k < 2; ++k) \
        acc[ai][bj][m][n] = __builtin_amdgcn_mfma_f32_16x16x32_bf16(Bt[n][k], At[m][k], acc[ai][bj][m][n], 0, 0, 0); __builtin_amdgcn_s_setprio(0); } while (0)
#define PG8_WAIT_V(n) asm volatile("s_waitcnt vmcnt(" #n ")" ::: "memory")
#define PG8_WAIT_L(n) asm volatile("s_waitcnt lgkmcnt(" #n ")" ::: "memory")
#define PG8_BAR __builtin_amdgcn_s_barrier()
#define PG8_SCHED __builtin_amdgcn_sched_barrier(0)
    Unit cur, nxt; int ui = 0;
    if (!S.next(0, cur)) return;
    f32x4 acc[2][2][4][2];
#pragma unroll
    for (int a = 0; a < 2; ++a)
#pragma unroll
        for (int b = 0; b < 2; ++b)
#pragma unroll
            for (int m = 0; m < 4; ++m)
#pragma unroll
                for (int n = 0; n < 2; ++n) acc[a][b][m][n] = (f32x4){0.f, 0.f, 0.f, 0.f};
    bf16x8 At[4][2], B0[2][2], B1[2][2];
    const char* cA = (const char*)g.A + (size_t)cur.pm * tstep; const char* cB = (const char*)g.Bt + (size_t)cur.pn * tstep;
    S.a_ready(cur);
    if constexpr (SP2) {
        PG8_STAGE(PG8_SB(0, 0), cB, voffB); PG8_STAGE(PG8_SB(0, 1), cB + hstep, voffB); PG8_STAGE(PG8_SA(0, 0), cA, voffA); PG8_STAGE(PG8_SA(0, 1), cA + hstepA, voffA);
        if (wr == 1) PG8_BAR;
        PG8_WAIT_V(2); PG8_BAR;
        PG8_STAGE(PG8_SB(1, 0), cB + kstep, voffB); PG8_STAGE(PG8_SA(1, 0), cA + kstep, voffA); PG8_STAGE(PG8_SB(1, 1), cB + hstep + kstep, voffB);
        PG8_WAIT_V(6); PG8_BAR;
    } else {
        PG8_STAGE(PG8_SB(0, 0), cB, voffB); PG8_STAGE(PG8_SA(0, 0), cA, voffA); PG8_STAGE(PG8_SB(0, 1), cB + hstep, voffB); PG8_STAGE(PG8_SA(0, 1), cA + hstepA, voffA);
        if (wr == 1) PG8_BAR;
        PG8_WAIT_V(4); PG8_BAR;
        PG8_STAGE(PG8_SB(1, 0), cB + kstep, voffB); PG8_STAGE(PG8_SA(1, 0), cA + kstep, voffA); PG8_STAGE(PG8_SB(1, 1), cB + hstep + kstep, voffB);
        PG8_WAIT_V(6); PG8_BAR;
    }
    for (;;) {
        const bool has_next = S.next(ui + 1, nxt);
        const char* nA = has_next ? (const char*)g.A + (size_t)nxt.pm * tstep : cA; const char* nB = has_next ? (const char*)g.Bt + (size_t)nxt.pn * tstep : cB;
        for (int t = 0; t < nt; t += 2) {
            const bool last = (t == nt - 2);
            const char* a1 = cA + (size_t)(t + 1) * kstep;
            const char* a2 = last ? nA : cA + (size_t)(t + 2) * kstep; const char* b2 = last ? nB : cB + (size_t)(t + 2) * kstep;
            const char* a3 = a2 + kstep; const char* b3 = b2 + kstep;
            if (last && has_next) S.a_ready(nxt);
            if constexpr (SP2) {
            PG8_LDB(B0, 0, 0); PG8_LDB(B1, 0, 1); PG8_SCHED; PG8_LDA(At, 0, 0); PG8_STAGE(PG8_SA(1, 1), a1 + hstepA, voffA);
            PG8_WAIT_V(8); PG8_WAIT_L(0); PG8_BAR; PG8_MMA(0, 0, At, B0); PG8_MMA(0, 1, At, B1); PG8_BAR; PG8_SCHED;
            PG8_LDA(At, 0, 1); PG8_STAGE(PG8_SB(0, 0), b2, voffB); PG8_STAGE(PG8_SB(0, 1), b2 + hstep, voffB); PG8_STAGE(PG8_SA(0, 0), a2, voffA);
            PG8_WAIT_V(8); PG8_WAIT_L(0); PG8_BAR; PG8_MMA(1, 0, At, B0); PG8_MMA(1, 1, At, B1); PG8_BAR; PG8_SCHED;
            PG8_LDB(B0, 1, 0); PG8_LDB(B1, 1, 1); PG8_SCHED; PG8_LDA(At, 1, 0); PG8_STAGE(PG8_SA(0, 1), a2 + hstepA, voffA);
            PG8_WAIT_V(8); PG8_WAIT_L(0); PG8_BAR; PG8_MMA(0, 0, At, B0); PG8_MMA(0, 1, At, B1); PG8_BAR; PG8_SCHED;
            PG8_LDA(At, 1, 1); PG8_STAGE(PG8_SB(1, 0), b3, voffB); PG8_STAGE(PG8_SB(1, 1), b3 + hstep, voffB); PG8_STAGE(PG8_SA(1, 0), a3, voffA);
            PG8_WAIT_V(8); PG8_WAIT_L(0); PG8_BAR; PG8_MMA(1, 0, At, B0); PG8_MMA(1, 1, At, B1); PG8_BAR; PG8_SCHED;
            } else {
            PG8_LDB(B0, 0, 0); PG8_SCHED; PG8_LDA(At, 0, 0); PG8_STAGE(PG8_SA(1, 1), a1 + hstepA, voffA);
            PG8_WAIT_L(8); PG8_BAR; PG8_WAIT_L(0); PG8_MMA(0, 0, At, B0); PG8_BAR; PG8_SCHED;
            PG8_LDB(B1, 0, 1); PG8_STAGE(PG8_SB(0, 0), b2, voffB);
            PG8_BAR; PG8_WAIT_L(0); PG8_MMA(0, 1, At, B1); PG8_BAR;
            PG8_LDA(At, 0, 1); PG8_STAGE(PG8_SA(0, 0), a2, voffA);
            PG8_BAR; PG8_WAIT_L(0); PG8_MMA(1, 0, At, B0); PG8_BAR; PG8_SCHED;
            PG8_STAGE(PG8_SB(0, 1), b2 + hstep, voffB);
            PG8_WAIT_V(6); PG8_BAR; PG8_MMA(1, 1, At, B1); PG8_BAR;
            PG8_LDB(B0, 1, 0); PG8_SCHED; PG8_LDA(At, 1, 0); PG8_STAGE(PG8_SA(0, 1), a2 + hstepA, voffA);
            PG8_WAIT_L(8); PG8_BAR; PG8_WAIT_L(0); PG8_MMA(0, 0, At, B0); PG8_BAR; PG8_SCHED;
            PG8_LDB(B1, 1, 1); PG8_STAGE(PG8_SB(1, 0), b3, voffB);
            PG8_BAR; PG8_WAIT_L(0); PG8_MMA(0, 1, At, B1); PG8_BAR;
            PG8_LDA(At, 1, 1); PG8_STAGE(PG8_SA(1, 0), a3, voffA);
            PG8_BAR; PG8_WAIT_L(0); PG8_MMA(1, 0, At, B0); PG8_BAR; PG8_SCHED;
            PG8_STAGE(PG8_SB(1, 1), b3 + hstep, voffB);
            PG8_WAIT_V(6); PG8_BAR; PG8_MMA(1, 1, At, B1); PG8_BAR;
            }
        }
        if constexpr (ALIGN_EPI) { if (wr == 0) PG8_BAR; }
        if constexpr (!Epi::AFTER_DRAIN) { E(acc, cur, wr, wc, fr, fq); S.done(cur); }
        if (!has_next) break;
#pragma unroll
        for (int a = 0; a < 2; ++a)
#pragma unroll
            for (int b = 0; b < 2; ++b)
#pragma unroll
                for (int m = 0; m < 4; ++m)
#pragma unroll
                    for (int n = 0; n < 2; ++n) acc[a][b][m][n] = (f32x4){0.f, 0.f, 0.f, 0.f};
        cur = nxt; cA = nA; cB = nB; ++ui;
        if constexpr (ALIGN_EPI) { if (wr == 1) PG8_BAR; }
    }
    PG8_WAIT_V(0);
    if constexpr (!ALIGN_EPI) { if (wr == 0) PG8_BAR; }
    PG8_BAR;
    if constexpr (Epi::AFTER_DRAIN) { E.fused(acc, cur, wr, wc, fr, fq, lds, wid, lane); S.done(cur); }
#undef PG8_SA
#undef PG8_SB
#undef PG8_STAGE
#undef PG8_LDA
#undef PG8_LDB
#undef PG8_MMA
#undef PG8_WAIT_V
#undef PG8_WAIT_L
#undef PG8_BAR
#undef PG8_SCHED
}
}

constexpr int BATCH = 2, SEQ = 8192, D = 1024, M = BATCH * SEQ, DEPTH = 2;
constexpr int PW = 512, HW = 512, NH = 4, HD = 128, CH = 64, NCH = SEQ / CH, NBH = BATCH * NH, NUNIT = NBH * NCH;
constexpr int IN_COLS = 4608, NMIX = 2560, NGATE = 2048, DFF = 2816, NUP = 2 * DFF;
constexpr float EPS = 1e-6f;
constexpr int NWAVES = 8, NTHREADS = 512;
constexpr int LDS_BYTES = 147456;

constexpr size_t MiB = 1u << 20;
constexpr size_t WS_BAR = 512 * 1024, BAR_BYTES = 16384;
constexpr size_t WS_SSQ = 1 * MiB;
constexpr size_t WS_DEC = 2 * MiB;
constexpr size_t WS_LB = 2 * MiB + 768 * 1024;
constexpr size_t WS_HBND = 3 * MiB;
constexpr size_t WS_W = 9 * MiB, W_LAYER = 29 * MiB + 512 * 1024;
constexpr size_t WO_IN = 0, WO_A = 9 * MiB, WO_PB = 10 * MiB, WO_O = 11 * MiB, WO_UP = 13 * MiB, WO_DN = 24 * MiB;
constexpr size_t WS_XB = 68 * MiB;
constexpr size_t WS_R = 100 * MiB;
constexpr size_t WS_U = WS_R, WS_HG = WS_R, WS_Q = WS_R + 16 * MiB, WS_V = WS_R + 32 * MiB, WS_SO = WS_R + 48 * MiB, WS_G = WS_R + 64 * MiB;
constexpr size_t WS_POOL = WS_R + 96 * MiB, WS_UT = WS_R + 112 * MiB, WS_GATES = WS_R + 16 * MiB, WS_MERGED = WS_R + 112 * MiB, WS_ACT = WS_R;
constexpr size_t WS_END = 256 * MiB;
static_assert(WS_UT + 32 * MiB <= WS_END && WS_ACT + (size_t)M * DFF * 2 <= WS_END && WS_GATES + 64 * MiB <= WS_POOL, "ws map");

#define LAS __attribute__((address_space(3)))
typedef unsigned short bf16;
typedef unsigned u32x4 __attribute__((ext_vector_type(4)));
typedef unsigned u32x2 __attribute__((ext_vector_type(2)));
typedef float f32x4 __attribute__((ext_vector_type(4)));
typedef float f32x2 __attribute__((ext_vector_type(2)));
typedef short bf16x8 __attribute__((ext_vector_type(8)));

__device__ __forceinline__ float bflo(unsigned w) { return __uint_as_float(w << 16); }
__device__ __forceinline__ float bfhi(unsigned w) { return __uint_as_float(w & 0xffff0000u); }
typedef __bf16 bf16x2_t __attribute__((ext_vector_type(2)));
__device__ __forceinline__ unsigned pk(float lo, float hi) { const bf16x2_t v = __builtin_convertvector((f32x2){lo, hi}, bf16x2_t); return __builtin_bit_cast(unsigned, v); }
__device__ __forceinline__ float sigm(float x) { return 1.f / (1.f + __expf(-x)); }
__device__ __forceinline__ float silu(float x) { return x * sigm(x); }
__device__ __forceinline__ float wave_sum(float v) {
#pragma unroll
    for (int o = 1; o < 64; o <<= 1) v += __shfl_xor(v, o);
    return v;
}
__device__ __forceinline__ float dpp_shr1(float x) { return __int_as_float(__builtin_amdgcn_update_dpp(0, __float_as_int(x), 0x111, 0xf, 0xf, true)); }
#define LDS_WAIT() asm volatile("s_waitcnt lgkmcnt(0)" ::: "memory")
#define VM_WAIT() asm volatile("s_waitcnt vmcnt(0)" ::: "memory")

__device__ __forceinline__ float load_rs(const float* ssq, int row0, int lane) {
    const f32x4* p = (const f32x4*)(ssq + (size_t)(row0 + lane) * 16);
    const f32x4 a = p[0], b = p[1], c = p[2], d = p[3];
    const f32x4 s = (a + b) + (c + d);
    return rsqrtf(((s[0] + s[1]) + (s[2] + s[3])) * (1.f / D) + EPS);
}

struct EpiInMix {
    static constexpr bool PERM = true, AFTER_DRAIN = false;
    bf16 *u, *q, *v, *so; float* g; const float* ssq; const float* lb; bf16* gates; const float* bgate;
    __device__ __forceinline__ void operator()(const f32x4 (&acc)[2][2][4][2], const pg8::Unit& un, int wr, int wc, int fr, int fq) const {
        const int lane = fr + 16 * fq;
        float rs[2]; rs[0] = load_rs(ssq, un.pm * 256 + wr * 64, lane); rs[1] = load_rs(ssq, un.pm * 256 + 128 + wr * 64, lane);
        const int sec = un.pn >> 1, colt = (un.pn & 1) * 256 + wc * 32 + 8 * fq, row0 = un.pm * 256 + wr * 64 + fr;
        if (un.pn >= 10) {
            const int col0 = (un.pn - 10) * 256 + wc * 32 + 8 * fq;
            f32x4 bv[2][2];
#pragma unroll
            for (int bj = 0; bj < 2; ++bj)
#pragma unroll
                for (int n = 0; n < 2; ++n) bv[bj][n] = *(const f32x4*)(bgate + col0 + bj * 128 + 4 * n);
#pragma unroll
            for (int ai = 0; ai < 2; ++ai)
#pragma unroll
                for (int m = 0; m < 4; ++m) {
                    const float r = __shfl(rs[ai], 16 * m + fr);
                    bf16* rowp = gates + (size_t)(row0 + ai * 128 + m * 16) * NGATE + col0;
#pragma unroll
                    for (int bj = 0; bj < 2; ++bj) {
                        f32x4 v0 = acc[ai][bj][m][0] * r + bv[bj][0], v1 = acc[ai][bj][m][1] * r + bv[bj][1];
#pragma unroll
                        for (int e = 0; e < 4; ++e) { v0[e] = sigm(v0[e]); v1[e] = sigm(v1[e]); }
                        u32x4 w; w.x = pk(v0[0], v0[1]); w.y = pk(v0[2], v0[3]); w.z = pk(v1[0], v1[1]); w.w = pk(v1[2], v1[3]);
                        *(u32x4*)(rowp + bj * 128) = w;
                    }
                }
        } else if (sec == 2) {
            f32x4 lbv[2][2];
#pragma unroll
            for (int bj = 0; bj < 2; ++bj)
#pragma unroll
                for (int n = 0; n < 2; ++n) lbv[bj][n] = *(const f32x4*)(lb + colt + bj * 128 + 4 * n);
#pragma unroll
            for (int ai = 0; ai < 2; ++ai)
#pragma unroll
                for (int m = 0; m < 4; ++m) {
                    const float r = __shfl(rs[ai], 16 * m + fr);
                    float* rowp = g + (size_t)(row0 + ai * 128 + m * 16) * 512 + colt;
#pragma unroll
                    for (int bj = 0; bj < 2; ++bj)
#pragma unroll
                        for (int n = 0; n < 2; ++n) {
                            const f32x4 z = acc[ai][bj][m][n] * r; f32x4 o;
#pragma unroll
                            for (int e = 0; e < 4; ++e) { const float l = lbv[bj][n][e]; o[e] = logf(l + (1.f - l) * sigm(z[e])); }
                            *(f32x4*)(rowp + bj * 128 + 4 * n) = o;
                        }
                }
        } else {
            bf16* base = sec == 0 ? u : (sec == 1 ? q : (sec == 3 ? v : so));
            const bool act = (sec == 1 || sec == 4);
#pragma unroll
            for (int ai = 0; ai < 2; ++ai)
#pragma unroll
                for (int m = 0; m < 4; ++m) {
                    const float r = __shfl(rs[ai], 16 * m + fr);
                    bf16* rowp = base + (size_t)(row0 + ai * 128 + m * 16) * 512 + colt;
#pragma unroll
                    for (int bj = 0; bj < 2; ++bj) {
                        f32x4 v0 = acc[ai][bj][m][0] * r, v1 = acc[ai][bj][m][1] * r;
                        if (act) {
#pragma unroll
                            for (int e = 0; e < 4; ++e) { v0[e] = silu(v0[e]); v1[e] = silu(v1[e]); }
                        }
                        u32x4 w; w.x = pk(v0[0], v0[1]); w.y = pk(v0[2], v0[3]); w.z = pk(v1[0], v1[1]); w.w = pk(v1[2], v1[3]);
                        *(u32x4*)(rowp + bj * 128) = w;
                    }
                }
        }
    }
};


constexpr int PAIR_DPM = (int)((WS_POOL - WS_HG) / (256 * PW * 2));
static_assert((WS_POOL - WS_HG) % (256 * PW * 2) == 0 && WO_PB - WO_A == 4 * 256 * PW * 2, "pair-unit offsets");
struct PairOrder {
    pg8::StaticOrder S;
    __device__ bool next(int i, pg8::Unit& u) const { if (!S.next(i >> 1, u)) return false; if (i & 1) { u.pm -= PAIR_DPM; u.pn += 4; } return true; }
    __device__ __forceinline__ void a_ready(const pg8::Unit&) const {}
    __device__ __forceinline__ void done(const pg8::Unit&) const {}
};
struct EpiMerge {
    static constexpr bool PERM = true, AFTER_DRAIN = false;
    bf16* merged; const bf16* gates;
    __device__ __forceinline__ void operator()(const f32x4 (&acc)[2][2][4][2], const pg8::Unit& un, int wr, int wc, int fr, int fq) const {
        const bool second = un.pn >= 4;
        const int pm = second ? un.pm + PAIR_DPM : un.pm, pn = second ? un.pn - 4 : un.pn;
        const int col0 = pn * 256 + wc * 32 + 8 * fq, row0 = pm * 256 + wr * 64 + fr;
        if (second) asm volatile("s_waitcnt vmcnt(0)" ::: "memory");
#pragma unroll
        for (int ai = 0; ai < 2; ++ai)
#pragma unroll
            for (int m = 0; m < 4; ++m) {
                const size_t row = (size_t)(row0 + ai * 128 + m * 16);
#pragma unroll
                for (int bj = 0; bj < 2; ++bj) {
                    const u32x4 gw = *(const u32x4*)(gates + row * NGATE + (second ? 1024 : 0) + col0 + bj * 128);
                    const f32x4 a0 = acc[ai][bj][m][0], a1 = acc[ai][bj][m][1];
                    float o[8];
                    o[0] = bflo(gw.x) * a0[0]; o[1] = bfhi(gw.x) * a0[1]; o[2] = bflo(gw.y) * a0[2]; o[3] = bfhi(gw.y) * a0[3];
                    o[4] = bflo(gw.z) * a1[0]; o[5] = bfhi(gw.z) * a1[1]; o[6] = bflo(gw.w) * a1[2]; o[7] = bfhi(gw.w) * a1[3];
                    bf16* mp = merged + row * D + col0 + bj * 128;
                    if (second) {
                        const u32x4 ow = *(const u32x4*)mp;
                        o[0] += bflo(ow.x); o[1] += bfhi(ow.x); o[2] += bflo(ow.y); o[3] += bfhi(ow.y);
                        o[4] += bflo(ow.z); o[5] += bfhi(ow.z); o[6] += bflo(ow.w); o[7] += bfhi(ow.w);
                    }
                    u32x4 w; w.x = pk(o[0], o[1]); w.y = pk(o[2], o[3]); w.z = pk(o[4], o[5]); w.w = pk(o[6], o[7]);
                    *(u32x4*)mp = w;
                }
            }
    }
};

template <bool LAST> struct EpiRes {
    static constexpr bool PERM = true, AFTER_DRAIN = false;
    float* out; bf16* xb; float* ssq;
    __device__ __forceinline__ void operator()(const f32x4 (&acc)[2][2][4][2], const pg8::Unit& un, int wr, int wc, int fr, int fq) const {
        const int col0 = un.pn * 256 + wc * 32 + 8 * fq, row0 = un.pm * 256 + wr * 64 + fr;
#pragma unroll
        for (int ai = 0; ai < 2; ++ai)
#pragma unroll
            for (int m = 0; m < 4; ++m) {
                const size_t row = (size_t)(row0 + ai * 128 + m * 16);
                float s = 0.f;
#pragma unroll
                for (int bj = 0; bj < 2; ++bj) {
                    const size_t p = row * D + col0 + bj * 128;
                    const u32x4 bw = *(const u32x4*)(xb + p);
                    const f32x4 x0 = (f32x4){bflo(bw.x), bfhi(bw.x), bflo(bw.y), bfhi(bw.y)} + acc[ai][bj][m][0], x1 = (f32x4){bflo(bw.z), bfhi(bw.z), bflo(bw.w), bfhi(bw.w)} + acc[ai][bj][m][1];
                    s += (x0[0] * x0[0] + x0[1] * x0[1]) + (x0[2] * x0[2] + x0[3] * x0[3]) + (x1[0] * x1[0] + x1[1] * x1[1]) + (x1[2] * x1[2] + x1[3] * x1[3]);
                    if (LAST) { *(f32x4*)(out + p) = x0; *(f32x4*)(out + p + 4) = x1; }
                    else { u32x4 w; w.x = pk(x0[0], x0[1]); w.y = pk(x0[2], x0[3]); w.z = pk(x1[0], x1[1]); w.w = pk(x1[2], x1[3]); *(u32x4*)(xb + p) = w; }
                }
                s += __shfl_xor(s, 16); s += __shfl_xor(s, 32);
                if (fq == 0) ssq[row * 16 + un.pn * 4 + wc] = s;
            }
    }
};

struct EpiUpConv {
    static constexpr bool PERM = false, AFTER_DRAIN = false;
    bf16* act; bf16* hbnd; const float* ssq; const float* cw; const float* cb;
    __device__ __forceinline__ void operator()(f32x4 (&acc)[2][2][4][2], const pg8::Unit& un, int wr, int wc, int fr, int fq) const {
        const int lane = fr + 16 * fq;
        {
            const float rs0 = load_rs(ssq, un.pm * 256 + 128 * wr, lane), rs1 = load_rs(ssq, un.pm * 256 + 128 * wr + 64, lane);
#pragma unroll
            for (int j = 0; j < 8; ++j) { const int src = (8 * fr + j) & 63; const float a = __shfl(rs0, src), b = __shfl(rs1, src); const float r = fr < 8 ? a : b;
#pragma unroll
                for (int bj = 0; bj < 2; ++bj)
#pragma unroll
                    for (int n = 0; n < 2; ++n) acc[j >> 2][bj][j & 3][n] *= r; }
        }
        const size_t tok0 = (size_t)un.pm * 256 + 128 * wr + 8 * fr;
        const int blk = un.pm * 2 + wr;
#pragma unroll
        for (int n = 0; n < 2; ++n) {
            const int ch0 = un.pn * 128 + wc * 32 + 16 * n + 4 * fq;
            if (fr == 15) {
                bf16* hb = hbnd + ((size_t)(blk * 4 + 2) * 2) * DFF + ch0;
                const f32x4 hv6 = acc[1][0][2][n], hv7 = acc[1][0][3][n], hg6 = acc[1][1][2][n], hg7 = acc[1][1][3][n];
                *(u32x2*)(hb) = (u32x2){pk(hv6[0], hv6[1]), pk(hv6[2], hv6[3])}; *(u32x2*)(hb + DFF) = (u32x2){pk(hg6[0], hg6[1]), pk(hg6[2], hg6[3])};
                *(u32x2*)(hb + 2 * DFF) = (u32x2){pk(hv7[0], hv7[1]), pk(hv7[2], hv7[3])}; *(u32x2*)(hb + 3 * DFF) = (u32x2){pk(hg7[0], hg7[1]), pk(hg7[2], hg7[3])};
            }
            if (fr == 0) {
#pragma unroll
                for (int j = 0; j < 2; ++j) { bf16* hb = hbnd + ((size_t)(blk * 4 + j) * 2) * DFF + ch0; const f32x4 hv = acc[0][0][j][n], hg = acc[0][1][j][n];
                    *(u32x2*)(hb) = (u32x2){pk(hv[0], hv[1]), pk(hv[2], hv[3])}; *(u32x2*)(hb + DFF) = (u32x2){pk(hg[0], hg[1]), pk(hg[2], hg[3])}; }
            }
#pragma unroll
            for (int bj = 0; bj < 2; ++bj) {
                const float* cwp = cw + bj * DFF + ch0;
                const f32x4 w0 = *(const f32x4*)(cwp), w1 = *(const f32x4*)(cwp + NUP), w2 = *(const f32x4*)(cwp + 2 * NUP), bb = *(const f32x4*)(cb + bj * DFF + ch0);
                f32x4 m2, m1;
#pragma unroll
                for (int e = 0; e < 4; ++e) { m2[e] = dpp_shr1(acc[1][bj][2][n][e]); m1[e] = dpp_shr1(acc[1][bj][3][n][e]); }
#pragma unroll
                for (int j = 7; j >= 0; --j) {
                    const f32x4 h0 = acc[j >> 2][bj][j & 3][n];
                    const f32x4 hm1 = j >= 1 ? acc[(j - 1 + 8) % 8 >> 2][bj][(j - 1 + 8) % 8 & 3][n] : m1;
                    const f32x4 hm2 = j >= 2 ? acc[(j - 2 + 8) % 8 >> 2][bj][(j - 2 + 8) % 8 & 3][n] : (j == 1 ? m1 : m2);
                    acc[j >> 2][bj][j & 3][n] = w2 * h0 + w1 * hm1 + w0 * hm2 + bb;
                }
            }
#pragma unroll
            for (int j = 0; j < 8; ++j) {
                const f32x4 vc = acc[j >> 2][0][j & 3][n], gc = acc[j >> 2][1][j & 3][n];
                f32x4 a;
#pragma unroll
                for (int e = 0; e < 4; ++e) a[e] = vc[e] * silu(gc[e]);
                if (!(j < 2 && fr == 0)) *(u32x2*)(act + (tok0 + j) * DFF + ch0) = (u32x2){pk(a[0], a[1]), pk(a[2], a[3])};
            }
        }
    }
};

struct Args { const float* in[17]; float* out; unsigned char* ws; int ph_lo, ph_hi; };

struct TrItem { const float* W; const float* rscale; bf16* WT; int K, N, drow0, k0, n0; };
__device__ __forceinline__ void tr_load(const TrItem& t, int lane, float (&wv)[32]) {
#pragma unroll
    for (int i = 0; i < 32; ++i) { const int kk = 2 * i + (lane >> 5); wv[i] = t.W[(size_t)(t.k0 + kk) * t.N + t.n0 + (lane & 31)]; }
    if (t.rscale) {
#pragma unroll
        for (int i = 0; i < 32; ++i) wv[i] *= t.rscale[t.k0 + 2 * i + (lane >> 5)];
    }
}
__device__ __forceinline__ void tr_store(const TrItem& t, int lane, const float (&wv)[32], LAS float* scr) {
#pragma unroll
    for (int i = 0; i < 32; ++i) scr[(2 * i + (lane >> 5)) * 33 + (lane & 31)] = wv[i];
    LDS_WAIT(); asm volatile("" ::: "memory");
    const int c = lane & 7;
#pragma unroll
    for (int j = 0; j < 4; ++j) { const int n = (lane >> 3) + 8 * j; const LAS float* sp = scr + (8 * c) * 33 + n;
        u32x4 o; o.x = pk(sp[0 * 33], sp[1 * 33]); o.y = pk(sp[2 * 33], sp[3 * 33]); o.z = pk(sp[4 * 33], sp[5 * 33]); o.w = pk(sp[6 * 33], sp[7 * 33]);
        *(u32x4*)(t.WT + (size_t)(t.drow0 + n) * t.K + t.k0 + 8 * c) = o; }
    LDS_WAIT(); asm volatile("" ::: "memory");
}
constexpr int I_IN = (D / 64) * (IN_COLS / 32), I_PB = (HW / 64) * (D / 32), I_O = (D / 64) * (D / 32), I_UP = (D / 64) * (NUP / 32), I_DN = (DFF / 64) * (D / 32);
constexpr int I_LAYER = I_IN + I_PB + I_O + I_UP + I_DN;
__device__ __forceinline__ TrItem tr_decode(const Args& a, int it) {
    const int l = it / I_LAYER; int r = it % I_LAYER;
    unsigned char* wl = a.ws + WS_W + (size_t)l * W_LAYER;
    TrItem t;
    if (r < I_IN) { const int nb = IN_COLS / 32; t.k0 = 64 * (r / nb); t.n0 = 32 * (r % nb); t.W = a.in[2] + (size_t)l * D * IN_COLS; t.K = D; t.N = IN_COLS; t.rscale = a.in[1] + l * D; t.WT = (bf16*)(wl + WO_IN); t.drow0 = t.n0; return t; }
    r -= I_IN;
    if (r < I_PB) { const int nb = D / 32; t.k0 = 64 * (r / nb); t.n0 = 32 * (r % nb); t.W = a.in[9] + (size_t)l * HW * D; t.K = HW; t.N = D; t.rscale = nullptr; t.WT = (bf16*)(wl + WO_PB); t.drow0 = t.n0; return t; }
    r -= I_PB;
    if (r < I_O) { const int nb = D / 32; t.k0 = 64 * (r / nb); t.n0 = 32 * (r % nb); t.W = a.in[10] + (size_t)l * D * D; t.K = D; t.N = D; t.rscale = nullptr; t.WT = (bf16*)(wl + WO_O); t.drow0 = t.n0; return t; }
    r -= I_O;
    if (r < I_UP) { const int nb = NUP / 32; t.k0 = 64 * (r / nb); t.n0 = 32 * (r % nb); t.W = a.in[12] + (size_t)l * D * NUP; t.K = D; t.N = NUP; t.rscale = a.in[11] + l * D; t.WT = (bf16*)(wl + WO_UP);
        const int bjs = t.n0 / DFF, rr = t.n0 % DFF; t.drow0 = 256 * (rr / 128) + 128 * bjs + (rr % 128); return t; }
    r -= I_UP;
    { const int nb = D / 32; t.k0 = 64 * (r / nb); t.n0 = 32 * (r % nb); t.W = a.in[15] + (size_t)l * DFF * D; t.K = DFF; t.N = D; t.rscale = nullptr; t.WT = (bf16*)(wl + WO_DN); t.drow0 = t.n0; return t; }
}

__device__ __forceinline__ void phase_prologue(const Args& a, LAS unsigned char* lds, int G) {
    int tid = threadIdx.x; asm volatile("" : "+v"(tid));
    const int lane = tid & 63, wave = __builtin_amdgcn_readfirstlane(tid >> 6);
    unsigned char* ws = a.ws;
    const float *x = a.in[0], *pool_w = a.in[4], *pool_scale = a.in[5], *lb_logits = a.in[6], *w_pa = a.in[8];
    LAS float* scr = (LAS float*)(lds + wave * 16384);
    const int gw = blockIdx.x * NWAVES + wave, NGW = G * NWAVES;
    for (int it = gw; it < DEPTH * I_LAYER; it += 2 * NGW) {
        const bool two = it + NGW < DEPTH * I_LAYER;
        const TrItem t0 = tr_decode(a, it), t1 = tr_decode(a, two ? it + NGW : it);
        float w0[32], w1[32];
        tr_load(t0, lane, w0); if (two) tr_load(t1, lane, w1);
        tr_store(t0, lane, w0, scr); if (two) tr_store(t1, lane, w1, scr);
    }
    for (int gt = blockIdx.x * NTHREADS + tid; gt < DEPTH * 65536; gt += G * NTHREADS) {
        const int l = __builtin_amdgcn_readfirstlane(gt >> 16), rem = gt & 65535, d = rem & 1023, cg8 = __builtin_amdgcn_readfirstlane(rem >> 10), gi = cg8 >> 4, c0 = (cg8 & 15) * 8;
        const float* pw = pool_w + ((size_t)(l * 4 + gi) * 128 + c0) * 128;
        const float* ps = pool_scale + l * PW + gi * 128;
        const float* wp = w_pa + ((size_t)l * PW + gi * 128) * D + d;
        LAS float* pwl = scr;
#pragma unroll
        for (int j = 0; j < 4; ++j) { const int e = j * 256 + lane * 4; const f32x4 v = *(const f32x4*)(pw + e) * *(const f32x4*)(ps + (e & 127)); *(LAS f32x4*)(pwl + e) = v; }
        LDS_WAIT(); asm volatile("" ::: "memory");
        float sacc[8];
#pragma unroll
        for (int i = 0; i < 8; ++i) sacc[i] = 0.f;
#pragma unroll 4
        for (int cp = 0; cp < 128; cp += 4) {
            const float w0 = wp[(size_t)cp * D], w1 = wp[(size_t)(cp + 1) * D], w2 = wp[(size_t)(cp + 2) * D], w3 = wp[(size_t)(cp + 3) * D];
#pragma unroll
            for (int i = 0; i < 8; ++i) { const f32x4 p = *(const LAS f32x4*)(pwl + i * 128 + cp); sacc[i] += (p[0] * w0 + p[1] * w1) + (p[2] * w2 + p[3] * w3); }
        }
        u32x4 o; o.x = pk(sacc[0], sacc[1]); o.y = pk(sacc[2], sacc[3]); o.z = pk(sacc[4], sacc[5]); o.w = pk(sacc[6], sacc[7]);
        *(u32x4*)((bf16*)(ws + WS_W + (size_t)l * W_LAYER + WO_A) + (size_t)d * PW + cg8 * 8) = o;
        LDS_WAIT(); asm volatile("" ::: "memory");
    }
    if (blockIdx.x == 0) {
        const int chn = tid;
        float mx = -1e30f;
        for (int l = 0; l < DEPTH; ++l) mx = fmaxf(mx, lb_logits[l * HW + chn]);
        float sum = 0.f;
        for (int l = 0; l < DEPTH; ++l) sum += expf(lb_logits[l * HW + chn] - mx);
        float cum = 0.f, c0v = 0.f;
        for (int l = 0; l < DEPTH; ++l) { cum += expf(lb_logits[l * HW + chn] - mx) / sum; if (l == 0) c0v = cum; ((float*)(ws + WS_LB))[l * HW + chn] = cum - c0v; }
    }
    bf16* xb = (bf16*)(ws + WS_XB); float* ssq = (float*)(ws + WS_SSQ);
    for (int m = gw; m < M; m += 2 * NGW) {
        const int m1 = m + NGW;
        const bool two = m1 < M;
        const f32x4* xr0 = (const f32x4*)(x + (size_t)m * D) + lane; const f32x4* xr1 = (const f32x4*)(x + (size_t)(two ? m1 : m) * D) + lane;
        f32x4 v0[4], v1[4]; float s0 = 0.f, s1 = 0.f;
#pragma unroll
        for (int j = 0; j < 4; ++j) { v0[j] = xr0[64 * j]; v1[j] = xr1[64 * j]; }
#pragma unroll
        for (int j = 0; j < 4; ++j) { s0 += (v0[j][0] * v0[j][0] + v0[j][1] * v0[j][1]) + (v0[j][2] * v0[j][2] + v0[j][3] * v0[j][3]); s1 += (v1[j][0] * v1[j][0] + v1[j][1] * v1[j][1]) + (v1[j][2] * v1[j][2] + v1[j][3] * v1[j][3]); }
        s0 = wave_sum(s0); s1 = wave_sum(s1);
        u32x2* o0 = (u32x2*)(xb + (size_t)m * D) + lane;
#pragma unroll
        for (int j = 0; j < 4; ++j) o0[64 * j] = (u32x2){pk(v0[j][0], v0[j][1]), pk(v0[j][2], v0[j][3])};
        if (lane < 16) ssq[(size_t)m * 16 + lane] = lane == 0 ? s0 : 0.f;
        if (two) {
            u32x2* o1 = (u32x2*)(xb + (size_t)m1 * D) + lane;
#pragma unroll
            for (int j = 0; j < 4; ++j) o1[64 * j] = (u32x2){pk(v1[j][0], v1[j][1]), pk(v1[j][2], v1[j][3])};
            if (lane < 16) ssq[(size_t)m1 * 16 + lane] = lane == 0 ? s1 : 0.f;
        }
    }
}

__device__ __forceinline__ void phase_fir(const bf16* u, bf16* pooled, int G) {
    int tid = threadIdx.x; asm volatile("" : "+v"(tid));
    for (int item = blockIdx.x * NTHREADS + tid; item < (M / 8) * 64; item += G * NTHREADS) {
        const int cgp = item & 63, run = item >> 6, m0 = run * 8, ts = m0 & (SEQ - 1), w = 2 << (cgp >> 4);
        const bf16* up = u + (size_t)m0 * PW + cgp * 8;
        float s[8];
#pragma unroll
        for (int i = 0; i < 8; ++i) s[i] = 0.f;
        for (int d = 1; d < w; ++d) if (ts - d >= 0) {
            const u32x4 x = *(const u32x4*)(up - (size_t)d * PW);
            s[0] += bflo(x.x); s[1] += bfhi(x.x); s[2] += bflo(x.y); s[3] += bfhi(x.y); s[4] += bflo(x.z); s[5] += bfhi(x.z); s[6] += bflo(x.w); s[7] += bfhi(x.w);
        }
#pragma unroll
        for (int r = 0; r < 8; ++r) {
            const u32x4 x = *(const u32x4*)(up + (size_t)r * PW);
            float c[8] = {bflo(x.x), bfhi(x.x), bflo(x.y), bfhi(x.y), bflo(x.z), bfhi(x.z), bflo(x.w), bfhi(x.w)};
#pragma unroll
            for (int i = 0; i < 8; ++i) s[i] += c[i];
            const int cnt = (ts + r + 1) < w ? (ts + r + 1) : w; const float inv = 1.f / (float)cnt;
            u32x4 o; o.x = pk(s[0] * inv - c[0], s[1] * inv - c[1]); o.y = pk(s[2] * inv - c[2], s[3] * inv - c[3]);
            o.z = pk(s[4] * inv - c[4], s[5] * inv - c[5]); o.w = pk(s[6] * inv - c[6], s[7] * inv - c[7]);
            *(u32x4*)(pooled + (size_t)(m0 + r) * PW + cgp * 8) = o;
            if (ts + r - w + 1 >= 0) {
                const u32x4 y = *(const u32x4*)(up + ((ptrdiff_t)r - w + 1) * PW);
                s[0] -= bflo(y.x); s[1] -= bfhi(y.x); s[2] -= bflo(y.y); s[3] -= bfhi(y.y); s[4] -= bflo(y.z); s[5] -= bfhi(y.z); s[6] -= bflo(y.w); s[7] -= bfhi(y.w);
            }
        }
    }
}

__device__ __forceinline__ u32x4 pack_lo8(const unsigned (&v)[8]) { u32x4 o; o.x = (v[0] & 0xffffu) | (v[1] << 16); o.y = (v[2] & 0xffffu) | (v[3] << 16); o.z = (v[4] & 0xffffu) | (v[5] << 16); o.w = (v[6] & 0xffffu) | (v[7] << 16); return o; }
__device__ __forceinline__ u32x4 pack_hi8(const unsigned (&v)[8]) { u32x4 o; o.x = (v[0] >> 16) | (v[1] & 0xffff0000u); o.y = (v[2] >> 16) | (v[3] & 0xffff0000u); o.z = (v[4] >> 16) | (v[5] & 0xffff0000u); o.w = (v[6] >> 16) | (v[7] & 0xffff0000u); return o; }

#define WG_BAR() do { asm volatile("s_waitcnt lgkmcnt(0)" ::: "memory"); __builtin_amdgcn_s_barrier(); asm volatile("" ::: "memory"); } while (0)
__device__ __forceinline__ void phase_h1(LAS unsigned char* lds, const float* g, const bf16* vb, bf16* UT, float* dec, int G) {
    int tid = threadIdx.x; asm volatile("" : "+v"(tid));
    const int lane = tid & 63, w = __builtin_amdgcn_readfirstlane(tid >> 6), r16 = lane & 15, q4 = lane >> 4;
    LAS unsigned char* KT = lds; LAS unsigned char* VT = lds + 18432; LAS float* SEG = (LAS float*)(lds + 36864);
    f32x2 gg[8]; unsigned vv[8];
    int unit = blockIdx.x;
    if (unit < NUNIT) {
        const int bh = unit >> 7, c = unit & 127, b = bh >> 2, h = bh & 3;
        const size_t m0 = (size_t)b * SEQ + c * CH + 8 * w; const int col = h * HD + 2 * lane;
#pragma unroll
        for (int r = 0; r < 8; ++r) { gg[r] = *(const f32x2*)(g + (m0 + r) * HW + col); vv[r] = *(const unsigned*)(vb + (m0 + r) * HW + col); }
    }
    for (; unit < NUNIT; unit += G) {
        f32x2 cs[8]; cs[0] = gg[0];
#pragma unroll
        for (int r = 1; r < 8; ++r) cs[r] = cs[r - 1] + gg[r];
        *(LAS f32x2*)(SEG + w * 128 + 2 * lane) = cs[7];
        *(LAS u32x4*)(VT + (2 * lane) * 144 + w * 16) = pack_lo8(vv); *(LAS u32x4*)(VT + (2 * lane + 1) * 144 + w * 16) = pack_hi8(vv);
        WG_BAR();
        f32x2 pre = {0.f, 0.f}, tot = {0.f, 0.f};
#pragma unroll
        for (int j = 0; j < 8; ++j) { const f32x2 sg = *(const LAS f32x2*)(SEG + j * 128 + 2 * lane); tot += sg; if (j < w) pre += sg; }
        unsigned kt[8];
#pragma unroll
        for (int r = 0; r < 8; ++r) { const f32x2 bb = pre + cs[r];
            kt[r] = pk((1.f - __expf(gg[r].x)) * __expf(tot.x - bb.x), (1.f - __expf(gg[r].y)) * __expf(tot.y - bb.y)); }
        *(LAS u32x4*)(KT + (2 * lane) * 144 + w * 16) = pack_lo8(kt); *(LAS u32x4*)(KT + (2 * lane + 1) * 144 + w * 16) = pack_hi8(kt);
        if (w == 0) *(f32x2*)(dec + (size_t)unit * HD + 2 * lane) = (f32x2){__expf(tot.x), __expf(tot.y)};
        const int nu = unit + G;
        if (nu < NUNIT) {
            const int bh = nu >> 7, c = nu & 127, b = bh >> 2, h = bh & 3;
            const size_t m0 = (size_t)b * SEQ + c * CH + 8 * w; const int col = h * HD + 2 * lane;
#pragma unroll
            for (int r = 0; r < 8; ++r) { gg[r] = *(const f32x2*)(g + (m0 + r) * HW + col); vv[r] = *(const unsigned*)(vb + (m0 + r) * HW + col); }
        }
        WG_BAR();
        bf16x8 yv[2];
#pragma unroll
        for (int ks = 0; ks < 2; ++ks) yv[ks] = *(const LAS bf16x8*)(VT + (16 * w + r16) * 144 + ks * 64 + q4 * 16);
        bf16* ut = UT + (size_t)unit * (HD * HD) + (size_t)(16 * w + r16) * HD + 4 * q4;
#pragma unroll
        for (int nb = 0; nb < 8; ++nb) {
            f32x4 a = {0.f, 0.f, 0.f, 0.f};
#pragma unroll
            for (int ks = 0; ks < 2; ++ks) { const bf16x8 xk = *(const LAS bf16x8*)(KT + (16 * nb + r16) * 144 + ks * 64 + q4 * 16); a = __builtin_amdgcn_mfma_f32_16x16x32_bf16(xk, yv[ks], a, 0, 0, 0); }
            *(u32x2*)(ut + 16 * nb) = (u32x2){pk(a[0], a[1]), pk(a[2], a[3])};
        }
        WG_BAR();
    }
}

__device__ __forceinline__ void phase_h2(bf16* UT, const float* dec, int G) {
    int tid = threadIdx.x; asm volatile("" : "+v"(tid));
    for (int e = blockIdx.x * NTHREADS + tid; e < NBH * HD * HD; e += G * NTHREADS) {
        const int bh = e >> 14, idx = e & 16383, k = idx & 127;
        bf16* up = UT + (size_t)bh * NCH * (HD * HD) + idx; const float* dp = dec + (size_t)bh * NCH * HD + k;
        float S = 0.f;
        for (int c0 = 0; c0 < NCH; c0 += 16) {
            bf16 uu[16]; float dd[16];
#pragma unroll
            for (int i = 0; i < 16; ++i) { uu[i] = up[(size_t)(c0 + i) * (HD * HD)]; dd[i] = dp[(size_t)(c0 + i) * HD]; }
#pragma unroll
            for (int i = 0; i < 16; ++i) { up[(size_t)(c0 + i) * (HD * HD)] = (bf16)(pk(S, 0.f) & 0xffffu); S = dd[i] * S + __uint_as_float((unsigned)uu[i] << 16); }
        }
    }
}

__device__ __forceinline__ void phase_h3(LAS unsigned char* lds, const bf16* qb, const float* g, const bf16* vb, const bf16* sob, const bf16* ST, const float* ng, bf16* hg, int G) {
    constexpr int SR = 272;
    int tid = threadIdx.x; asm volatile("" : "+v"(tid));
    const int lane = tid & 63, w = __builtin_amdgcn_readfirstlane(tid >> 6), r16 = lane & 15, q4 = lane >> 4;
    LAS unsigned char* QH = lds; LAS unsigned char* QD = lds + 17408; LAS unsigned char* KD = lds + 34816; LAS unsigned char* KE = lds + 52224; LAS unsigned char* QO = lds + 69632;
    LAS unsigned char* VT = lds + 95744; LAS float* SEG = (LAS float*)(lds + 114176); LAS float* RMS = (LAS float*)(lds + 118272);
    const int bi = w >> 1, odd = w & 1;
    f32x2 gg[8]; unsigned qq[8], vv[8];
    int unit = blockIdx.x;
    if (unit < NUNIT) {
        const int bh = unit >> 7, c = unit & 127, b = bh >> 2, h = bh & 3;
        const size_t m0 = (size_t)b * SEQ + c * CH + 8 * w; const int col = h * HD + 2 * lane;
#pragma unroll
        for (int r = 0; r < 8; ++r) { gg[r] = *(const f32x2*)(g + (m0 + r) * HW + col); qq[r] = *(const unsigned*)(qb + (m0 + r) * HW + col); vv[r] = *(const unsigned*)(vb + (m0 + r) * HW + col); }
    }
    for (; unit < NUNIT; unit += G) {
        const int bh = unit >> 7, c = unit & 127, b = bh >> 2, h = bh & 3;
        const size_t mu = (size_t)b * SEQ + c * CH;
        const bf16* STu = ST + (size_t)unit * (HD * HD) + (size_t)(64 * odd + r16) * HD + q4 * 8;
        bf16x8 xs[4][4];
#pragma unroll
        for (int ks = 0; ks < 4; ++ks)
#pragma unroll
            for (int nb = 0; nb < 4; ++nb) xs[ks][nb] = *(const bf16x8*)(STu + (size_t)(16 * nb) * HD + ks * 32);
        const size_t row = mu + 16 * bi + r16;
        u32x2 sv[4]; f32x4 ngv[4];
#pragma unroll
        for (int nb = 0; nb < 4; ++nb) { const int v0 = 64 * odd + 16 * nb + 4 * q4; ngv[nb] = *(const f32x4*)(ng + v0); sv[nb] = *(const u32x2*)(sob + row * HW + h * HD + v0); }
        f32x2 cs[8]; cs[0] = gg[0];
#pragma unroll
        for (int r = 1; r < 8; ++r) cs[r] = cs[r - 1] + gg[r];
        *(LAS f32x2*)(SEG + w * 128 + 2 * lane) = cs[7];
        *(LAS u32x4*)(VT + (2 * lane) * 144 + w * 16) = pack_lo8(vv); *(LAS u32x4*)(VT + (2 * lane + 1) * 144 + w * 16) = pack_hi8(vv);
        WG_BAR();
        f32x2 pre = {0.f, 0.f};
        for (int j = 0; j < w; ++j) pre += *(const LAS f32x2*)(SEG + j * 128 + 2 * lane);
        const f32x2 cmid = *(const LAS f32x2*)(SEG + (2 * bi) * 128 + 2 * lane);
        const f32x2 bsum = cmid + *(const LAS f32x2*)(SEG + (2 * bi + 1) * 128 + 2 * lane);
        f32x2 bsm1 = {0.f, 0.f}, bsm2 = {0.f, 0.f};
        if (bi >= 1) bsm1 = *(const LAS f32x2*)(SEG + (2 * bi - 2) * 128 + 2 * lane) + *(const LAS f32x2*)(SEG + (2 * bi - 1) * 128 + 2 * lane);
        if (bi >= 2) bsm2 = bsm1 + *(const LAS f32x2*)(SEG + (2 * bi - 4) * 128 + 2 * lane) + *(const LAS f32x2*)(SEG + (2 * bi - 3) * 128 + 2 * lane);
        const f32x2 cbase = odd ? cmid : (f32x2){0.f, 0.f};
        const int pbase = (bi * (bi - 1)) / 2;
#pragma unroll
        for (int r = 0; r < 8; ++r) {
            const int t = 8 * w + r, tl = 8 * odd + r;
            const f32x2 cl = cbase + cs[r], bf = pre + cs[r];
            const float qx = bflo(qq[r]), qy = bfhi(qq[r]);
            const float kx = 1.f - __expf(gg[r].x), ky = 1.f - __expf(gg[r].y);
            *(LAS unsigned*)(QH + t * SR + 4 * lane) = pk(qx * __expf(bf.x), qy * __expf(bf.y));
            *(LAS unsigned*)(QD + t * SR + 4 * lane) = pk(qx * __expf(fminf(cl.x - cmid.x, 80.f)), qy * __expf(fminf(cl.y - cmid.y, 80.f)));
            *(LAS unsigned*)(KD + t * SR + 4 * lane) = pk(kx * __expf(fminf(cmid.x - cl.x, 80.f)), ky * __expf(fminf(cmid.y - cl.y, 80.f)));
            if (bi < 3) *(LAS unsigned*)(KE + t * SR + 4 * lane) = pk(kx * __expf(bsum.x - cl.x), ky * __expf(bsum.y - cl.y));
            if (bi >= 1) *(LAS unsigned*)(QO + ((pbase + bi - 1) * 16 + tl) * SR + 4 * lane) = pk(qx * __expf(cl.x), qy * __expf(cl.y));
            if (bi >= 2) *(LAS unsigned*)(QO + ((pbase + bi - 2) * 16 + tl) * SR + 4 * lane) = pk(qx * __expf(cl.x + bsm1.x), qy * __expf(cl.y + bsm1.y));
            if (bi >= 3) *(LAS unsigned*)(QO + ((pbase + 0) * 16 + tl) * SR + 4 * lane) = pk(qx * __expf(cl.x + bsm2.x), qy * __expf(cl.y + bsm2.y));
        }
        WG_BAR();
        { const int nu = unit + G;
          if (nu < NUNIT) {
            const int bh2 = nu >> 7, c2 = nu & 127, b2 = bh2 >> 2, h2 = bh2 & 3;
            const size_t m0 = (size_t)b2 * SEQ + c2 * CH + 8 * w; const int col = h2 * HD + 2 * lane;
#pragma unroll
            for (int r = 0; r < 8; ++r) { gg[r] = *(const f32x2*)(g + (m0 + r) * HW + col); qq[r] = *(const unsigned*)(qb + (m0 + r) * HW + col); vv[r] = *(const unsigned*)(vb + (m0 + r) * HW + col); }
          } }
        const int i = bi, vh = odd;
        f32x4 acc[4];
#pragma unroll
        for (int nb = 0; nb < 4; ++nb) acc[nb] = (f32x4){0.f, 0.f, 0.f, 0.f};
#pragma unroll
        for (int ks = 0; ks < 4; ++ks) {
            const bf16x8 y = *(const LAS bf16x8*)(QH + (16 * i + r16) * SR + ks * 64 + q4 * 16);
#pragma unroll
            for (int nb = 0; nb < 4; ++nb) acc[nb] = __builtin_amdgcn_mfma_f32_16x16x32_bf16(xs[ks][nb], y, acc[nb], 0, 0, 0);
        }
#pragma unroll
        for (int jp = 0; jp < 2; ++jp) {
            if (2 * jp <= i) {
                f32x4 p[2];
#pragma unroll
                for (int jj = 0; jj < 2; ++jj) {
                    const int j = 2 * jp + jj;
                    p[jj] = (f32x4){0.f, 0.f, 0.f, 0.f};
                    if (j <= i) {
                        const LAS unsigned char* Kb = (j == i ? KD : KE) + (16 * j + r16) * SR + q4 * 16;
                        const LAS unsigned char* Qb = (j == i ? QD + (16 * i + r16) * SR : QO + ((pbase + j) * 16 + r16) * SR) + q4 * 16;
#pragma unroll
                        for (int ks = 0; ks < 4; ++ks) { const bf16x8 xk = *(const LAS bf16x8*)(Kb + ks * 64); const bf16x8 yq = *(const LAS bf16x8*)(Qb + ks * 64); p[jj] = __builtin_amdgcn_mfma_f32_16x16x32_bf16(xk, yq, p[jj], 0, 0, 0); }
                        if (j == i) {
#pragma unroll
                            for (int e = 0; e < 4; ++e) if (4 * q4 + e > r16) p[jj][e] = 0.f;
                        }
                    }
                }
                u32x4 ypw; ypw.x = pk(p[0][0], p[0][1]); ypw.y = pk(p[0][2], p[0][3]); ypw.z = pk(p[1][0], p[1][1]); ypw.w = pk(p[1][2], p[1][3]);
                const bf16x8 yp = __builtin_bit_cast(bf16x8, ypw);
#pragma unroll
                for (int nb = 0; nb < 4; ++nb) {
                    const LAS unsigned char* vp = VT + (64 * vh + 16 * nb + r16) * 144 + (32 * jp + 4 * q4) * 2;
                    const u32x2 lo = *(const LAS u32x2*)vp, hi = *(const LAS u32x2*)(vp + 32);
                    const u32x4 xw = {lo.x, lo.y, hi.x, hi.y};
                    acc[nb] = __builtin_amdgcn_mfma_f32_16x16x32_bf16(__builtin_bit_cast(bf16x8, xw), yp, acc[nb], 0, 0, 0);
                }
            }
        }
        float ss = 0.f;
#pragma unroll
        for (int nb = 0; nb < 4; ++nb) ss += (acc[nb][0] * acc[nb][0] + acc[nb][1] * acc[nb][1]) + (acc[nb][2] * acc[nb][2] + acc[nb][3] * acc[nb][3]);
        ss += __shfl_xor(ss, 16); ss += __shfl_xor(ss, 32);
        if (q4 == 0) RMS[(16 * i + r16) * 2 + vh] = ss;
        WG_BAR();
        const float rstd = rsqrtf((RMS[(16 * i + r16) * 2] + RMS[(16 * i + r16) * 2 + 1]) * (1.f / HD) + EPS);
#pragma unroll
        for (int nb = 0; nb < 4; ++nb) {
            const int v0 = 64 * vh + 16 * nb + 4 * q4;
            const f32x4 o = acc[nb] * rstd * ngv[nb];
            *(u32x2*)(hg + row * HW + h * HD + v0) = (u32x2){pk(o[0] * bflo(sv[nb].x), o[1] * bfhi(sv[nb].x)), pk(o[2] * bflo(sv[nb].y), o[3] * bfhi(sv[nb].y))};
        }
        WG_BAR();
    }
}

__device__ __forceinline__ f32x4 bf4(u32x2 v) { return (f32x4){bflo(v.x), bfhi(v.x), bflo(v.y), bfhi(v.y)}; }
__device__ __forceinline__ void ffn_fixup(int pm, const bf16* hbnd, const float* cw, const float* cb, bf16* act) {
    int tid = threadIdx.x; asm volatile("" : "+v"(tid));
    for (int idx = tid; idx < DFF / 4; idx += NTHREADS) {
        const int c4 = idx * 4;
        const f32x4 wv0 = *(const f32x4*)(cw + c4), wv1 = *(const f32x4*)(cw + NUP + c4), wv2 = *(const f32x4*)(cw + 2 * NUP + c4), bv = *(const f32x4*)(cb + c4);
        const f32x4 wg0 = *(const f32x4*)(cw + DFF + c4), wg1 = *(const f32x4*)(cw + NUP + DFF + c4), wg2 = *(const f32x4*)(cw + 2 * NUP + DFF + c4), bg = *(const f32x4*)(cb + DFF + c4);
        u32x2 hv[2][4], hg[2][4];
#pragma unroll
        for (int bb = 0; bb < 2; ++bb) {
            const int blk = 2 * pm + bb; const bool first = (blk & 63) == 0;
#pragma unroll
            for (int k = 0; k < 4; ++k) {
                const int sb = k < 2 ? blk - 1 : blk, slot = k < 2 ? k + 2 : k - 2;
                const bf16* p = hbnd + ((size_t)(sb * 4 + slot) * 2) * DFF + c4;
                if (k < 2 && first) { hv[bb][k] = (u32x2){0u, 0u}; hg[bb][k] = (u32x2){0u, 0u}; }
                else { hv[bb][k] = *(const u32x2*)p; hg[bb][k] = *(const u32x2*)(p + DFF); }
            }
        }
#pragma unroll
        for (int bb = 0; bb < 2; ++bb)
#pragma unroll
            for (int dl = 0; dl < 2; ++dl) {
                const f32x4 vc = wv2 * bf4(hv[bb][2 + dl]) + wv1 * bf4(hv[bb][1 + dl]) + wv0 * bf4(hv[bb][dl]) + bv;
                const f32x4 gc = wg2 * bf4(hg[bb][2 + dl]) + wg1 * bf4(hg[bb][1 + dl]) + wg0 * bf4(hg[bb][dl]) + bg;
                f32x4 a;
#pragma unroll
                for (int e = 0; e < 4; ++e) a[e] = vc[e] * silu(gc[e]);
                *(u32x2*)(act + ((size_t)(2 * pm + bb) * 128 + dl) * DFF + c4) = (u32x2){pk(a[0], a[1]), pk(a[2], a[3])};
            }
    }
}

__device__ __forceinline__ void phase_final(float* out, const float* ssq, const float* fg, int G) {
    int tid = threadIdx.x; asm volatile("" : "+v"(tid));
    const int lane = tid & 63, wave = tid >> 6;
    for (int m = blockIdx.x * NWAVES + wave; m < M; m += G * NWAVES) {
        const f32x4* sp = (const f32x4*)(ssq + (size_t)m * 16);
        const f32x4 s = (sp[0] + sp[1]) + (sp[2] + sp[3]);
        const float rstd = rsqrtf(((s[0] + s[1]) + (s[2] + s[3])) * (1.f / D) + EPS);
        f32x4* xr = (f32x4*)(out + (size_t)m * D) + lane; const f32x4* gr = (const f32x4*)fg + lane;
#pragma unroll
        for (int j = 0; j < 4; ++j) xr[64 * j] = xr[64 * j] * rstd * gr[64 * j];
    }
}


#ifndef DEBUG_SCAN
#define DEBUG_SCAN 0
#endif
__device__ __forceinline__ void scan_bf16(const bf16* p, size_t n, int* flags, int code, int G) {
    int tid = threadIdx.x; asm volatile("" : "+v"(tid));
    const u32x4* q = (const u32x4*)p; const size_t n16 = n / 8; bool bad = false, huge = false;
    for (size_t i = (size_t)blockIdx.x * NTHREADS + tid; i < n16; i += (size_t)G * NTHREADS) { const u32x4 w = q[i];
#pragma unroll
        for (int e = 0; e < 4; ++e) { const unsigned x = w[e]; if ((x & 0x7f80u) == 0x7f80u || (x & 0x7f800000u) == 0x7f800000u) bad = true; if (fabsf(bflo(x)) > 1e4f || fabsf(bfhi(x)) > 1e4f) huge = true; } }
    if (bad) flags[code] = 1; if (huge) flags[64 + code] = 1;
}
__device__ __forceinline__ void scan_f32(const float* p, size_t n, int* flags, int code, int G) {
    int tid = threadIdx.x; asm volatile("" : "+v"(tid));
    bool bad = false, huge = false;
    for (size_t i = (size_t)blockIdx.x * NTHREADS + tid; i < n; i += (size_t)G * NTHREADS) { const unsigned x = __float_as_uint(p[i]); if ((x & 0x7f800000u) == 0x7f800000u) bad = true; if (fabsf(p[i]) > 1e4f) huge = true; }
    if (bad) flags[code] = 1; if (huge) flags[64 + code] = 1;
}
#define XB_TMO      128
#define XB_XCNT(j)  (256  + 64 * (j))
#define XB_XSUB(j)  (1280 + 64 * (j))
#define XB_XGEN(j)  (2304 + 64 * (j))
#define XB_TOP      3328
#define XB_TOPGEN   3392
#define XCD_BAR_WORDS 3456
#define XB_SPIN_CAP (1u << 18)

__device__ __forceinline__ unsigned xb_ld(unsigned* p)              { return __hip_atomic_load(p, __ATOMIC_RELAXED, __HIP_MEMORY_SCOPE_AGENT); }
__device__ __forceinline__ unsigned xb_add(unsigned* p, unsigned v) { return __hip_atomic_fetch_add(p, v, __ATOMIC_RELAXED, __HIP_MEMORY_SCOPE_AGENT); }
__device__ __forceinline__ unsigned xb_xcc_id() { return (unsigned)__builtin_amdgcn_s_getreg((3 << 11) | 20) & 0xFu; }
#define XB_SPIN(cond, bar) do { unsigned _sp = 0; while (cond) { __builtin_amdgcn_s_sleep(1); \
    if ((++_sp & 255u) == 0u) { if (xb_ld(&(bar)[XB_TMO])) break; if (_sp > XB_SPIN_CAP) { atomicAdd(&(bar)[XB_TMO], 1u); break; } } } } while (0)

struct XcdBarrier {
    unsigned* bar; unsigned x;
    volatile LAS unsigned* st;
};

__device__ __forceinline__ XcdBarrier xcd_barrier_post(unsigned* bar, volatile LAS unsigned* st) {
    XcdBarrier b; b.bar = bar; b.x = xb_xcc_id(); b.st = st;
    if (threadIdx.x == 0) (void)xb_add(&bar[XB_XCNT(b.x)], 1u);
    return b;
}
__device__ __forceinline__ void xcd_barrier_complete(unsigned* bar, unsigned x, unsigned& nloc, unsigned& nx) {
    const unsigned G = gridDim.x * gridDim.y * gridDim.z;
    unsigned sum, cnt, mine, sp = 0u;
    for (;;) {
        sum = 0u; cnt = 0u; mine = 0u;
#pragma unroll
        for (unsigned j = 0; j < 16; ++j) { const unsigned c = xb_ld(&bar[XB_XCNT(j)]); sum += c; cnt += (c > 0u) ? 1u : 0u; mine = (j == x) ? c : mine; }
        if (sum == G) break;
        __builtin_amdgcn_s_sleep(1);
        if ((++sp & 255u) == 0u) { if (xb_ld(&bar[XB_TMO])) break; if (sp > XB_SPIN_CAP) { atomicAdd(&bar[XB_TMO], 1u); break; } }
    }
    nloc = mine > 0u ? mine : 1u; nx = cnt > 0u ? cnt : 1u;
}

__device__ __forceinline__ void xcd_barrier(const XcdBarrier& b) {
    asm volatile("s_waitcnt vmcnt(0)" ::: "memory");
    __syncthreads();
    if (threadIdx.x == 0) {
        unsigned* bar = b.bar;
        __builtin_amdgcn_s_waitcnt(0);
        unsigned nloc = b.st[0], nx = b.st[1];
        if (nloc == 0u) { xcd_barrier_complete(bar, b.x, nloc, nx); b.st[0] = nloc; b.st[1] = nx; }
        const unsigned old = xb_add(&bar[XB_XSUB(b.x)], 1u);
        const unsigned gen = old / nloc;
        if (old + 1u == (gen + 1u) * nloc) {
            __builtin_amdgcn_fence(__ATOMIC_RELEASE, "agent");
            asm volatile("s_waitcnt vmcnt(0)" ::: "memory");
            const unsigned og = xb_add(&bar[XB_TOP], 1u);
            const unsigned tg = og / nx;
            if (og + 1u == (tg + 1u) * nx) xb_add(&bar[XB_TOPGEN], 1u);
            else XB_SPIN(xb_ld(&bar[XB_TOPGEN]) == tg, bar);
            __builtin_amdgcn_fence(__ATOMIC_ACQUIRE, "agent");
            xb_add(&bar[XB_XGEN(b.x)], 1u);
            asm volatile("s_waitcnt vmcnt(0)" ::: "memory");
        } else {
            XB_SPIN(xb_ld(&bar[XB_XGEN(b.x)]) == gen, bar);
            __builtin_amdgcn_fence(__ATOMIC_ACQUIRE, "agent");
            asm volatile("s_waitcnt vmcnt(0)" ::: "memory");
        }
    }
    __syncthreads();
}

#ifndef ONE_LAUNCH
#define ONE_LAUNCH 1
#endif
constexpr int PH_PER_LAYER = 8, N_PHASES = 1 + DEPTH * PH_PER_LAYER + 1;

__global__ void __launch_bounds__(NTHREADS, 2) trunk_fwd(Args args) {
    extern __shared__ __attribute__((aligned(16))) unsigned char lds_raw[];
    LAS unsigned char* lds = (LAS unsigned char*)lds_raw;
    cg::grid_group grid = cg::this_grid();
    const int G = gridDim.x;
    unsigned char* ws = args.ws;
    float* out = args.out;
    const int lo = args.ph_lo, hi = args.ph_hi;
    float* ssq = (float*)(ws + WS_SSQ); float* dec = (float*)(ws + WS_DEC); bf16* hbnd = (bf16*)(ws + WS_HBND); bf16* xb = (bf16*)(ws + WS_XB);
    bf16 *ub = (bf16*)(ws + WS_U), *hgb = (bf16*)(ws + WS_HG), *qb = (bf16*)(ws + WS_Q), *vb = (bf16*)(ws + WS_V), *sob = (bf16*)(ws + WS_SO), *pooled = (bf16*)(ws + WS_POOL);
    bf16 *UT = (bf16*)(ws + WS_UT), *gates = (bf16*)out  , *merged = (bf16*)(ws + WS_MERGED), *act = (bf16*)(ws + WS_ACT);
    float* gl = (float*)(ws + WS_G);
#ifndef PHASE_MASK
#define PHASE_MASK 0xfff
#endif
#define EN(j) (((PHASE_MASK) >> (j)) & 1)
#define IN(k) (lo <= (k) && (k) < hi)
#define SC(k) (DEBUG_SCAN && lo == (k) && hi == (k) - 1)
    volatile LAS unsigned* MISC = (volatile LAS unsigned*)(lds + 131072 + 512);
    { int t_ = threadIdx.x; asm volatile("" : "+v"(t_)); if (t_ < 32) MISC[t_] = 0u; }
    __syncthreads();
    XcdBarrier bar = xcd_barrier_post((unsigned*)(ws + WS_BAR), MISC + 8);
#ifndef PROBE_A
#define PROBE_A -1
#define PROBE_B -1
#endif
    unsigned long long* tsb = (unsigned long long*)(ws + 4096);
#define STAMP(k) do { if (PROBE_A >= 0 && blockIdx.x == 0) { int t_ = threadIdx.x; asm volatile("" : "+v"(t_)); if (t_ == 0) tsb[(k)] = __builtin_amdgcn_s_memrealtime(); } } while (0)
#define SEAM(k) do { if (IN(k) && IN((k) + 1)) { if ((k) == 0) grid.sync(); else xcd_barrier(bar); } STAMP((k) + 1); } while (0)
    STAMP(0);

    int* dbg = (int*)ws;
    if (EN(9) && IN(0)) { if (DEBUG_SCAN && blockIdx.x == 0) { int t_ = threadIdx.x; asm volatile("" : "+v"(t_)); if (t_ < 128) dbg[t_] = 0; } phase_prologue(args, lds, G); }
    SEAM(0);
    for (int l = 0; l < DEPTH; ++l) {
        const int pb = 1 + l * PH_PER_LAYER;
        unsigned char* wl = ws + WS_W + (size_t)l * W_LAYER;
        const bf16* Win = (const bf16*)(wl + WO_IN);
        if (EN(0) && IN(pb + 0)) {
            pg8::Gemm g{xb, Win, M, IN_COLS, D}; pg8::StaticOrder S; S.init(M, IN_COLS, G, (int)blockIdx.x);
            EpiInMix E{ub, qb, vb, sob, gl, ssq, (const float*)(ws + WS_LB) + l * HW, gates, args.in[3] + l * NGATE};
            pg8::gemm_phase<EpiInMix, pg8::StaticOrder, true, true>(lds, g, S, E);
        }
        SEAM(pb + 0);
        if (SC(pb + 1)) { const int cb_ = 20 * l; scan_bf16(ub, (size_t)M * 512, dbg, cb_ + 1, G); scan_bf16(qb, (size_t)M * 512, dbg, cb_ + 2, G); scan_bf16(vb, (size_t)M * 512, dbg, cb_ + 3, G); scan_bf16(sob, (size_t)M * 512, dbg, cb_ + 4, G); scan_f32(gl, (size_t)M * 512, dbg, cb_ + 5, G); }
        if (EN(1) && IN(pb + 1)) { phase_fir(ub, pooled, G); phase_h1(lds, gl, vb, UT, dec, G); }
        SEAM(pb + 1);
        if (SC(pb + 2)) { const int cb_ = 20 * l; scan_bf16(pooled, (size_t)M * 512, dbg, cb_ + 6, G); scan_bf16(UT, (size_t)NUNIT * 16384, dbg, cb_ + 7, G); scan_f32(dec, (size_t)NUNIT * 128, dbg, cb_ + 8, G); }
        if (EN(2) && IN(pb + 2)) phase_h2(UT, dec, G);
        SEAM(pb + 2);
        if (SC(pb + 3)) { scan_bf16(UT, (size_t)NUNIT * 16384, dbg, 20 * l + 9, G); }
        if (EN(3) && IN(pb + 3)) phase_h3(lds, qb, gl, vb, sob, UT, args.in[7] + l * HD, hgb, G);
        SEAM(pb + 3);
        if (SC(pb + 4)) { scan_bf16(gates, (size_t)M * 2048, dbg, 20 * l + 11, G); }
        if (EN(5) && IN(pb + 4)) {
            pg8::Gemm g{pooled, (const bf16*)(wl + WO_A), M, D, PW}; PairOrder S; S.S.init(M, D, G, (int)blockIdx.x);
            EpiMerge E{merged, gates};
            pg8::gemm_phase<EpiMerge, PairOrder, true, true>(lds, g, S, E);
        }
        SEAM(pb + 4);
        if (SC(pb + 5)) { scan_bf16(merged, (size_t)M * 1024, dbg, 20 * l + 12, G); }
        if (EN(6) && IN(pb + 5)) {
            pg8::Gemm g{merged, (const bf16*)(wl + WO_O), M, D, D}; pg8::StaticOrder S; S.init(M, D, G, (int)blockIdx.x);
            EpiRes<false> E{out, xb, ssq};
            pg8::gemm_phase<EpiRes<false>, pg8::StaticOrder, true, true>(lds, g, S, E);
        }
        SEAM(pb + 5);
        if (SC(pb + 6)) { scan_f32(out, (size_t)M * 1024, dbg, 20 * l + 13, G); scan_bf16(xb, (size_t)M * 1024, dbg, 20 * l + 14, G); scan_f32(ssq, (size_t)M * 16, dbg, 20 * l + 15, G); }
        if (EN(7) && IN(pb + 6)) {
            pg8::Gemm g{xb, (const bf16*)(wl + WO_UP), M, NUP, D}; pg8::StaticOrder S; S.init(M, NUP, G, (int)blockIdx.x);
            EpiUpConv E{act, hbnd, ssq, args.in[13] + (size_t)l * 3 * NUP, args.in[14] + (size_t)l * NUP};
            pg8::gemm_phase<EpiUpConv, pg8::StaticOrder, true, true, true>(lds, g, S, E);
        }
        SEAM(pb + 6);
        if (SC(pb + 7)) { scan_bf16(act, (size_t)M * DFF, dbg, 20 * l + 16, G); scan_bf16(hbnd, (size_t)128 * 4 * 2 * DFF, dbg, 20 * l + 17, G); }
        if (EN(8) && IN(pb + 7)) {
            pg8::StaticOrder S; S.init(M, D, G, (int)blockIdx.x);
            pg8::Unit un;
            for (int i = 0; S.next(i, un); ++i) ffn_fixup(un.pm, hbnd, args.in[13] + (size_t)l * 3 * NUP, args.in[14] + (size_t)l * NUP, act);
            VM_WAIT(); __builtin_amdgcn_fence(__ATOMIC_ACQ_REL, "agent"); __syncthreads();
            pg8::Gemm g{act, (const bf16*)(wl + WO_DN), M, D, DFF};
            if (l == DEPTH - 1) { EpiRes<true> E{out, xb, ssq}; pg8::gemm_phase<EpiRes<true>, pg8::StaticOrder, true, true>(lds, g, S, E); }
            else { EpiRes<false> E{out, xb, ssq}; pg8::gemm_phase<EpiRes<false>, pg8::StaticOrder, true, true>(lds, g, S, E); }
        }
        SEAM(pb + 7);
    }
    if (SC(N_PHASES - 1)) {
        scan_f32(out, (size_t)M * 1024, dbg, 58, G); scan_f32(ssq, (size_t)M * 16, dbg, 59, G);
        __syncthreads();
    }
    if (EN(10) && IN(N_PHASES - 1)) phase_final(out, ssq, args.in[16], G);
    if (DEBUG_SCAN && IN(N_PHASES)) {
        int t_ = threadIdx.x; asm volatile("" : "+v"(t_));
        int c1 = -1, c2 = -1; for (int i = 63; i >= 0; --i) { if (dbg[i]) c1 = i; if (dbg[64 + i]) c2 = i; }
        const float cval = 100.f * (float)(c2 + 2);
        for (size_t i = (size_t)blockIdx.x * NTHREADS + t_; i < (size_t)M * D; i += (size_t)G * NTHREADS) out[i] = (i == 0) ? 1e4f * (float)(c1 + 1) : cval;
    }
    if (PROBE_A >= 0 && blockIdx.x == 0) {
        int t_ = threadIdx.x; asm volatile("" : "+v"(t_));
        if (t_ == 0) {
            STAMP(N_PHASES);
            __builtin_amdgcn_fence(__ATOMIC_ACQ_REL, "agent");
            const unsigned long long da = tsb[PROBE_A + 1] - tsb[PROBE_A], db = PROBE_B >= 0 ? tsb[PROBE_B + 1] - tsb[PROBE_B] : 0ull;
            const unsigned long long spin = 4ull * da + 204800ull * (db / 3200ull);
            const unsigned long long t0 = __builtin_amdgcn_s_memrealtime();
            while (__builtin_amdgcn_s_memrealtime() - t0 < spin) __builtin_amdgcn_s_sleep(32);
        }
    }
#undef IN
#undef SEAM
}

extern "C" void kernel_launch(void* const* d_in, const int* in_sizes, int n_in, void* d_out, int out_size, void* d_ws, size_t ws_size, hipStream_t stream) {
    static int grid = 0;
    if (grid == 0) {
        if (n_in != 17 || in_sizes[0] != M * D || out_size != M * D || ws_size < WS_END) { fprintf(stderr, "kernel_launch: unexpected shapes (n_in %d, in0 %d, out %d, ws %zu)\n", n_in, n_in > 0 ? in_sizes[0] : -1, out_size, ws_size); grid = -1; return; }
        int dev = 0, cus = 0, per_cu = 0;
        hipGetDevice(&dev); hipDeviceGetAttribute(&cus, hipDeviceAttributeMultiprocessorCount, dev);
        if (hipFuncSetAttribute((const void*)trunk_fwd, hipFuncAttributeMaxDynamicSharedMemorySize, LDS_BYTES) != hipSuccess) { fprintf(stderr, "kernel_launch: hipFuncSetAttribute failed\n"); grid = -1; return; }
        if (hipOccupancyMaxActiveBlocksPerMultiprocessor(&per_cu, (const void*)trunk_fwd, NTHREADS, LDS_BYTES) != hipSuccess || per_cu < 1) { fprintf(stderr, "kernel_launch: occupancy query says %d\n", per_cu); per_cu = 1; }
        (void)hipGetLastError();
        grid = cus * 1;
        fprintf(stderr, "kernel_launch: grid %d (cus %d, per_cu %d)\n", grid, cus, per_cu);
    }
    if (grid < 0) return;
    Args a{};
    for (int i = 0; i < 17; ++i) a.in[i] = (const float*)d_in[i];
    a.out = (float*)d_out; a.ws = (unsigned char*)d_ws;
#if ONE_LAUNCH
    if (hipMemsetAsync((char*)d_ws + WS_BAR, 0, BAR_BYTES, stream) != hipSuccess) { fprintf(stderr, "kernel_launch: memset failed\n"); return; }
    a.ph_lo = 0; a.ph_hi = N_PHASES;
    void* kargs[] = {&a};
    hipError_t e = hipLaunchCooperativeKernel((const void*)trunk_fwd, dim3(grid), dim3(NTHREADS), kargs, LDS_BYTES, stream);
    if (e != hipSuccess) fprintf(stderr, "kernel_launch: cooperative launch failed: %s (grid %d)\n", hipGetErrorString(e), grid);
#else
    for (int p = 0; p < N_PHASES + (DEBUG_SCAN ? 1 : 0); ++p) {
        if (DEBUG_SCAN && p > 0 && p < N_PHASES) { a.ph_lo = p; a.ph_hi = p - 1; hipLaunchKernelGGL(trunk_fwd, dim3(grid), dim3(NTHREADS), LDS_BYTES, stream, a); }
        a.ph_lo = p; a.ph_hi = p + 1;
        hipLaunchKernelGGL(trunk_fwd, dim3(grid), dim3(NTHREADS), LDS_BYTES, stream, a);
    }
#endif
}
```

```cpp
#include <hip/hip_runtime.h>
#include <hip/hip_cooperative_groups.h>
#include <cstdio>
#include <cstdint>
namespace cg = cooperative_groups;
namespace pg8 {
#define PG8_LAS __attribute__((address_space(3)))
typedef unsigned short bf16_t;
typedef short bf16x8 __attribute__((ext_vector_type(8)));
typedef float f32x4 __attribute__((ext_vector_type(4)));
typedef unsigned u32x4 __attribute__((ext_vector_type(4)));
constexpr int BM = 256, BK = 64, HALF = 128, HTB = HALF * BK * 2  , STAGE_BYTES = 8 * HTB, NXCD = 8, WGM = 8;

__host__ __device__ __forceinline__ int lds_byte(int r, int c) { const int st = (r >> 4) * 2 + (c >> 5), rr = r & 15, cc = c & 31, ob = rr * 64 + cc * 2; return st * 1024 + (ob ^ (((ob >> 9) & 1) << 5)); }
__host__ __device__ __forceinline__ void stage_rc(int b, int& R, int& C) { const int st = b / 1024, sb = b % 1024, swz = sb ^ (((sb >> 9) & 1) << 5); R = (st >> 1) * 16 + swz / 64; C = (st & 1) * 32 + (swz % 64) / 2; }
__host__ __device__ __forceinline__ int perm32(int rho) { const int n = rho >> 4, i = rho & 15; return 8 * (i >> 2) + 4 * n + (i & 3); }

struct Unit { int pm, pn; };
struct Gemm { const bf16_t* A; const bf16_t* Bt; int M, N, K; };

struct StaticOrder {
    int nM, nN, nwg, G, c;
    __host__ __device__ void init(int M, int N, int G_, int c_) { nM = M / BM; nN = N / BM; nwg = nM * nN; G = G_; c = c_; }
    __host__ __device__ bool next(int i, Unit& u) const {
        const long L = (long)i * G + c; if (L >= nwg) return false;
        int wgid = (int)L; { const int q = nwg / NXCD, r = nwg % NXCD, xcd = wgid % NXCD, off = wgid / NXCD; wgid = (xcd < r ? xcd * (q + 1) : r * (q + 1) + (xcd - r) * q) + off; }
        const int nig = WGM * nN, gid = wgid / nig, fm = gid * WGM, gsz = (nM - fm) < WGM ? (nM - fm) : WGM;
        u.pm = fm + ((wgid % nig) % gsz); u.pn = (wgid % nig) / gsz; return true;
    }
    __device__ __forceinline__ void a_ready(const Unit&) const {}
    __device__ __forceinline__ void done(const Unit&) const {}
};

__device__ __forceinline__ unsigned cvt_pk_bf16(float lo, float hi) { unsigned r; asm volatile("v_cvt_pk_bf16_f32 %0, %1, %2" : "=v"(r) : "v"(lo), "v"(hi)); return r; }
typedef float f32x2 __attribute__((ext_vector_type(2)));
template <class Epi, class Sched, bool ALIGN_EPI = false, bool SP2 = false, bool ROWPERM = false>
__device__ __forceinline__ void gemm_phase(PG8_LAS unsigned char* lds, const Gemm g, const Sched& S, const Epi& E) {
    int tid = threadIdx.x; asm volatile("" : "+v"(tid));
    const int wid = __builtin_amdgcn_readfirstlane(tid >> 6), lane = tid & 63, wr = wid >> 2, wc = wid & 3, fr = lane & 15, fq = lane >> 4;
    const int K = g.K, nt = K / BK;
    unsigned voffA[2], voffB[2];
#pragma unroll
    for (int i = 0; i < 2; ++i) { int R, C; stage_rc(tid * 16 + i * 8192, R, C); const int Rb = Epi::PERM ? ((R & ~31) + perm32(R & 31)) : R;
        const int Ra = ROWPERM ? (128 * (R >> 6) + 8 * (R & 15) + ((R >> 4) & 3)) : R;
        voffA[i] = (unsigned)(Ra * K + C) * 2u; voffB[i] = (unsigned)(Rb * K + C) * 2u; }
    const size_t kstep = (size_t)(BK * 2);
    const size_t hstep = (size_t)HALF * K * 2;
    const size_t hstepA = ROWPERM ? (size_t)4 * K * 2 : hstep;
    const size_t tstep = 2 * hstep;
    const unsigned ldsw = (unsigned)wid * 1024u;
    const int aoff = lds_byte(wr * 64 + fr, fq * 8), boff = lds_byte(wc * 32 + fr, fq * 8);
#define PG8_SA(b, h) (((b) * 2 + (h)) * HTB)
#define PG8_SB(b, h) ((4 + (b) * 2 + (h)) * HTB)
#define PG8_STAGE(bufoff, gbase, voff) do { _Pragma("unroll") for (int _i = 0; _i < 2; ++_i) \
        __builtin_amdgcn_global_load_lds((const unsigned*)((const char*)(gbase) + (voff)[_i]), (PG8_LAS unsigned*)(lds + (bufoff) + ldsw + _i * 8192), 16, 0, 0); } while (0)
#define PG8_LDA(dst, b, h) do { _Pragma("unroll") for (int m = 0; m < 4; ++m) _Pragma("unroll") for (int k = 0; k < 2; ++k) dst[m][k] = *(const PG8_LAS bf16x8*)(lds + PG8_SA(b, h) + aoff + m * 2048 + k * 1024); } while (0)
#define PG8_LDB(dst, b, h) do { _Pragma("unroll") for (int n = 0; n < 2; ++n) _Pragma("unroll") for (int k = 0; k < 2; ++k) dst[n][k] = *(const PG8_LAS bf16x8*)(lds + PG8_SB(b, h) + boff + n * 2048 + k * 1024); } while (0)
#define PG8_MMA(ai, bj, At, Bt) do { __builtin_amdgcn_s_setprio(1); _Pragma("unroll") for (int m = 0; m < 4; ++m) _Pragma("unroll") for (int n = 0; n < 2; ++n) _Pragma("unroll") for (int k = 0; k < 2; ++k) \
        acc[ai][bj][m][n] = __builtin_amdgcn_mfma_f32_16x16x32_bf16(Bt[n][k], At[m][k], acc[ai][bj][m][n], 0, 0, 0); __builtin_amdgcn_s_setprio(0); } while (0)
#define PG8_WAIT_V(n) asm volatile("s_waitcnt vmcnt(" #n ")" ::: "memory")
#define PG8_WAIT_L(n) asm volatile("s_waitcnt lgkmcnt(" #n ")" ::: "memory")
#define PG8_BAR __builtin_amdgcn_s_barrier()
#define PG8_SCHED __builtin_amdgcn_sched_barrier(0)
    Unit cur, nxt; int ui = 0;
    if (!S.next(0, cur)) return;
    f32x4 acc[2][2][4][2];
#pragma unroll
    for (int a = 0; a < 2; ++a)
#pragma unroll
        for (int b = 0; b < 2; ++b)
#pragma unroll
            for (int m = 0; m < 4; ++m)
#pragma unroll
                for (int n = 0; n < 2; ++n) acc[a][b][m][n] = (f32x4){0.f, 0.f, 0.f, 0.f};
    bf16x8 At[4][2], B0[2][2], B1[2][2];
    const char* cA = (const char*)g.A + (size_t)cur.pm * tstep; const char* cB = (const char*)g.Bt + (size_t)cur.pn * tstep;
    S.a_ready(cur);
    if constexpr (SP2) {
        PG8_STAGE(PG8_SB(0, 0), cB, voffB); PG8_STAGE(PG8_SB(0, 1), cB + hstep, voffB); PG8_STAGE(PG8_SA(0, 0), cA, voffA); PG8_STAGE(PG8_SA(0, 1), cA + hstepA, voffA);
        if (wr == 1) PG8_BAR;
        PG8_WAIT_V(2); PG8_BAR;
        PG8_STAGE(PG8_SB(1, 0), cB + kstep, voffB); PG8_STAGE(PG8_SA(1, 0), cA + kstep, voffA); PG8_STAGE(PG8_SB(1, 1), cB + hstep + kstep, voffB);
        PG8_WAIT_V(6); PG8_BAR;
    } else {
        PG8_STAGE(PG8_SB(0, 0), cB, voffB); PG8_STAGE(PG8_SA(0, 0), cA, voffA); PG8_STAGE(PG8_SB(0, 1), cB + hstep, voffB); PG8_STAGE(PG8_SA(0, 1), cA + hstepA, voffA);
        if (wr == 1) PG8_BAR;
        PG8_WAIT_V(4); PG8_BAR;
        PG8_STAGE(PG8_SB(1, 0), cB + kstep, voffB); PG8_STAGE(PG8_SA(1, 0), cA + kstep, voffA); PG8_STAGE(PG8_SB(1, 1), cB + hstep + kstep, voffB);
        PG8_WAIT_V(6); PG8_BAR;
    }
    for (;;) {
        const bool has_next = S.next(ui + 1, nxt);
        const char* nA = has_next ? (const char*)g.A + (size_t)nxt.pm * tstep : cA; const char* nB = has_next ? (const char*)g.Bt + (size_t)nxt.pn * tstep : cB;
        for (int t = 0; t < nt; t += 2) {
            const bool last = (t == nt - 2);
            const char* a1 = cA + (size_t)(t + 1) * kstep;
            const char* a2 = last ? nA : cA + (size_t)(t + 2) * kstep; const char* b2 = last ? nB : cB + (size_t)(t + 2) * kstep;
            const char* a3 = a2 + kstep; const char* b3 = b2 + kstep;
            if (last && has_next) S.a_ready(nxt);
            if constexpr (SP2) {
            PG8_LDB(B0, 0, 0); PG8_LDB(B1, 0, 1); PG8_SCHED; PG8_LDA(At, 0, 0); PG8_STAGE(PG8_SA(1, 1), a1 + hstepA, voffA);
            PG8_WAIT_V(8); PG8_WAIT_L(0); PG8_BAR; PG8_MMA(0, 0, At, B0); PG8_MMA(0, 1, At, B1); PG8_BAR; PG8_SCHED;
            PG8_LDA(At, 0, 1); PG8_STAGE(PG8_SB(0, 0), b2, voffB); PG8_STAGE(PG8_SB(0, 1), b2 + hstep, voffB); PG8_STAGE(PG8_SA(0, 0), a2, voffA);
            PG8_WAIT_V(8); PG8_WAIT_L(0); PG8_BAR; PG8_MMA(1, 0, At, B0); PG8_MMA(1, 1, At, B1); PG8_BAR; PG8_SCHED;
            PG8_LDB(B0, 1, 0); PG8_LDB(B1, 1, 1); PG8_SCHED; PG8_LDA(At, 1, 0); PG8_STAGE(PG8_SA(0, 1), a2 + hstepA, voffA);
            PG8_WAIT_V(8); PG8_WAIT_L(0); PG8_BAR; PG8_MMA(0, 0, At, B0); PG8_MMA(0, 1, At, B1); PG8_BAR; PG8_SCHED;
            PG8_LDA(At, 1, 1); PG8_STAGE(PG8_SB(1, 0), b3, voffB); PG8_STAGE(PG8_SB(1, 1), b3 + hstep, voffB); PG8_STAGE(PG8_SA(1, 0), a3, voffA);
            PG8_WAIT_V(8); PG8_WAIT_L(0); PG8_BAR; PG8_MMA(1, 0, At, B0); PG8_MMA(1, 1, At, B1); PG8_BAR; PG8_SCHED;
            } else {
            PG8_LDB(B0, 0, 0); PG8_SCHED; PG8_LDA(At, 0, 0); PG8_STAGE(PG8_SA(1, 1), a1 + hstepA, voffA);
            PG8_WAIT_L(8); PG8_BAR; PG8_WAIT_L(0); PG8_MMA(0, 0, At, B0); PG8_BAR; PG8_SCHED;
            PG8_LDB(B1, 0, 1); PG8_STAGE(PG8_SB(0, 0), b2, voffB);
            PG8_BAR; PG8_WAIT_L(0); PG8_MMA(0, 1, At, B1); PG8_BAR;
            PG8_LDA(At, 0, 1); PG8_STAGE(PG8_SA(0, 0), a2, voffA);
            PG8_BAR; PG8_WAIT_L(0); PG8_MMA(1, 0, At, B0); PG8_BAR; PG8_SCHED;
            PG8_STAGE(PG8_SB(0, 1), b2 + hstep, voffB);
            PG8_WAIT_V(6); PG8_BAR; PG8_MMA(1, 1, At, B1); PG8_BAR;
            PG8_LDB(B0, 1, 0); PG8_SCHED; PG8_LDA(At, 1, 0); PG8_STAGE(PG8_SA(0, 1), a2 + hstepA, voffA);
            PG8_WAIT_L(8); PG8_BAR; PG8_WAIT_L(0); PG8_MMA(0, 0, At, B0); PG8_BAR; PG8_SCHED;
            PG8_LDB(B1, 1, 1); PG8_STAGE(PG8_SB(1, 0), b3, voffB);
            PG8_BAR; PG8_WAIT_L(0); PG8_MMA(0, 1, At, B1); PG8_BAR;
            PG8_LDA(At, 1, 1); PG8_STAGE(PG8_SA(1, 0), a3, voffA);
            PG8_BAR; PG8_WAIT_L(0); PG8_MMA(1, 0, At, B0); PG8_BAR; PG8_SCHED;
            PG8_STAGE(PG8_SB(1, 1), b3 + hstep, voffB);
            PG8_WAIT_V(6); PG8_BAR; PG8_MMA(1, 1, At, B1); PG8_BAR;
            }
        }
        if constexpr (ALIGN_EPI) { if (wr == 0) PG8_BAR; }
        if constexpr (!Epi::AFTER_DRAIN) { E(acc, cur, wr, wc, fr, fq); S.done(cur); }
        if (!has_next) break;
#pragma unroll
        for (int a = 0; a < 2; ++a)
#pragma unroll
            for (int b = 0; b < 2; ++b)
#pragma unroll
                for (int m = 0; m < 4; ++m)
#pragma unroll
                    for (int n = 0; n < 2; ++n) acc[a][b][m][n] = (f32x4){0.f, 0.f, 0.f, 0.f};
        cur = nxt; cA = nA; cB = nB; ++ui;
        if constexpr (ALIGN_EPI) { if (wr == 1) PG8_BAR; }
    }
    PG8_WAIT_V(0);
    if constexpr (!ALIGN_EPI) { if (wr == 0) PG8_BAR; }
    PG8_BAR;
    if constexpr (Epi::AFTER_DRAIN) { E.fused(acc, cur, wr, wc, fr, fq, lds, wid, lane); S.done(cur); }
#undef PG8_SA
#undef PG8_SB
#undef PG8_STAGE
#undef PG8_LDA
#undef PG8_LDB
#undef PG8_MMA
#undef PG8_WAIT_V
#undef PG8_WAIT_L
#undef PG8_BAR
#undef PG8_SCHED
}
}

constexpr int BATCH = 2, SEQ = 8192, D = 1024, M = BATCH * SEQ, DEPTH = 2;
constexpr int PW = 512, HW = 512, NH = 4, HD = 128, CH = 64, NCH = SEQ / CH, NBH = BATCH * NH, NUNIT = NBH * NCH;
constexpr int IN_COLS = 4608, NMIX = 2560, NGATE = 2048, DFF = 2816, NUP = 2 * DFF;
constexpr float EPS = 1e-6f;
constexpr int NWAVES = 8, NTHREADS = 512;
constexpr int LDS_BYTES = 147456;

constexpr size_t MiB = 1u << 20;
constexpr size_t WS_BAR = 512 * 1024, BAR_BYTES = 16384;
constexpr size_t WS_SSQ = 1 * MiB;
constexpr size_t WS_DEC = 2 * MiB;
constexpr size_t WS_LB = 2 * MiB + 768 * 1024;
constexpr size_t WS_HBND = 3 * MiB;
constexpr size_t WS_W = 9 * MiB, W_LAYER = 29 * MiB + 512 * 1024;
constexpr size_t WO_IN = 0, WO_A = 9 * MiB, WO_PB = 10 * MiB, WO_O = 11 * MiB, WO_UP = 13 * MiB, WO_DN = 24 * MiB;
constexpr size_t WS_XB = 68 * MiB;
constexpr size_t WS_R = 100 * MiB;
constexpr size_t WS_U = WS_R, WS_HG = WS_R, WS_Q = WS_R + 16 * MiB, WS_V = WS_R + 32 * MiB, WS_SO = WS_R + 48 * MiB, WS_G = WS_R + 64 * MiB;
constexpr size_t WS_POOL = WS_R + 96 * MiB, WS_UT = WS_R + 112 * MiB, WS_GATES = WS_R + 16 * MiB, WS_MERGED = WS_R + 112 * MiB, WS_ACT = WS_R;
constexpr size_t WS_XF = WS_R + 88 * MiB;
constexpr size_t WS_END = 256 * MiB;
static_assert(WS_UT + 32 * MiB <= WS_END && WS_ACT + (size_t)M * DFF * 2 <= WS_END && WS_GATES + 64 * MiB <= WS_POOL, "ws map");

#define LAS __attribute__((address_space(3)))
typedef unsigned short bf16;
typedef unsigned u32x4 __attribute__((ext_vector_type(4)));
typedef unsigned u32x2 __attribute__((ext_vector_type(2)));
typedef float f32x4 __attribute__((ext_vector_type(4)));
typedef float f32x2 __attribute__((ext_vector_type(2)));
typedef short bf16x8 __attribute__((ext_vector_type(8)));

__device__ __forceinline__ float bflo(unsigned w) { return __uint_as_float(w << 16); }
__device__ __forceinline__ float bfhi(unsigned w) { return __uint_as_float(w & 0xffff0000u); }
typedef __bf16 bf16x2_t __attribute__((ext_vector_type(2)));
__device__ __forceinline__ unsigned pk(float lo, float hi) { const bf16x2_t v = __builtin_convertvector((f32x2){lo, hi}, bf16x2_t); return __builtin_bit_cast(unsigned, v); }
__device__ __forceinline__ float sigm(float x) { return 1.f / (1.f + __expf(-x)); }
__device__ __forceinline__ float silu(float x) { return x * sigm(x); }
__device__ __forceinline__ float wave_sum(float v) {
#pragma unroll
    for (int o = 1; o < 64; o <<= 1) v += __shfl_xor(v, o);
    return v;
}
__device__ __forceinline__ float dpp_shr1(float x) { return __int_as_float(__builtin_amdgcn_update_dpp(0, __float_as_int(x), 0x111, 0xf, 0xf, true)); }
#define LDS_WAIT() asm volatile("s_waitcnt lgkmcnt(0)" ::: "memory")
#define VM_WAIT() asm volatile("s_waitcnt vmcnt(0)" ::: "memory")

__device__ __forceinline__ float load_rs(const float* ssq, int row0, int lane) {
    const f32x4* p = (const f32x4*)(ssq + (size_t)(row0 + lane) * 16);
    const f32x4 a = p[0], b = p[1], c = p[2], d = p[3];
    const f32x4 s = (a + b) + (c + d);
    return rsqrtf(((s[0] + s[1]) + (s[2] + s[3])) * (1.f / D) + EPS);
}

struct EpiInMix {
    static constexpr bool PERM = true, AFTER_DRAIN = false;
    bf16 *u, *q, *v, *so; float* g; const float* ssq; const float* lb; bf16* gates; const float* bgate; int pn_off;
    __device__ __forceinline__ void operator()(const f32x4 (&acc)[2][2][4][2], const pg8::Unit& un0, int wr, int wc, int fr, int fq) const {
        const int lane = fr + 16 * fq;
        pg8::Unit un = un0; un.pn += pn_off;
        float rs[2]; rs[0] = load_rs(ssq, un.pm * 256 + wr * 64, lane); rs[1] = load_rs(ssq, un.pm * 256 + 128 + wr * 64, lane);
        const int sec = un.pn >> 1, colt = (un.pn & 1) * 256 + wc * 32 + 8 * fq, row0 = un.pm * 256 + wr * 64 + fr;
        if (un.pn >= 10) {
            const int col0 = (un.pn - 10) * 256 + wc * 32 + 8 * fq;
            f32x4 bv[2][2];
#pragma unroll
            for (int bj = 0; bj < 2; ++bj)
#pragma unroll
                for (int n = 0; n < 2; ++n) bv[bj][n] = *(const f32x4*)(bgate + col0 + bj * 128 + 4 * n);
#pragma unroll
            for (int ai = 0; ai < 2; ++ai)
#pragma unroll
                for (int m = 0; m < 4; ++m) {
                    const float r = __shfl(rs[ai], 16 * m + fr);
                    bf16* rowp = gates + (size_t)(row0 + ai * 128 + m * 16) * NGATE + col0;
#pragma unroll
                    for (int bj = 0; bj < 2; ++bj) {
                        f32x4 v0 = acc[ai][bj][m][0] * r + bv[bj][0], v1 = acc[ai][bj][m][1] * r + bv[bj][1];
#pragma unroll
                        for (int e = 0; e < 4; ++e) { v0[e] = sigm(v0[e]); v1[e] = sigm(v1[e]); }
                        u32x4 w; w.x = pk(v0[0], v0[1]); w.y = pk(v0[2], v0[3]); w.z = pk(v1[0], v1[1]); w.w = pk(v1[2], v1[3]);
                        *(u32x4*)(rowp + bj * 128) = w;
                    }
                }
        } else if (sec == 2) {
            f32x4 lbv[2][2];
#pragma unroll
            for (int bj = 0; bj < 2; ++bj)
#pragma unroll
                for (int n = 0; n < 2; ++n) lbv[bj][n] = *(const f32x4*)(lb + colt + bj * 128 + 4 * n);
#pragma unroll
            for (int ai = 0; ai < 2; ++ai)
#pragma unroll
                for (int m = 0; m < 4; ++m) {
                    const float r = __shfl(rs[ai], 16 * m + fr);
                    float* rowp = g + (size_t)(row0 + ai * 128 + m * 16) * 512 + colt;
#pragma unroll
                    for (int bj = 0; bj < 2; ++bj)
#pragma unroll
                        for (int n = 0; n < 2; ++n) {
                            const f32x4 z = acc[ai][bj][m][n] * r; f32x4 o;
#pragma unroll
                            for (int e = 0; e < 4; ++e) { const float l = lbv[bj][n][e]; o[e] = logf(l + (1.f - l) * sigm(z[e])); }
                            *(f32x4*)(rowp + bj * 128 + 4 * n) = o;
                        }
                }
        } else {
            bf16* base = sec == 0 ? u : (sec == 1 ? q : (sec == 3 ? v : so));
            const bool act = (sec == 1 || sec == 4);
#pragma unroll
            for (int ai = 0; ai < 2; ++ai)
#pragma unroll
                for (int m = 0; m < 4; ++m) {
                    const float r = __shfl(rs[ai], 16 * m + fr);
                    bf16* rowp = base + (size_t)(row0 + ai * 128 + m * 16) * 512 + colt;
#pragma unroll
                    for (int bj = 0; bj < 2; ++bj) {
                        f32x4 v0 = acc[ai][bj][m][0] * r, v1 = acc[ai][bj][m][1] * r;
                        if (act) {
#pragma unroll
                            for (int e = 0; e < 4; ++e) { v0[e] = silu(v0[e]); v1[e] = silu(v1[e]); }
                        }
                        u32x4 w; w.x = pk(v0[0], v0[1]); w.y = pk(v0[2], v0[3]); w.z = pk(v1[0], v1[1]); w.w = pk(v1[2], v1[3]);
                        *(u32x4*)(rowp + bj * 128) = w;
                    }
                }
        }
    }
};


template <bool SECOND> struct EpiMerge {
    static constexpr bool PERM = true, AFTER_DRAIN = false;
    bf16* merged; const bf16* gates;
    __device__ __forceinline__ void operator()(const f32x4 (&acc)[2][2][4][2], const pg8::Unit& un, int wr, int wc, int fr, int fq) const {
        const int col0 = un.pn * 256 + wc * 32 + 8 * fq, row0 = un.pm * 256 + wr * 64 + fr;
#pragma unroll
        for (int ai = 0; ai < 2; ++ai)
#pragma unroll
            for (int m = 0; m < 4; ++m) {
                const size_t row = (size_t)(row0 + ai * 128 + m * 16);
#pragma unroll
                for (int bj = 0; bj < 2; ++bj) {
                    const u32x4 gw = *(const u32x4*)(gates + row * NGATE + (SECOND ? 1024 : 0) + col0 + bj * 128);
                    const f32x4 a0 = acc[ai][bj][m][0], a1 = acc[ai][bj][m][1];
                    float o[8];
                    o[0] = bflo(gw.x) * a0[0]; o[1] = bfhi(gw.x) * a0[1]; o[2] = bflo(gw.y) * a0[2]; o[3] = bfhi(gw.y) * a0[3];
                    o[4] = bflo(gw.z) * a1[0]; o[5] = bfhi(gw.z) * a1[1]; o[6] = bflo(gw.w) * a1[2]; o[7] = bfhi(gw.w) * a1[3];
                    bf16* mp = merged + row * D + col0 + bj * 128;
                    if (SECOND) {
                        const u32x4 ow = *(const u32x4*)mp;
                        o[0] += bflo(ow.x); o[1] += bfhi(ow.x); o[2] += bflo(ow.y); o[3] += bfhi(ow.y);
                        o[4] += bflo(ow.z); o[5] += bfhi(ow.z); o[6] += bflo(ow.w); o[7] += bfhi(ow.w);
                    }
                    u32x4 w; w.x = pk(o[0], o[1]); w.y = pk(o[2], o[3]); w.z = pk(o[4], o[5]); w.w = pk(o[6], o[7]);
                    *(u32x4*)mp = w;
                }
            }
    }
};

template <bool LAST> struct EpiRes {
    static constexpr bool PERM = true, AFTER_DRAIN = false;
    float* out; bf16* xb; float* ssq;
    __device__ __forceinline__ void operator()(const f32x4 (&acc)[2][2][4][2], const pg8::Unit& un, int wr, int wc, int fr, int fq) const {
        const int col0 = un.pn * 256 + wc * 32 + 8 * fq, row0 = un.pm * 256 + wr * 64 + fr;
#pragma unroll
        for (int ai = 0; ai < 2; ++ai)
#pragma unroll
            for (int m = 0; m < 4; ++m) {
                const size_t row = (size_t)(row0 + ai * 128 + m * 16);
                float s = 0.f;
#pragma unroll
                for (int bj = 0; bj < 2; ++bj) {
                    const size_t p = row * D + col0 + bj * 128;
                    const u32x4 bw = *(const u32x4*)(xb + p);
                    const f32x4 x0 = (f32x4){bflo(bw.x), bfhi(bw.x), bflo(bw.y), bfhi(bw.y)} + acc[ai][bj][m][0], x1 = (f32x4){bflo(bw.z), bfhi(bw.z), bflo(bw.w), bfhi(bw.w)} + acc[ai][bj][m][1];
                    s += (x0[0] * x0[0] + x0[1] * x0[1]) + (x0[2] * x0[2] + x0[3] * x0[3]) + (x1[0] * x1[0] + x1[1] * x1[1]) + (x1[2] * x1[2] + x1[3] * x1[3]);
                    if (LAST) { *(f32x4*)(out + p) = x0; *(f32x4*)(out + p + 4) = x1; }
                    else { u32x4 w; w.x = pk(x0[0], x0[1]); w.y = pk(x0[2], x0[3]); w.z = pk(x1[0], x1[1]); w.w = pk(x1[2], x1[3]); *(u32x4*)(xb + p) = w; }
                }
                s += __shfl_xor(s, 16); s += __shfl_xor(s, 32);
                if (fq == 0) ssq[row * 16 + un.pn * 4 + wc] = s;
            }
    }
};

struct EpiUpConv {
    static constexpr bool PERM = false, AFTER_DRAIN = false;
    bf16* act; bf16* hbnd; const float* ssq; const float* cw; const float* cb;
    __device__ __forceinline__ void operator()(f32x4 (&acc)[2][2][4][2], const pg8::Unit& un, int wr, int wc, int fr, int fq) const {
        const int lane = fr + 16 * fq;
        {
            const float rs0 = load_rs(ssq, un.pm * 256 + 128 * wr, lane), rs1 = load_rs(ssq, un.pm * 256 + 128 * wr + 64, lane);
#pragma unroll
            for (int j = 0; j < 8; ++j) { const int src = (8 * fr + j) & 63; const float a = __shfl(rs0, src), b = __shfl(rs1, src); const float r = fr < 8 ? a : b;
#pragma unroll
                for (int bj = 0; bj < 2; ++bj)
#pragma unroll
                    for (int n = 0; n < 2; ++n) acc[j >> 2][bj][j & 3][n] *= r; }
        }
        const size_t tok0 = (size_t)un.pm * 256 + 128 * wr + 8 * fr;
        const int blk = un.pm * 2 + wr;
#pragma unroll
        for (int n = 0; n < 2; ++n) {
            const int ch0 = un.pn * 128 + wc * 32 + 16 * n + 4 * fq;
            if (fr == 15) {
                bf16* hb = hbnd + ((size_t)(blk * 4 + 2) * 2) * DFF + ch0;
                const f32x4 hv6 = acc[1][0][2][n], hv7 = acc[1][0][3][n], hg6 = acc[1][1][2][n], hg7 = acc[1][1][3][n];
                *(u32x2*)(hb) = (u32x2){pk(hv6[0], hv6[1]), pk(hv6[2], hv6[3])}; *(u32x2*)(hb + DFF) = (u32x2){pk(hg6[0], hg6[1]), pk(hg6[2], hg6[3])};
                *(u32x2*)(hb + 2 * DFF) = (u32x2){pk(hv7[0], hv7[1]), pk(hv7[2], hv7[3])}; *(u32x2*)(hb + 3 * DFF) = (u32x2){pk(hg7[0], hg7[1]), pk(hg7[2], hg7[3])};
            }
            if (fr == 0) {
#pragma unroll
                for (int j = 0; j < 2; ++j) { bf16* hb = hbnd + ((size_t)(blk * 4 + j) * 2) * DFF + ch0; const f32x4 hv = acc[0][0][j][n], hg = acc[0][1][j][n];
                    *(u32x2*)(hb) = (u32x2){pk(hv[0], hv[1]), pk(hv[2], hv[3])}; *(u32x2*)(hb + DFF) = (u32x2){pk(hg[0], hg[1]), pk(hg[2], hg[3])}; }
            }
#pragma unroll
            for (int bj = 0; bj < 2; ++bj) {
                const float* cwp = cw + bj * DFF + ch0;
                const f32x4 w0 = *(const f32x4*)(cwp), w1 = *(const f32x4*)(cwp + NUP), w2 = *(const f32x4*)(cwp + 2 * NUP), bb = *(const f32x4*)(cb + bj * DFF + ch0);
                f32x4 m2, m1;
#pragma unroll
                for (int e = 0; e < 4; ++e) { m2[e] = dpp_shr1(acc[1][bj][2][n][e]); m1[e] = dpp_shr1(acc[1][bj][3][n][e]); }
#pragma unroll
                for (int j = 7; j >= 0; --j) {
                    const f32x4 h0 = acc[j >> 2][bj][j & 3][n];
                    const f32x4 hm1 = j >= 1 ? acc[(j - 1 + 8) % 8 >> 2][bj][(j - 1 + 8) % 8 & 3][n] : m1;
                    const f32x4 hm2 = j >= 2 ? acc[(j - 2 + 8) % 8 >> 2][bj][(j - 2 + 8) % 8 & 3][n] : (j == 1 ? m1 : m2);
                    acc[j >> 2][bj][j & 3][n] = w2 * h0 + w1 * hm1 + w0 * hm2 + bb;
                }
            }
#pragma unroll
            for (int j = 0; j < 8; ++j) {
                const f32x4 vc = acc[j >> 2][0][j & 3][n], gc = acc[j >> 2][1][j & 3][n];
                f32x4 a;
#pragma unroll
                for (int e = 0; e < 4; ++e) a[e] = vc[e] * silu(gc[e]);
                if (!(j < 2 && fr == 0)) *(u32x2*)(act + (tok0 + j) * DFF + ch0) = (u32x2){pk(a[0], a[1]), pk(a[2], a[3])};
            }
        }
    }
};

struct Args { const float* in[17]; float* out; unsigned char* ws; int ph_lo, ph_hi; };

struct TrItem { const float* W; const float* rscale; bf16* WT; int K, N, drow0, k0, n0; };
__device__ __forceinline__ void tr_load(const TrItem& t, int lane, float (&wv)[32]) {
#pragma unroll
    for (int i = 0; i < 32; ++i) { const int kk = 2 * i + (lane >> 5); wv[i] = t.W[(size_t)(t.k0 + kk) * t.N + t.n0 + (lane & 31)]; }
    if (t.rscale) {
#pragma unroll
        for (int i = 0; i < 32; ++i) wv[i] *= t.rscale[t.k0 + 2 * i + (lane >> 5)];
    }
}
__device__ __forceinline__ void tr_store(const TrItem& t, int lane, const float (&wv)[32], LAS float* scr) {
#pragma unroll
    for (int i = 0; i < 32; ++i) scr[(2 * i + (lane >> 5)) * 33 + (lane & 31)] = wv[i];
    LDS_WAIT(); asm volatile("" ::: "memory");
    const int c = lane & 7;
#pragma unroll
    for (int j = 0; j < 4; ++j) { const int n = (lane >> 3) + 8 * j; const LAS float* sp = scr + (8 * c) * 33 + n;
        u32x4 o; o.x = pk(sp[0 * 33], sp[1 * 33]); o.y = pk(sp[2 * 33], sp[3 * 33]); o.z = pk(sp[4 * 33], sp[5 * 33]); o.w = pk(sp[6 * 33], sp[7 * 33]);
        *(u32x4*)(t.WT + (size_t)(t.drow0 + n) * t.K + t.k0 + 8 * c) = o; }
    LDS_WAIT(); asm volatile("" ::: "memory");
}
constexpr int I_IN = (D / 64) * (IN_COLS / 32), I_PB = (HW / 64) * (D / 32), I_O = (D / 64) * (D / 32), I_UP = (D / 64) * (NUP / 32), I_DN = (DFF / 64) * (D / 32);
constexpr int I_LAYER = I_IN + I_PB + I_O + I_UP + I_DN;
__device__ __forceinline__ TrItem tr_decode(const Args& a, int it) {
    const int l = it / I_LAYER; int r = it % I_LAYER;
    unsigned char* wl = a.ws + WS_W + (size_t)l * W_LAYER;
    TrItem t;
    if (r < I_IN) { const int nb = IN_COLS / 32; t.k0 = 64 * (r / nb); t.n0 = 32 * (r % nb); t.W = a.in[2] + (size_t)l * D * IN_COLS; t.K = D; t.N = IN_COLS; t.rscale = a.in[1] + l * D; t.WT = (bf16*)(wl + WO_IN); t.drow0 = t.n0; return t; }
    r -= I_IN;
    if (r < I_PB) { const int nb = D / 32; t.k0 = 64 * (r / nb); t.n0 = 32 * (r % nb); t.W = a.in[9] + (size_t)l * HW * D; t.K = HW; t.N = D; t.rscale = nullptr; t.WT = (bf16*)(wl + WO_PB); t.drow0 = t.n0; return t; }
    r -= I_PB;
    if (r < I_O) { const int nb = D / 32; t.k0 = 64 * (r / nb); t.n0 = 32 * (r % nb); t.W = a.in[10] + (size_t)l * D * D; t.K = D; t.N = D; t.rscale = nullptr; t.WT = (bf16*)(wl + WO_O); t.drow0 = t.n0; return t; }
    r -= I_O;
    if (r < I_UP) { const int nb = NUP / 32; t.k0 = 64 * (r / nb); t.n0 = 32 * (r % nb); t.W = a.in[12] + (size_t)l * D * NUP; t.K = D; t.N = NUP; t.rscale = a.in[11] + l * D; t.WT = (bf16*)(wl + WO_UP);
        const int bjs = t.n0 / DFF, rr = t.n0 % DFF; t.drow0 = 256 * (rr / 128) + 128 * bjs + (rr % 128); return t; }
    r -= I_UP;
    { const int nb = D / 32; t.k0 = 64 * (r / nb); t.n0 = 32 * (r % nb); t.W = a.in[15] + (size_t)l * DFF * D; t.K = DFF; t.N = D; t.rscale = nullptr; t.WT = (bf16*)(wl + WO_DN); t.drow0 = t.n0; return t; }
}

__device__ __forceinline__ void phase_prologue(const Args& a, LAS unsigned char* lds, int G) {
    int tid = threadIdx.x; asm volatile("" : "+v"(tid));
    const int lane = tid & 63, wave = __builtin_amdgcn_readfirstlane(tid >> 6);
    unsigned char* ws = a.ws;
    const float *x = a.in[0], *pool_w = a.in[4], *pool_scale = a.in[5], *lb_logits = a.in[6], *w_pa = a.in[8];
    LAS float* scr = (LAS float*)(lds + wave * 16384);
    const int gw = blockIdx.x * NWAVES + wave, NGW = G * NWAVES;
    for (int it = gw; it < DEPTH * I_LAYER; it += 2 * NGW) {
        const bool two = it + NGW < DEPTH * I_LAYER;
        const TrItem t0 = tr_decode(a, it), t1 = tr_decode(a, two ? it + NGW : it);
        float w0[32], w1[32];
        tr_load(t0, lane, w0); if (two) tr_load(t1, lane, w1);
        tr_store(t0, lane, w0, scr); if (two) tr_store(t1, lane, w1, scr);
    }
    for (int gt = blockIdx.x * NTHREADS + tid; gt < DEPTH * 65536; gt += G * NTHREADS) {
        const int l = __builtin_amdgcn_readfirstlane(gt >> 16), rem = gt & 65535, d = rem & 1023, cg8 = __builtin_amdgcn_readfirstlane(rem >> 10), gi = cg8 >> 4, c0 = (cg8 & 15) * 8;
        const float* pw = pool_w + ((size_t)(l * 4 + gi) * 128 + c0) * 128;
        const float* ps = pool_scale + l * PW + gi * 128;
        const float* wp = w_pa + ((size_t)l * PW + gi * 128) * D + d;
        LAS float* pwl = scr;
#pragma unroll
        for (int j = 0; j < 4; ++j) { const int e = j * 256 + lane * 4; const f32x4 v = *(const f32x4*)(pw + e) * *(const f32x4*)(ps + (e & 127)); *(LAS f32x4*)(pwl + e) = v; }
        LDS_WAIT(); asm volatile("" ::: "memory");
        float sacc[8];
#pragma unroll
        for (int i = 0; i < 8; ++i) sacc[i] = 0.f;
#pragma unroll 4
        for (int cp = 0; cp < 128; cp += 4) {
            const float w0 = wp[(size_t)cp * D], w1 = wp[(size_t)(cp + 1) * D], w2 = wp[(size_t)(cp + 2) * D], w3 = wp[(size_t)(cp + 3) * D];
#pragma unroll
            for (int i = 0; i < 8; ++i) { const f32x4 p = *(const LAS f32x4*)(pwl + i * 128 + cp); sacc[i] += (p[0] * w0 + p[1] * w1) + (p[2] * w2 + p[3] * w3); }
        }
        u32x4 o; o.x = pk(sacc[0], sacc[1]); o.y = pk(sacc[2], sacc[3]); o.z = pk(sacc[4], sacc[5]); o.w = pk(sacc[6], sacc[7]);
        *(u32x4*)((bf16*)(ws + WS_W + (size_t)l * W_LAYER + WO_A) + (size_t)d * PW + cg8 * 8) = o;
        LDS_WAIT(); asm volatile("" ::: "memory");
    }
    if (blockIdx.x == 0) {
        const int chn = tid;
        float mx = -1e30f;
        for (int l = 0; l < DEPTH; ++l) mx = fmaxf(mx, lb_logits[l * HW + chn]);
        float sum = 0.f;
        for (int l = 0; l < DEPTH; ++l) sum += expf(lb_logits[l * HW + chn] - mx);
        float cum = 0.f, c0v = 0.f;
        for (int l = 0; l < DEPTH; ++l) { cum += expf(lb_logits[l * HW + chn] - mx) / sum; if (l == 0) c0v = cum; ((float*)(ws + WS_LB))[l * HW + chn] = cum - c0v; }
    }
    bf16* xb = (bf16*)(ws + WS_XB); float* ssq = (float*)(ws + WS_SSQ);
    for (int m = gw; m < M; m += 2 * NGW) {
        const int m1 = m + NGW;
        const bool two = m1 < M;
        const f32x4* xr0 = (const f32x4*)(x + (size_t)m * D) + lane; const f32x4* xr1 = (const f32x4*)(x + (size_t)(two ? m1 : m) * D) + lane;
        f32x4 v0[4], v1[4]; float s0 = 0.f, s1 = 0.f;
#pragma unroll
        for (int j = 0; j < 4; ++j) { v0[j] = xr0[64 * j]; v1[j] = xr1[64 * j]; }
#pragma unroll
        for (int j = 0; j < 4; ++j) { s0 += (v0[j][0] * v0[j][0] + v0[j][1] * v0[j][1]) + (v0[j][2] * v0[j][2] + v0[j][3] * v0[j][3]); s1 += (v1[j][0] * v1[j][0] + v1[j][1] * v1[j][1]) + (v1[j][2] * v1[j][2] + v1[j][3] * v1[j][3]); }
        s0 = wave_sum(s0); s1 = wave_sum(s1);
        u32x2* o0 = (u32x2*)(xb + (size_t)m * D) + lane;
#pragma unroll
        for (int j = 0; j < 4; ++j) o0[64 * j] = (u32x2){pk(v0[j][0], v0[j][1]), pk(v0[j][2], v0[j][3])};
        if (lane < 16) ssq[(size_t)m * 16 + lane] = lane == 0 ? s0 : 0.f;
        if (two) {
            u32x2* o1 = (u32x2*)(xb + (size_t)m1 * D) + lane;
#pragma unroll
            for (int j = 0; j < 4; ++j) o1[64 * j] = (u32x2){pk(v1[j][0], v1[j][1]), pk(v1[j][2], v1[j][3])};
            if (lane < 16) ssq[(size_t)m1 * 16 + lane] = lane == 0 ? s1 : 0.f;
        }
    }
}

__device__ __forceinline__ void phase_fir(const bf16* u, bf16* pooled, int G) {
    int tid = threadIdx.x; asm volatile("" : "+v"(tid));
    for (int item = blockIdx.x * NTHREADS + tid; item < (M / 8) * 64; item += G * NTHREADS) {
        const int cgp = item & 63, run = item >> 6, m0 = run * 8, ts = m0 & (SEQ - 1), w = 2 << (cgp >> 4);
        const bf16* up = u + (size_t)m0 * PW + cgp * 8;
        float s[8];
#pragma unroll
        for (int i = 0; i < 8; ++i) s[i] = 0.f;
        for (int d = 1; d < w; ++d) if (ts - d >= 0) {
            const u32x4 x = *(const u32x4*)(up - (size_t)d * PW);
            s[0] += bflo(x.x); s[1] += bfhi(x.x); s[2] += bflo(x.y); s[3] += bfhi(x.y); s[4] += bflo(x.z); s[5] += bfhi(x.z); s[6] += bflo(x.w); s[7] += bfhi(x.w);
        }
#pragma unroll
        for (int r = 0; r < 8; ++r) {
            const u32x4 x = *(const u32x4*)(up + (size_t)r * PW);
            float c[8] = {bflo(x.x), bfhi(x.x), bflo(x.y), bfhi(x.y), bflo(x.z), bfhi(x.z), bflo(x.w), bfhi(x.w)};
#pragma unroll
            for (int i = 0; i < 8; ++i) s[i] += c[i];
            const int cnt = (ts + r + 1) < w ? (ts + r + 1) : w; const float inv = 1.f / (float)cnt;
            u32x4 o; o.x = pk(s[0] * inv - c[0], s[1] * inv - c[1]); o.y = pk(s[2] * inv - c[2], s[3] * inv - c[3]);
            o.z = pk(s[4] * inv - c[4], s[5] * inv - c[5]); o.w = pk(s[6] * inv - c[6], s[7] * inv - c[7]);
            *(u32x4*)(pooled + (size_t)(m0 + r) * PW + cgp * 8) = o;
            if (ts + r - w + 1 >= 0) {
                const u32x4 y = *(const u32x4*)(up + ((ptrdiff_t)r - w + 1) * PW);
                s[0] -= bflo(y.x); s[1] -= bfhi(y.x); s[2] -= bflo(y.y); s[3] -= bfhi(y.y); s[4] -= bflo(y.z); s[5] -= bfhi(y.z); s[6] -= bflo(y.w); s[7] -= bfhi(y.w);
            }
        }
    }
}

__device__ __forceinline__ u32x4 pack_lo8(const unsigned (&v)[8]) { u32x4 o; o.x = (v[0] & 0xffffu) | (v[1] << 16); o.y = (v[2] & 0xffffu) | (v[3] << 16); o.z = (v[4] & 0xffffu) | (v[5] << 16); o.w = (v[6] & 0xffffu) | (v[7] << 16); return o; }
__device__ __forceinline__ u32x4 pack_hi8(const unsigned (&v)[8]) { u32x4 o; o.x = (v[0] >> 16) | (v[1] & 0xffff0000u); o.y = (v[2] >> 16) | (v[3] & 0xffff0000u); o.z = (v[4] >> 16) | (v[5] & 0xffff0000u); o.w = (v[6] >> 16) | (v[7] & 0xffff0000u); return o; }

#define WG_BAR() do { asm volatile("s_waitcnt lgkmcnt(0)" ::: "memory"); __builtin_amdgcn_s_barrier(); asm volatile("" ::: "memory"); } while (0)
__device__ __forceinline__ void phase_h1(LAS unsigned char* lds, const float* g, const bf16* vb, bf16* UT, float* dec, int G) {
    int tid = threadIdx.x; asm volatile("" : "+v"(tid));
    const int lane = tid & 63, w = __builtin_amdgcn_readfirstlane(tid >> 6), r16 = lane & 15, q4 = lane >> 4;
    LAS unsigned char* KT = lds; LAS unsigned char* VT = lds + 18432; LAS float* SEG = (LAS float*)(lds + 36864);
    f32x2 gg[8]; unsigned vv[8];
    int unit = blockIdx.x;
    if (unit < NUNIT) {
        const int bh = unit >> 7, c = unit & 127, b = bh >> 2, h = bh & 3;
        const size_t m0 = (size_t)b * SEQ + c * CH + 8 * w; const int col = h * HD + 2 * lane;
#pragma unroll
        for (int r = 0; r < 8; ++r) { gg[r] = *(const f32x2*)(g + (m0 + r) * HW + col); vv[r] = *(const unsigned*)(vb + (m0 + r) * HW + col); }
    }
    for (; unit < NUNIT; unit += G) {
        f32x2 cs[8]; cs[0] = gg[0];
#pragma unroll
        for (int r = 1; r < 8; ++r) cs[r] = cs[r - 1] + gg[r];
        *(LAS f32x2*)(SEG + w * 128 + 2 * lane) = cs[7];
        *(LAS u32x4*)(VT + (2 * lane) * 144 + w * 16) = pack_lo8(vv); *(LAS u32x4*)(VT + (2 * lane + 1) * 144 + w * 16) = pack_hi8(vv);
        WG_BAR();
        f32x2 pre = {0.f, 0.f}, tot = {0.f, 0.f};
#pragma unroll
        for (int j = 0; j < 8; ++j) { const f32x2 sg = *(const LAS f32x2*)(SEG + j * 128 + 2 * lane); tot += sg; if (j < w) pre += sg; }
        unsigned kt[8];
#pragma unroll
        for (int r = 0; r < 8; ++r) { const f32x2 bb = pre + cs[r];
            kt[r] = pk((1.f - __expf(gg[r].x)) * __expf(tot.x - bb.x), (1.f - __expf(gg[r].y)) * __expf(tot.y - bb.y)); }
        *(LAS u32x4*)(KT + (2 * lane) * 144 + w * 16) = pack_lo8(kt); *(LAS u32x4*)(KT + (2 * lane + 1) * 144 + w * 16) = pack_hi8(kt);
        if (w == 0) *(f32x2*)(dec + (size_t)unit * HD + 2 * lane) = (f32x2){__expf(tot.x), __expf(tot.y)};
        const int nu = unit + G;
        if (nu < NUNIT) {
            const int bh = nu >> 7, c = nu & 127, b = bh >> 2, h = bh & 3;
            const size_t m0 = (size_t)b * SEQ + c * CH + 8 * w; const int col = h * HD + 2 * lane;
#pragma unroll
            for (int r = 0; r < 8; ++r) { gg[r] = *(const f32x2*)(g + (m0 + r) * HW + col); vv[r] = *(const unsigned*)(vb + (m0 + r) * HW + col); }
        }
        WG_BAR();
        bf16x8 yv[2];
#pragma unroll
        for (int ks = 0; ks < 2; ++ks) yv[ks] = *(const LAS bf16x8*)(VT + (16 * w + r16) * 144 + ks * 64 + q4 * 16);
        bf16* ut = UT + (size_t)unit * (HD * HD) + (size_t)(16 * w + r16) * HD + 4 * q4;
#pragma unroll
        for (int nb = 0; nb < 8; ++nb) {
            f32x4 a = {0.f, 0.f, 0.f, 0.f};
#pragma unroll
            for (int ks = 0; ks < 2; ++ks) { const bf16x8 xk = *(const LAS bf16x8*)(KT + (16 * nb + r16) * 144 + ks * 64 + q4 * 16); a = __builtin_amdgcn_mfma_f32_16x16x32_bf16(xk, yv[ks], a, 0, 0, 0); }
            *(u32x2*)(ut + 16 * nb) = (u32x2){pk(a[0], a[1]), pk(a[2], a[3])};
        }
        WG_BAR();
    }
}

__device__ __forceinline__ void phase_h2(bf16* UT, const float* dec, int G) {
    int tid = threadIdx.x; asm volatile("" : "+v"(tid));
    for (int e = blockIdx.x * NTHREADS + tid; e < NBH * HD * HD; e += G * NTHREADS) {
        const int bh = e >> 14, idx = e & 16383, k = idx & 127;
        bf16* up = UT + (size_t)bh * NCH * (HD * HD) + idx; const float* dp = dec + (size_t)bh * NCH * HD + k;
        float S = 0.f;
        for (int c0 = 0; c0 < NCH; c0 += 16) {
            bf16 uu[16]; float dd[16];
#pragma unroll
            for (int i = 0; i < 16; ++i) { uu[i] = up[(size_t)(c0 + i) * (HD * HD)]; dd[i] = dp[(size_t)(c0 + i) * HD]; }
#pragma unroll
            for (int i = 0; i < 16; ++i) { up[(size_t)(c0 + i) * (HD * HD)] = (bf16)(pk(S, 0.f) & 0xffffu); S = dd[i] * S + __uint_as_float((unsigned)uu[i] << 16); }
        }
    }
}

__device__ __forceinline__ void phase_h3(LAS unsigned char* lds, const bf16* qb, const float* g, const bf16* vb, const bf16* sob, const bf16* ST, const float* ng, bf16* hg, int G) {
    constexpr int SR = 272;
    int tid = threadIdx.x; asm volatile("" : "+v"(tid));
    const int lane = tid & 63, w = __builtin_amdgcn_readfirstlane(tid >> 6), r16 = lane & 15, q4 = lane >> 4;
    LAS unsigned char* QH = lds; LAS unsigned char* QD = lds + 17408; LAS unsigned char* KD = lds + 34816; LAS unsigned char* KE = lds + 52224; LAS unsigned char* QO = lds + 69632;
    LAS unsigned char* VT = lds + 95744; LAS float* SEG = (LAS float*)(lds + 114176); LAS float* RMS = (LAS float*)(lds + 118272);
    const int bi = w >> 1, odd = w & 1;
    f32x2 gg[8]; unsigned qq[8], vv[8];
    int unit = blockIdx.x;
    if (unit < NUNIT) {
        const int bh = unit >> 7, c = unit & 127, b = bh >> 2, h = bh & 3;
        const size_t m0 = (size_t)b * SEQ + c * CH + 8 * w; const int col = h * HD + 2 * lane;
#pragma unroll
        for (int r = 0; r < 8; ++r) { gg[r] = *(const f32x2*)(g + (m0 + r) * HW + col); qq[r] = *(const unsigned*)(qb + (m0 + r) * HW + col); vv[r] = *(const unsigned*)(vb + (m0 + r) * HW + col); }
    }
    for (; unit < NUNIT; unit += G) {
        const int bh = unit >> 7, c = unit & 127, b = bh >> 2, h = bh & 3;
        const size_t mu = (size_t)b * SEQ + c * CH;
        const bf16* STu = ST + (size_t)unit * (HD * HD) + (size_t)(64 * odd + r16) * HD + q4 * 8;
        bf16x8 xs[4][4];
#pragma unroll
        for (int ks = 0; ks < 4; ++ks)
#pragma unroll
            for (int nb = 0; nb < 4; ++nb) xs[ks][nb] = *(const bf16x8*)(STu + (size_t)(16 * nb) * HD + ks * 32);
        const size_t row = mu + 16 * bi + r16;
        u32x2 sv[4]; f32x4 ngv[4];
#pragma unroll
        for (int nb = 0; nb < 4; ++nb) { const int v0 = 64 * odd + 16 * nb + 4 * q4; ngv[nb] = *(const f32x4*)(ng + v0); sv[nb] = *(const u32x2*)(sob + row * HW + h * HD + v0); }
        f32x2 cs[8]; cs[0] = gg[0];
#pragma unroll
        for (int r = 1; r < 8; ++r) cs[r] = cs[r - 1] + gg[r];
        *(LAS f32x2*)(SEG + w * 128 + 2 * lane) = cs[7];
        *(LAS u32x4*)(VT + (2 * lane) * 144 + w * 16) = pack_lo8(vv); *(LAS u32x4*)(VT + (2 * lane + 1) * 144 + w * 16) = pack_hi8(vv);
        WG_BAR();
        f32x2 pre = {0.f, 0.f};
        for (int j = 0; j < w; ++j) pre += *(const LAS f32x2*)(SEG + j * 128 + 2 * lane);
        const f32x2 cmid = *(const LAS f32x2*)(SEG + (2 * bi) * 128 + 2 * lane);
        const f32x2 bsum = cmid + *(const LAS f32x2*)(SEG + (2 * bi + 1) * 128 + 2 * lane);
        f32x2 bsm1 = {0.f, 0.f}, bsm2 = {0.f, 0.f};
        if (bi >= 1) bsm1 = *(const LAS f32x2*)(SEG + (2 * bi - 2) * 128 + 2 * lane) + *(const LAS f32x2*)(SEG + (2 * bi - 1) * 128 + 2 * lane);
        if (bi >= 2) bsm2 = bsm1 + *(const LAS f32x2*)(SEG + (2 * bi - 4) * 128 + 2 * lane) + *(const LAS f32x2*)(SEG + (2 * bi - 3) * 128 + 2 * lane);
        const f32x2 cbase = odd ? cmid : (f32x2){0.f, 0.f};
        const int pbase = (bi * (bi - 1)) / 2;
#pragma unroll
        for (int r = 0; r < 8; ++r) {
            const int t = 8 * w + r, tl = 8 * odd + r;
            const f32x2 cl = cbase + cs[r], bf = pre + cs[r];
            const float qx = bflo(qq[r]), qy = bfhi(qq[r]);
            const float kx = 1.f - __expf(gg[r].x), ky = 1.f - __expf(gg[r].y);
            *(LAS unsigned*)(QH + t * SR + 4 * lane) = pk(qx * __expf(bf.x), qy * __expf(bf.y));
            *(LAS unsigned*)(QD + t * SR + 4 * lane) = pk(qx * __expf(fminf(cl.x - cmid.x, 80.f)), qy * __expf(fminf(cl.y - cmid.y, 80.f)));
            *(LAS unsigned*)(KD + t * SR + 4 * lane) = pk(kx * __expf(fminf(cmid.x - cl.x, 80.f)), ky * __expf(fminf(cmid.y - cl.y, 80.f)));
            if (bi < 3) *(LAS unsigned*)(KE + t * SR + 4 * lane) = pk(kx * __expf(bsum.x - cl.x), ky * __expf(bsum.y - cl.y));
            if (bi >= 1) *(LAS unsigned*)(QO + ((pbase + bi - 1) * 16 + tl) * SR + 4 * lane) = pk(qx * __expf(cl.x), qy * __expf(cl.y));
            if (bi >= 2) *(LAS unsigned*)(QO + ((pbase + bi - 2) * 16 + tl) * SR + 4 * lane) = pk(qx * __expf(cl.x + bsm1.x), qy * __expf(cl.y + bsm1.y));
            if (bi >= 3) *(LAS unsigned*)(QO + ((pbase + 0) * 16 + tl) * SR + 4 * lane) = pk(qx * __expf(cl.x + bsm2.x), qy * __expf(cl.y + bsm2.y));
        }
        WG_BAR();
        { const int nu = unit + G;
          if (nu < NUNIT) {
            const int bh2 = nu >> 7, c2 = nu & 127, b2 = bh2 >> 2, h2 = bh2 & 3;
            const size_t m0 = (size_t)b2 * SEQ + c2 * CH + 8 * w; const int col = h2 * HD + 2 * lane;
#pragma unroll
            for (int r = 0; r < 8; ++r) { gg[r] = *(const f32x2*)(g + (m0 + r) * HW + col); qq[r] = *(const unsigned*)(qb + (m0 + r) * HW + col); vv[r] = *(const unsigned*)(vb + (m0 + r) * HW + col); }
          } }
        const int i = bi, vh = odd;
        f32x4 acc[4];
#pragma unroll
        for (int nb = 0; nb < 4; ++nb) acc[nb] = (f32x4){0.f, 0.f, 0.f, 0.f};
#pragma unroll
        for (int ks = 0; ks < 4; ++ks) {
            const bf16x8 y = *(const LAS bf16x8*)(QH + (16 * i + r16) * SR + ks * 64 + q4 * 16);
#pragma unroll
            for (int nb = 0; nb < 4; ++nb) acc[nb] = __builtin_amdgcn_mfma_f32_16x16x32_bf16(xs[ks][nb], y, acc[nb], 0, 0, 0);
        }
#pragma unroll
        for (int jp = 0; jp < 2; ++jp) {
            if (2 * jp <= i) {
                f32x4 p[2];
#pragma unroll
                for (int jj = 0; jj < 2; ++jj) {
                    const int j = 2 * jp + jj;
                    p[jj] = (f32x4){0.f, 0.f, 0.f, 0.f};
                    if (j <= i) {
                        const LAS unsigned char* Kb = (j == i ? KD : KE) + (16 * j + r16) * SR + q4 * 16;
                        const LAS unsigned char* Qb = (j == i ? QD + (16 * i + r16) * SR : QO + ((pbase + j) * 16 + r16) * SR) + q4 * 16;
#pragma unroll
                        for (int ks = 0; ks < 4; ++ks) { const bf16x8 xk = *(const LAS bf16x8*)(Kb + ks * 64); const bf16x8 yq = *(const LAS bf16x8*)(Qb + ks * 64); p[jj] = __builtin_amdgcn_mfma_f32_16x16x32_bf16(xk, yq, p[jj], 0, 0, 0); }
                        if (j == i) {
#pragma unroll
                            for (int e = 0; e < 4; ++e) if (4 * q4 + e > r16) p[jj][e] = 0.f;
                        }
                    }
                }
                u32x4 ypw; ypw.x = pk(p[0][0], p[0][1]); ypw.y = pk(p[0][2], p[0][3]); ypw.z = pk(p[1][0], p[1][1]); ypw.w = pk(p[1][2], p[1][3]);
                const bf16x8 yp = __builtin_bit_cast(bf16x8, ypw);
#pragma unroll
                for (int nb = 0; nb < 4; ++nb) {
                    const LAS unsigned char* vp = VT + (64 * vh + 16 * nb + r16) * 144 + (32 * jp + 4 * q4) * 2;
                    const u32x2 lo = *(const LAS u32x2*)vp, hi = *(const LAS u32x2*)(vp + 32);
                    const u32x4 xw = {lo.x, lo.y, hi.x, hi.y};
                    acc[nb] = __builtin_amdgcn_mfma_f32_16x16x32_bf16(__builtin_bit_cast(bf16x8, xw), yp, acc[nb], 0, 0, 0);
                }
            }
        }
        float ss = 0.f;
#pragma unroll
        for (int nb = 0; nb < 4; ++nb) ss += (acc[nb][0] * acc[nb][0] + acc[nb][1] * acc[nb][1]) + (acc[nb][2] * acc[nb][2] + acc[nb][3] * acc[nb][3]);
        ss += __shfl_xor(ss, 16); ss += __shfl_xor(ss, 32);
        if (q4 == 0) RMS[(16 * i + r16) * 2 + vh] = ss;
        WG_BAR();
        const float rstd = rsqrtf((RMS[(16 * i + r16) * 2] + RMS[(16 * i + r16) * 2 + 1]) * (1.f / HD) + EPS);
#pragma unroll
        for (int nb = 0; nb < 4; ++nb) {
            const int v0 = 64 * vh + 16 * nb + 4 * q4;
            const f32x4 o = acc[nb] * rstd * ngv[nb];
            *(u32x2*)(hg + row * HW + h * HD + v0) = (u32x2){pk(o[0] * bflo(sv[nb].x), o[1] * bfhi(sv[nb].x)), pk(o[2] * bflo(sv[nb].y), o[3] * bfhi(sv[nb].y))};
        }
        WG_BAR();
    }
}

__device__ __forceinline__ f32x4 bf4(u32x2 v) { return (f32x4){bflo(v.x), bfhi(v.x), bflo(v.y), bfhi(v.y)}; }
__device__ __forceinline__ void ffn_fixup(int pm, const bf16* hbnd, const float* cw, const float* cb, bf16* act) {
    int tid = threadIdx.x; asm volatile("" : "+v"(tid));
    for (int idx = tid; idx < DFF / 4; idx += NTHREADS) {
        const int c4 = idx * 4;
        const f32x4 wv0 = *(const f32x4*)(cw + c4), wv1 = *(const f32x4*)(cw + NUP + c4), wv2 = *(const f32x4*)(cw + 2 * NUP + c4), bv = *(const f32x4*)(cb + c4);
        const f32x4 wg0 = *(const f32x4*)(cw + DFF + c4), wg1 = *(const f32x4*)(cw + NUP + DFF + c4), wg2 = *(const f32x4*)(cw + 2 * NUP + DFF + c4), bg = *(const f32x4*)(cb + DFF + c4);
        u32x2 hv[2][4], hg[2][4];
#pragma unroll
        for (int bb = 0; bb < 2; ++bb) {
            const int blk = 2 * pm + bb; const bool first = (blk & 63) == 0;
#pragma unroll
            for (int k = 0; k < 4; ++k) {
                const int sb = k < 2 ? blk - 1 : blk, slot = k < 2 ? k + 2 : k - 2;
                const bf16* p = hbnd + ((size_t)(sb * 4 + slot) * 2) * DFF + c4;
                if (k < 2 && first) { hv[bb][k] = (u32x2){0u, 0u}; hg[bb][k] = (u32x2){0u, 0u}; }
                else { hv[bb][k] = *(const u32x2*)p; hg[bb][k] = *(const u32x2*)(p + DFF); }
            }
        }
#pragma unroll
        for (int bb = 0; bb < 2; ++bb)
#pragma unroll
            for (int dl = 0; dl < 2; ++dl) {
                const f32x4 vc = wv2 * bf4(hv[bb][2 + dl]) + wv1 * bf4(hv[bb][1 + dl]) + wv0 * bf4(hv[bb][dl]) + bv;
                const f32x4 gc = wg2 * bf4(hg[bb][2 + dl]) + wg1 * bf4(hg[bb][1 + dl]) + wg0 * bf4(hg[bb][dl]) + bg;
                f32x4 a;
#pragma unroll
                for (int e = 0; e < 4; ++e) a[e] = vc[e] * silu(gc[e]);
                *(u32x2*)(act + ((size_t)(2 * pm + bb) * 128 + dl) * DFF + c4) = (u32x2){pk(a[0], a[1]), pk(a[2], a[3])};
            }
    }
}

__device__ __forceinline__ void phase_final(const float* xf, float* out, const float* ssq, const float* fg, int G) {
    int tid = threadIdx.x; asm volatile("" : "+v"(tid));
    const int lane = tid & 63, wave = tid >> 6;
    for (int m = blockIdx.x * NWAVES + wave; m < M; m += G * NWAVES) {
        const f32x4* sp = (const f32x4*)(ssq + (size_t)m * 16);
        const f32x4 s = (sp[0] + sp[1]) + (sp[2] + sp[3]);
        const float rstd = rsqrtf(((s[0] + s[1]) + (s[2] + s[3])) * (1.f / D) + EPS);
        const f32x4* xr = (const f32x4*)(xf + (size_t)m * D) + lane; f32x4* orow = (f32x4*)(out + (size_t)m * D) + lane; const f32x4* gr = (const f32x4*)fg + lane;
#pragma unroll
        for (int j = 0; j < 4; ++j) orow[64 * j] = xr[64 * j] * rstd * gr[64 * j];
    }
}


#ifndef DEBUG_SCAN
#define DEBUG_SCAN 0
#endif
__device__ __forceinline__ void scan_bf16(const bf16* p, size_t n, int* flags, int code, int G) {
    int tid = threadIdx.x; asm volatile("" : "+v"(tid));
    const u32x4* q = (const u32x4*)p; const size_t n16 = n / 8; bool bad = false, huge = false;
    for (size_t i = (size_t)blockIdx.x * NTHREADS + tid; i < n16; i += (size_t)G * NTHREADS) { const u32x4 w = q[i];
#pragma unroll
        for (int e = 0; e < 4; ++e) { const unsigned x = w[e]; if ((x & 0x7f80u) == 0x7f80u || (x & 0x7f800000u) == 0x7f800000u) bad = true; if (fabsf(bflo(x)) > 1e4f || fabsf(bfhi(x)) > 1e4f) huge = true; } }
    if (bad) flags[code] = 1; if (huge) flags[64 + code] = 1;
}
__device__ __forceinline__ void scan_f32(const float* p, size_t n, int* flags, int code, int G) {
    int tid = threadIdx.x; asm volatile("" : "+v"(tid));
    bool bad = false, huge = false;
    for (size_t i = (size_t)blockIdx.x * NTHREADS + tid; i < n; i += (size_t)G * NTHREADS) { const unsigned x = __float_as_uint(p[i]); if ((x & 0x7f800000u) == 0x7f800000u) bad = true; if (fabsf(p[i]) > 1e4f) huge = true; }
    if (bad) flags[code] = 1; if (huge) flags[64 + code] = 1;
}
#define XB_TMO      128
#define XB_XCNT(j)  (256  + 64 * (j))
#define XB_XSUB(j)  (1280 + 64 * (j))
#define XB_XGEN(j)  (2304 + 64 * (j))
#define XB_TOP      3328
#define XB_TOPGEN   3392
#define XCD_BAR_WORDS 3456
#define XB_SPIN_CAP (1u << 18)

__device__ __forceinline__ unsigned xb_ld(unsigned* p)              { return __hip_atomic_load(p, __ATOMIC_RELAXED, __HIP_MEMORY_SCOPE_AGENT); }
__device__ __forceinline__ unsigned xb_add(unsigned* p, unsigned v) { return __hip_atomic_fetch_add(p, v, __ATOMIC_RELAXED, __HIP_MEMORY_SCOPE_AGENT); }
__device__ __forceinline__ unsigned xb_xcc_id() { return (unsigned)__builtin_amdgcn_s_getreg((3 << 11) | 20) & 0xFu; }
#define XB_SPIN(cond, bar) do { unsigned _sp = 0; while (cond) { __builtin_amdgcn_s_sleep(1); \
    if ((++_sp & 255u) == 0u) { if (xb_ld(&(bar)[XB_TMO])) break; if (_sp > XB_SPIN_CAP) { atomicAdd(&(bar)[XB_TMO], 1u); break; } } } } while (0)

struct XcdBarrier {
    unsigned* bar; unsigned x;
    volatile LAS unsigned* st;
};

__device__ __forceinline__ XcdBarrier xcd_barrier_post(unsigned* bar, volatile LAS unsigned* st) {
    XcdBarrier b; b.bar = bar; b.x = xb_xcc_id(); b.st = st;
    if (threadIdx.x == 0) (void)xb_add(&bar[XB_XCNT(b.x)], 1u);
    return b;
}
__device__ __forceinline__ void xcd_barrier_complete(unsigned* bar, unsigned x, unsigned& nloc, unsigned& nx) {
    const unsigned G = gridDim.x * gridDim.y * gridDim.z;
    unsigned sum, cnt, mine, sp = 0u;
    for (;;) {
        sum = 0u; cnt = 0u; mine = 0u;
#pragma unroll
        for (unsigned j = 0; j < 16; ++j) { const unsigned c = xb_ld(&bar[XB_XCNT(j)]); sum += c; cnt += (c > 0u) ? 1u : 0u; mine = (j == x) ? c : mine; }
        if (sum == G) break;
        __builtin_amdgcn_s_sleep(1);
        if ((++sp & 255u) == 0u) { if (xb_ld(&bar[XB_TMO])) break; if (sp > XB_SPIN_CAP) { atomicAdd(&bar[XB_TMO], 1u); break; } }
    }
    nloc = mine > 0u ? mine : 1u; nx = cnt > 0u ? cnt : 1u;
}

__device__ __forceinline__ void xcd_barrier(const XcdBarrier& b) {
    asm volatile("s_waitcnt vmcnt(0)" ::: "memory");
    __syncthreads();
    if (threadIdx.x == 0) {
        unsigned* bar = b.bar;
        __builtin_amdgcn_s_waitcnt(0);
        unsigned nloc = b.st[0], nx = b.st[1];
        if (nloc == 0u) { xcd_barrier_complete(bar, b.x, nloc, nx); b.st[0] = nloc; b.st[1] = nx; }
        const unsigned old = xb_add(&bar[XB_XSUB(b.x)], 1u);
        const unsigned gen = old / nloc;
        if (old + 1u == (gen + 1u) * nloc) {
            __builtin_amdgcn_fence(__ATOMIC_RELEASE, "agent");
            asm volatile("s_waitcnt vmcnt(0)" ::: "memory");
            const unsigned og = xb_add(&bar[XB_TOP], 1u);
            const unsigned tg = og / nx;
            if (og + 1u == (tg + 1u) * nx) xb_add(&bar[XB_TOPGEN], 1u);
            else XB_SPIN(xb_ld(&bar[XB_TOPGEN]) == tg, bar);
            __builtin_amdgcn_fence(__ATOMIC_ACQUIRE, "agent");
            xb_add(&bar[XB_XGEN(b.x)], 1u);
            asm volatile("s_waitcnt vmcnt(0)" ::: "memory");
        } else {
            XB_SPIN(xb_ld(&bar[XB_XGEN(b.x)]) == gen, bar);
            __builtin_amdgcn_fence(__ATOMIC_ACQUIRE, "agent");
            asm volatile("s_waitcnt vmcnt(0)" ::: "memory");
        }
    }
    __syncthreads();
}

#ifndef ONE_LAUNCH
#define ONE_LAUNCH 1
#endif
constexpr int PH_PER_LAYER = 9, N_PHASES = 1 + DEPTH * PH_PER_LAYER + 1;

__global__ void __launch_bounds__(NTHREADS, 2) trunk_fwd(Args args) {
    extern __shared__ __attribute__((aligned(16))) unsigned char lds_raw[];
    LAS unsigned char* lds = (LAS unsigned char*)lds_raw;
    cg::grid_group grid = cg::this_grid();
    const int G = gridDim.x;
    unsigned char* ws = args.ws;
    float* out = args.out;
    const int lo = args.ph_lo, hi = args.ph_hi;
    float* ssq = (float*)(ws + WS_SSQ); float* dec = (float*)(ws + WS_DEC); bf16* hbnd = (bf16*)(ws + WS_HBND); bf16* xb = (bf16*)(ws + WS_XB);
    bf16 *ub = (bf16*)(ws + WS_U), *hgb = (bf16*)(ws + WS_HG), *qb = (bf16*)(ws + WS_Q), *vb = (bf16*)(ws + WS_V), *sob = (bf16*)(ws + WS_SO), *pooled = (bf16*)(ws + WS_POOL);
    bf16 *UT = (bf16*)(ws + WS_UT), *gates = (bf16*)(ws + WS_GATES), *merged = (bf16*)(ws + WS_MERGED), *act = (bf16*)(ws + WS_ACT);
    float* gl = (float*)(ws + WS_G);
#ifndef PHASE_MASK
#define PHASE_MASK 0xfff
#endif
#define EN(j) (((PHASE_MASK) >> (j)) & 1)
#define IN(k) (lo <= (k) && (k) < hi)
#define SC(k) (DEBUG_SCAN && lo == (k) && hi == (k) - 1)
    volatile LAS unsigned* MISC = (volatile LAS unsigned*)(lds + 131072 + 512);
    { int t_ = threadIdx.x; asm volatile("" : "+v"(t_)); if (t_ < 32) MISC[t_] = 0u; }
    __syncthreads();
    XcdBarrier bar = xcd_barrier_post((unsigned*)(ws + WS_BAR), MISC + 8);
#ifndef PROBE_A
#define PROBE_A -1
#define PROBE_B -1
#endif
    unsigned long long* tsb = (unsigned long long*)(ws + 4096);
#define STAMP(k) do { if (PROBE_A >= 0 && blockIdx.x == 0) { int t_ = threadIdx.x; asm volatile("" : "+v"(t_)); if (t_ == 0) tsb[(k)] = __builtin_amdgcn_s_memrealtime(); } } while (0)
#define SEAM(k) do { if (IN(k) && IN((k) + 1)) { if ((k) == 0) grid.sync(); else xcd_barrier(bar); } STAMP((k) + 1); } while (0)
    STAMP(0);

    int* dbg = (int*)ws;
    if (EN(9) && IN(0)) { if (DEBUG_SCAN && blockIdx.x == 0) { int t_ = threadIdx.x; asm volatile("" : "+v"(t_)); if (t_ < 128) dbg[t_] = 0; } phase_prologue(args, lds, G); }
    SEAM(0);
    for (int l = 0; l < DEPTH; ++l) {
        const int pb = 1 + l * PH_PER_LAYER;
        unsigned char* wl = ws + WS_W + (size_t)l * W_LAYER;
        const bf16* Win = (const bf16*)(wl + WO_IN);
        if (EN(0) && IN(pb + 0)) {
            pg8::Gemm g{xb, Win, M, NMIX, D}; pg8::StaticOrder S; S.init(M, NMIX, G, (int)blockIdx.x);
            EpiInMix E{ub, qb, vb, sob, gl, ssq, (const float*)(ws + WS_LB) + l * HW, gates, args.in[3] + l * NGATE, 0};
            pg8::gemm_phase<EpiInMix, pg8::StaticOrder, true, true>(lds, g, S, E);
        }
        SEAM(pb + 0);
        if (SC(pb + 1)) { const int cb_ = 20 * l; scan_bf16(ub, (size_t)M * 512, dbg, cb_ + 1, G); scan_bf16(qb, (size_t)M * 512, dbg, cb_ + 2, G); scan_bf16(vb, (size_t)M * 512, dbg, cb_ + 3, G); scan_bf16(sob, (size_t)M * 512, dbg, cb_ + 4, G); scan_f32(gl, (size_t)M * 512, dbg, cb_ + 5, G); }
        if (EN(1) && IN(pb + 1)) { phase_fir(ub, pooled, G); phase_h1(lds, gl, vb, UT, dec, G); }
        SEAM(pb + 1);
        if (SC(pb + 2)) { const int cb_ = 20 * l; scan_bf16(pooled, (size_t)M * 512, dbg, cb_ + 6, G); scan_bf16(UT, (size_t)NUNIT * 16384, dbg, cb_ + 7, G); scan_f32(dec, (size_t)NUNIT * 128, dbg, cb_ + 8, G); }
        if (EN(2) && IN(pb + 2)) phase_h2(UT, dec, G);
        SEAM(pb + 2);
        if (SC(pb + 3)) { scan_bf16(UT, (size_t)NUNIT * 16384, dbg, 20 * l + 9, G); }
        if (EN(3) && IN(pb + 3)) phase_h3(lds, qb, gl, vb, sob, UT, args.in[7] + l * HD, hgb, G);
        SEAM(pb + 3);
        if (SC(pb + 4)) { scan_bf16(gates, (size_t)M * 2048, dbg, 20 * l + 11, G); }
        if (EN(4) && IN(pb + 4)) {
            pg8::Gemm g{xb, Win + (size_t)NMIX * D, M, NGATE, D}; pg8::StaticOrder S; S.init(M, NGATE, G, (int)blockIdx.x);
            EpiInMix E{ub, qb, vb, sob, gl, ssq, (const float*)(ws + WS_LB) + l * HW, gates, args.in[3] + l * NGATE, 10};
            pg8::gemm_phase<EpiInMix, pg8::StaticOrder, true, true>(lds, g, S, E);
        }
        SEAM(pb + 4);
        if (EN(5) && IN(pb + 5)) {
            { pg8::Gemm g{pooled, (const bf16*)(wl + WO_A), M, D, PW}; pg8::StaticOrder S; S.init(M, D, G, (int)blockIdx.x);
              EpiMerge<false> E{merged, gates};
              pg8::gemm_phase<EpiMerge<false>, pg8::StaticOrder, true, true>(lds, g, S, E); }
            VM_WAIT(); __syncthreads();
            { pg8::Gemm g{hgb, (const bf16*)(wl + WO_PB), M, D, HW}; pg8::StaticOrder S; S.init(M, D, G, (int)blockIdx.x);
              EpiMerge<true> E{merged, gates};
              pg8::gemm_phase<EpiMerge<true>, pg8::StaticOrder, true, true>(lds, g, S, E); }
        }
        SEAM(pb + 5);
        if (SC(pb + 6)) { scan_bf16(merged, (size_t)M * 1024, dbg, 20 * l + 12, G); }
        if (EN(6) && IN(pb + 6)) {
            pg8::Gemm g{merged, (const bf16*)(wl + WO_O), M, D, D}; pg8::StaticOrder S; S.init(M, D, G, (int)blockIdx.x);
            EpiRes<false> E{out, xb, ssq};
            pg8::gemm_phase<EpiRes<false>, pg8::StaticOrder, true, true>(lds, g, S, E);
        }
        SEAM(pb + 6);
        if (SC(pb + 7)) { scan_f32(out, (size_t)M * 1024, dbg, 20 * l + 13, G); scan_bf16(xb, (size_t)M * 1024, dbg, 20 * l + 14, G); scan_f32(ssq, (size_t)M * 16, dbg, 20 * l + 15, G); }
        if (EN(7) && IN(pb + 7)) {
            pg8::Gemm g{xb, (const bf16*)(wl + WO_UP), M, NUP, D}; pg8::StaticOrder S; S.init(M, NUP, G, (int)blockIdx.x);
            EpiUpConv E{act, hbnd, ssq, args.in[13] + (size_t)l * 3 * NUP, args.in[14] + (size_t)l * NUP};
            pg8::gemm_phase<EpiUpConv, pg8::StaticOrder, true, true, true>(lds, g, S, E);
        }
        SEAM(pb + 7);
        if (SC(pb + 8)) { scan_bf16(act, (size_t)M * DFF, dbg, 20 * l + 16, G); scan_bf16(hbnd, (size_t)128 * 4 * 2 * DFF, dbg, 20 * l + 17, G); }
        if (EN(8) && IN(pb + 8)) {
            pg8::StaticOrder S; S.init(M, D, G, (int)blockIdx.x);
            pg8::Unit un;
            for (int i = 0; S.next(i, un); ++i) ffn_fixup(un.pm, hbnd, args.in[13] + (size_t)l * 3 * NUP, args.in[14] + (size_t)l * NUP, act);
            VM_WAIT(); __builtin_amdgcn_fence(__ATOMIC_ACQ_REL, "agent"); __syncthreads();
            pg8::Gemm g{act, (const bf16*)(wl + WO_DN), M, D, DFF};
            if (l == DEPTH - 1) { EpiRes<true> E{(float*)(ws + WS_XF), xb, ssq}; pg8::gemm_phase<EpiRes<true>, pg8::StaticOrder, true, true>(lds, g, S, E); }
            else { EpiRes<false> E{out, xb, ssq}; pg8::gemm_phase<EpiRes<false>, pg8::StaticOrder, true, true>(lds, g, S, E); }
        }
        SEAM(pb + 8);
    }
    if (SC(N_PHASES - 1)) {
        scan_f32(out, (size_t)M * 1024, dbg, 58, G); scan_f32(ssq, (size_t)M * 16, dbg, 59, G);
        __syncthreads();
    }
    if (EN(10) && IN(N_PHASES - 1)) phase_final((const float*)(ws + WS_XF), out, ssq, args.in[16], G);
    if (DEBUG_SCAN && IN(N_PHASES)) {
        int t_ = threadIdx.x; asm volatile("" : "+v"(t_));
        int c1 = -1, c2 = -1; for (int i = 63; i >= 0; --i) { if (dbg[i]) c1 = i; if (dbg[64 + i]) c2 = i; }
        const float cval = 100.f * (float)(c2 + 2);
        for (size_t i = (size_t)blockIdx.x * NTHREADS + t_; i < (size_t)M * D; i += (size_t)G * NTHREADS) out[i] = (i == 0) ? 1e4f * (float)(c1 + 1) : cval;
    }
    if (PROBE_A >= 0 && blockIdx.x == 0) {
        int t_ = threadIdx.x; asm volatile("" : "+v"(t_));
        if (t_ == 0) {
            STAMP(N_PHASES);
            __builtin_amdgcn_fence(__ATOMIC_ACQ_REL, "agent");
            const unsigned long long da = tsb[PROBE_A + 1] - tsb[PROBE_A], db = PROBE_B >= 0 ? tsb[PROBE_B + 1] - tsb[PROBE_B] : 0ull;
            const unsigned long long spin = 4ull * da + 204800ull * (db / 3200ull);
            const unsigned long long t0 = __builtin_amdgcn_s_memrealtime();
            while (__builtin_amdgcn_s_memrealtime() - t0 < spin) __builtin_amdgcn_s_sleep(32);
        }
    }
#undef IN
#undef SEAM
}

extern "C" void kernel_launch(void* const* d_in, const int* in_sizes, int n_in, void* d_out, int out_size, void* d_ws, size_t ws_size, hipStream_t stream) {
    static int grid = 0;
    if (grid == 0) {
        if (n_in != 17 || in_sizes[0] != M * D || out_size != M * D || ws_size < WS_END) { fprintf(stderr, "kernel_launch: unexpected shapes (n_in %d, in0 %d, out %d, ws %zu)\n", n_in, n_in > 0 ? in_sizes[0] : -1, out_size, ws_size); grid = -1; return; }
        int dev = 0, cus = 0, per_cu = 0;
        hipGetDevice(&dev); hipDeviceGetAttribute(&cus, hipDeviceAttributeMultiprocessorCount, dev);
        if (hipFuncSetAttribute((const void*)trunk_fwd, hipFuncAttributeMaxDynamicSharedMemorySize, LDS_BYTES) != hipSuccess) { fprintf(stderr, "kernel_launch: hipFuncSetAttribute failed\n"); grid = -1; return; }
        if (hipOccupancyMaxActiveBlocksPerMultiprocessor(&per_cu, (const void*)trunk_fwd, NTHREADS, LDS_BYTES) != hipSuccess || per_cu < 1) { fprintf(stderr, "kernel_launch: occupancy query says %d\n", per_cu); per_cu = 1; }
        (void)hipGetLastError();
        grid = cus * 1;
        fprintf(stderr, "kernel_launch: grid %d (cus %d, per_cu %d)\n", grid, cus, per_cu);
    }
    if (grid < 0) return;
    Args a{};
    for (int i = 0; i < 17; ++i) a.in[i] = (const float*)d_in[i];
    a.out = (float*)d_out; a.ws = (unsigned char*)d_ws;
#if ONE_LAUNCH
    if (hipMemsetAsync((char*)d_ws + WS_BAR, 0, BAR_BYTES, stream) != hipSuccess) { fprintf(stderr, "kernel_launch: memset failed\n"); return; }
    a.ph_lo = 0; a.ph_hi = N_PHASES;
    void* kargs[] = {&a};
    hipError_t e = hipLaunchCooperativeKernel((const void*)trunk_fwd, dim3(grid), dim3(NTHREADS), kargs, LDS_BYTES, stream);
    if (e != hipSuccess) fprintf(stderr, "kernel_launch: cooperative launch failed: %s (grid %d)\n", hipGetErrorString(e), grid);
#else
    for (int p = 0; p < N_PHASES + (DEBUG_SCAN ? 1 : 0); ++p) {
        if (DEBUG_SCAN && p > 0 && p < N_PHASES) { a.ph_lo = p; a.ph_hi = p - 1; hipLaunchKernelGGL(trunk_fwd, dim3(grid), dim3(NTHREADS), LDS_BYTES, stream, a); }
        a.ph_lo = p; a.ph_hi = p + 1;
        hipLaunchKernelGGL(trunk_fwd, dim3(grid), dim3(NTHREADS), LDS_BYTES, stream, a);
    }
#endif
}
```

```cpp
#include <hip/hip_runtime.h>
#include <hip/hip_cooperative_groups.h>
#include <cstdio>
#include <cstdint>
namespace cg = cooperative_groups;
namespace pg8 {
#define PG8_LAS __attribute__((address_space(3)))
typedef unsigned short bf16_t;
typedef short bf16x8 __attribute__((ext_vector_type(8)));
typedef float f32x4 __attribute__((ext_vector_type(4)));
typedef unsigned u32x4 __attribute__((ext_vector_type(4)));
constexpr int BM = 256, BK = 64, HALF = 128, HTB = HALF * BK * 2  , STAGE_BYTES = 8 * HTB, NXCD = 8, WGM = 8;

__host__ __device__ __forceinline__ int lds_byte(int r, int c) { const int st = (r >> 4) * 2 + (c >> 5), rr = r & 15, cc = c & 31, ob = rr * 64 + cc * 2; return st * 1024 + (ob ^ (((ob >> 9) & 1) << 5)); }
__host__ __device__ __forceinline__ void stage_rc(int b, int& R, int& C) { const int st = b / 1024, sb = b % 1024, swz = sb ^ (((sb >> 9) & 1) << 5); R = (st >> 1) * 16 + swz / 64; C = (st & 1) * 32 + (swz % 64) / 2; }
__host__ __device__ __forceinline__ int perm32(int rho) { const int n = rho >> 4, i = rho & 15; return 8 * (i >> 2) + 4 * n + (i & 3); }

struct Unit { int pm, pn; };
struct Gemm { const bf16_t* A; const bf16_t* Bt; int M, N, K; };

struct StaticOrder {
    int nM, nN, nwg, G, c;
    __host__ __device__ void init(int M, int N, int G_, int c_) { nM = M / BM; nN = N / BM; nwg = nM * nN; G = G_; c = c_; }
    __host__ __device__ bool next(int i, Unit& u) const {
        const long L = (long)i * G + c; if (L >= nwg) return false;
        int wgid = (int)L; { const int q = nwg / NXCD, r = nwg % NXCD, xcd = wgid % NXCD, off = wgid / NXCD; wgid = (xcd < r ? xcd * (q + 1) : r * (q + 1) + (xcd - r) * q) + off; }
        const int nig = WGM * nN, gid = wgid / nig, fm = gid * WGM, gsz = (nM - fm) < WGM ? (nM - fm) : WGM;
        u.pm = fm + ((wgid % nig) % gsz); u.pn = (wgid % nig) / gsz; return true;
    }
    __device__ __forceinline__ void a_ready(const Unit&) const {}
    __device__ __forceinline__ void done(const Unit&) const {}
};

__device__ __forceinline__ unsigned cvt_pk_bf16(float lo, float hi) { unsigned r; asm volatile("v_cvt_pk_bf16_f32 %0, %1, %2" : "=v"(r) : "v"(lo), "v"(hi)); return r; }
typedef float f32x2 __attribute__((ext_vector_type(2)));
template <class Epi, class Sched, bool ALIGN_EPI = false, bool SP2 = false, bool ROWPERM = false>
__device__ __forceinline__ void gemm_phase(PG8_LAS unsigned char* lds, const Gemm g, const Sched& S, const Epi& E) {
    int tid = threadIdx.x; asm volatile("" : "+v"(tid));
    const int wid = __builtin_amdgcn_readfirstlane(tid >> 6), lane = tid & 63, wr = wid >> 2, wc = wid & 3, fr = lane & 15, fq = lane >> 4;
    const int K = g.K, nt = K / BK;
    unsigned voffA[2], voffB[2];
#pragma unroll
    for (int i = 0; i < 2; ++i) { int R, C; stage_rc(tid * 16 + i * 8192, R, C); const int Rb = Epi::PERM ? ((R & ~31) + perm32(R & 31)) : R;
        const int Ra = ROWPERM ? (128 * (R >> 6) + 8 * (R & 15) + ((R >> 4) & 3)) : R;
        voffA[i] = (unsigned)(Ra * K + C) * 2u; voffB[i] = (unsigned)(Rb * K + C) * 2u; }
    const size_t kstep = (size_t)(BK * 2);
    const size_t hstep = (size_t)HALF * K * 2;
    const size_t hstepA = ROWPERM ? (size_t)4 * K * 2 : hstep;
    const size_t tstep = 2 * hstep;
    const unsigned ldsw = (unsigned)wid * 1024u;
    const int aoff = lds_byte(wr * 64 + fr, fq * 8), boff = lds_byte(wc * 32 + fr, fq * 8);
#define PG8_SA(b, h) (((b) * 2 + (h)) * HTB)
#define PG8_SB(b, h) ((4 + (b) * 2 + (h)) * HTB)
#define PG8_STAGE(bufoff, gbase, voff) do { _Pragma("unroll") for (int _i = 0; _i < 2; ++_i) \
        __builtin_amdgcn_global_load_lds((const unsigned*)((const char*)(gbase) + (voff)[_i]), (PG8_LAS unsigned*)(lds + (bufoff) + ldsw + _i * 8192), 16, 0, 0); } while (0)
#define PG8_LDA(dst, b, h) do { _Pragma("unroll") for (int m = 0; m < 4; ++m) _Pragma("unroll") for (int k = 0; k < 2; ++k) dst[m][k] = *(const PG8_LAS bf16x8*)(lds + PG8_SA(b, h) + aoff + m * 2048 + k * 1024); } while (0)
#define PG8_LDB(dst, b, h) do { _Pragma("unroll") for (int n = 0; n < 2; ++n) _Pragma("unroll") for (int k = 0; k < 2; ++k) dst[n][k] = *(const PG8_LAS bf16x8*)(lds + PG8_SB(b, h) + boff + n * 2048 + k * 1024); } while (0)
#define PG8_MMA(ai, bj, At, Bt) do { __builtin_amdgcn_s_setprio(1); _Pragma("unroll") for (int m = 0; m < 4; ++m) _Pragma("unroll") for (int n = 0; n < 2; ++n) _Pragma("unroll") for (int k = 0; k < 2; ++k) \
        acc[ai][bj][m][n] = __builtin_amdgcn_mfma_f32_16x16x32_bf16(Bt[n][k], At[m][k], acc[ai][bj][m][n], 0, 0, 0); __builtin_amdgcn_s_setprio(0); } while (0)
#define PG8_WAIT_V(n) asm volatile("s_waitcnt vmcnt(" #n ")" ::: "memory")
#define PG8_WAIT_L(n) asm volatile("s_waitcnt lgkmcnt(" #n ")" ::: "memory")
#define PG8_BAR __builtin_amdgcn_s_barrier()
#define PG8_SCHED __builtin_amdgcn_sched_barrier(0)
    Unit cur, nxt; int ui = 0;
    if (!S.next(0, cur)) return;
    f32x4 acc[2][2][4][2];
#pragma unroll
    for (int a = 0; a < 2; ++a)
#pragma unroll
        for (int b = 0; b < 2; ++b)
#pragma unroll
            for (int m = 0; m < 4; ++m)
#pragma unroll
                for (int n = 0; n < 2; ++n) acc[a][b][m][n] = (f32x4){0.f, 0.f, 0.f, 0.f};
    bf16x8 At[4][2], B0[2][2], B1[2][2];
    const char* cA = (const char*)g.A + (size_t)cur.pm * tstep; const char* cB = (const char*)g.Bt + (size_t)cur.pn * tstep;
    S.a_ready(cur);
    if constexpr (SP2) {
        PG8_STAGE(PG8_SB(0, 0), cB, voffB); PG8_STAGE(PG8_SB(0, 1), cB + hstep, voffB); PG8_STAGE(PG8_SA(0, 0), cA, voffA); PG8_STAGE(PG8_SA(0, 1), cA + hstepA, voffA);
        if (wr == 1) PG8_BAR;
        PG8_WAIT_V(2); PG8_BAR;
        PG8_STAGE(PG8_SB(1, 0), cB + kstep, voffB); PG8_STAGE(PG8_SA(1, 0), cA + kstep, voffA); PG8_STAGE(PG8_SB(1, 1), cB + hstep + kstep, voffB);
        PG8_WAIT_V(6); PG8_BAR;
    } else {
        PG8_STAGE(PG8_SB(0, 0), cB, voffB); PG8_STAGE(PG8_SA(0, 0), cA, voffA); PG8_STAGE(PG8_SB(0, 1), cB + hstep, voffB); PG8_STAGE(PG8_SA(0, 1), cA + hstepA, voffA);
        if (wr == 1) PG8_BAR;
        PG8_WAIT_V(4); PG8_BAR;
        PG8_STAGE(PG8_SB(1, 0), cB + kstep, voffB); PG8_STAGE(PG8_SA(1, 0), cA + kstep, voffA); PG8_STAGE(PG8_SB(1, 1), cB + hstep + kstep, voffB);
        PG8_WAIT_V(6); PG8_BAR;
    }
    for (;;) {
        const bool has_next = S.next(ui + 1, nxt);
        const char* nA = has_next ? (const char*)g.A + (size_t)nxt.pm * tstep : cA; const char* nB = has_next ? (const char*)g.Bt + (size_t)nxt.pn * tstep : cB;
        for (int t = 0; t < nt; t += 2) {
            const bool last = (t == nt - 2);
            const char* a1 = cA + (size_t)(t + 1) * kstep;
            const char* a2 = last ? nA : cA + (size_t)(t + 2) * kstep; const char* b2 = last ? nB : cB + (size_t)(t + 2) * kstep;
            const char* a3 = a2 + kstep; const char* b3 = b2 + kstep;
            if (last && has_next) S.a_ready(nxt);
            if constexpr (SP2) {
            PG8_LDB(B0, 0, 0); PG8_LDB(B1, 0, 1); PG8_SCHED; PG8_LDA(At, 0, 0); PG8_STAGE(PG8_SA(1, 1), a1 + hstepA, voffA);
            PG8_WAIT_V(8); PG8_WAIT_L(0); PG8_BAR; PG8_MMA(0, 0, At, B0); PG8_MMA(0, 1, At, B1); PG8_BAR; PG8_SCHED;
            PG8_LDA(At, 0, 1); PG8_STAGE(PG8_SB(0, 0), b2, voffB); PG8_STAGE(PG8_SB(0, 1), b2 + hstep, voffB); PG8_STAGE(PG8_SA(0, 0), a2, voffA);
            PG8_WAIT_V(8); PG8_WAIT_L(0); PG8_BAR; PG8_MMA(1, 0, At, B0); PG8_MMA(1, 1, At, B1); PG8_BAR; PG8_SCHED;
            PG8_LDB(B0, 1, 0); PG8_LDB(B1, 1, 1); PG8_SCHED; PG8_LDA(At, 1, 0); PG8_STAGE(PG8_SA(0, 1), a2 + hstepA, voffA);
            PG8_WAIT_V(8); PG8_WAIT_L(0); PG8_BAR; PG8_MMA(0, 0, At, B0); PG8_MMA(0, 1, At, B1); PG8_BAR; PG8_SCHED;
            PG8_LDA(At, 1, 1); PG8_STAGE(PG8_SB(1, 0), b3, voffB); PG8_STAGE(PG8_SB(1, 1), b3 + hstep, voffB); PG8_STAGE(PG8_SA(1, 0), a3, voffA);
            PG8_WAIT_V(8); PG8_WAIT_L(0); PG8_BAR; PG8_MMA(1, 0, At, B0); PG8_MMA(1, 1, At, B1); PG8_BAR; PG8_SCHED;
            } else {
            PG8_LDB(B0, 0, 0); PG8_SCHED; PG8_LDA(At, 0, 0); PG8_STAGE(PG8_SA(1, 1), a1 + hstepA, voffA);
            PG8_WAIT_L(8); PG8_BAR; PG8_WAIT_L(0); PG8_MMA(0, 0, At, B0); PG8_BAR; PG8_SCHED;
            PG8_LDB(B1, 0, 1); PG8_STAGE(PG8_SB(0, 0), b2, voffB);
            PG8_BAR; PG8_WAIT_L(0); PG8_MMA(0, 1, At, B1); PG8_BAR;
            PG8_LDA(At, 0, 1); PG8_STAGE(PG8_SA(0, 0), a2, voffA);
            PG8_BAR; PG8_WAIT_L(0); PG8_MMA(1, 0, At, B0); PG8_BAR; PG8_SCHED;
            PG8_STAGE(PG8_SB(0, 1), b2 + hstep, voffB);
            PG8_WAIT_V(6); PG8_BAR; PG8_MMA(1, 1, At, B1); PG8_BAR;
            PG8_LDB(B0, 1, 0); PG8_SCHED; PG8_LDA(At, 1, 0); PG8_STAGE(PG8_SA(0, 1), a2 + hstepA, voffA);
            PG8_WAIT_L(8); PG8_BAR; PG8_WAIT_L(0); PG8_MMA(0, 0, At, B0); PG8_BAR; PG8_SCHED;
            PG8_LDB(B1, 1, 1); PG8_STAGE(PG8_SB(1, 0), b3, voffB);
            PG8_BAR; PG8_WAIT_L(0); PG8_MMA(0, 1, At, B1); PG8_BAR;
            PG8_LDA(At, 1, 1); PG8_STAGE(PG8_SA(1, 0), a3, voffA);
            PG8_BAR; PG8_WAIT_L(0); PG8_MMA(1, 0, At, B0); PG8_BAR; PG8_SCHED;
            PG8_STAGE(PG8_SB(1, 1), b3 + hstep, voffB);
            PG8_WAIT_V(6); PG8_BAR; PG8_MMA(1, 1, At, B1); PG8_BAR;
            }
        }
        if constexpr (ALIGN_EPI) { if (wr == 0) PG8_BAR; }
        if constexpr (!Epi::AFTER_DRAIN) { E(acc, cur, wr, wc, fr, fq); S.done(cur); }
        if (!has_next) break;
#pragma unroll
        for (int a = 0; a < 2; ++a)
#pragma unroll
            for (int b = 0; b < 2; ++b)
#pragma unroll
                for (int m = 0; m < 4; ++m)
#pragma unroll
                    for (int n = 0; n < 2; ++n) acc[a][b][m][n] = (f32x4){0.f, 0.f, 0.f, 0.f};
        cur = nxt; cA = nA; cB = nB; ++ui;
        if constexpr (ALIGN_EPI) { if (wr == 1) PG8_BAR; }
    }
    PG8_WAIT_V(0);
    if constexpr (!ALIGN_EPI) { if (wr == 0) PG8_BAR; }
    PG8_BAR;
    if constexpr (Epi::AFTER_DRAIN) { E.fused(acc, cur, wr, wc, fr, fq, lds, wid, lane); S.done(cur); }
#undef PG8_SA
#undef PG8_SB
#undef PG8_STAGE
#undef PG8_LDA
#undef PG8_LDB
#undef PG8_MMA
#undef PG8_WAIT_V
#undef PG8_WAIT_L
#undef PG8_BAR
#undef PG8_SCHED
}
}

constexpr int BATCH = 2, SEQ = 8192, D = 1024, M = BATCH * SEQ, DEPTH = 2;
constexpr int PW = 512, HW = 512, NH = 4, HD = 128, CH = 64, NCH = SEQ / CH, NBH = BATCH * NH, NUNIT = NBH * NCH;
constexpr int IN_COLS = 4608, NMIX = 2560, NGATE = 2048, DFF = 2816, NUP = 2 * DFF;
constexpr float EPS = 1e-6f;
constexpr int NWAVES = 8, NTHREADS = 512;
constexpr int LDS_BYTES = 147456;

constexpr size_t MiB = 1u << 20;
constexpr size_t WS_BAR = 512 * 1024, BAR_BYTES = 16384;
constexpr size_t WS_SSQ = 1 * MiB;
constexpr size_t WS_DEC = 2 * MiB;
constexpr size_t WS_LB = 2 * MiB + 768 * 1024;
constexpr size_t WS_HBND = 3 * MiB;
constexpr size_t WS_W = 9 * MiB, W_LAYER = 29 * MiB + 512 * 1024;
constexpr size_t WO_IN = 0, WO_A = 9 * MiB, WO_PB = 10 * MiB, WO_O = 11 * MiB, WO_UP = 13 * MiB, WO_DN = 24 * MiB;
constexpr size_t WS_XB = 68 * MiB;
constexpr size_t WS_R = 100 * MiB;
constexpr size_t WS_U = WS_R, WS_HG = WS_R, WS_Q = WS_R + 16 * MiB, WS_V = WS_R + 32 * MiB, WS_SO = WS_R + 48 * MiB, WS_G = WS_R + 64 * MiB;
constexpr size_t WS_POOL = WS_R + 96 * MiB, WS_UT = WS_R + 112 * MiB, WS_GATES = WS_R + 16 * MiB, WS_MERGED = WS_R + 112 * MiB, WS_ACT = WS_R;
constexpr size_t WS_XF = WS_R + 88 * MiB;
constexpr size_t WS_END = 256 * MiB;
static_assert(WS_UT + 32 * MiB <= WS_END && WS_ACT + (size_t)M * DFF * 2 <= WS_END && WS_GATES + 64 * MiB <= WS_POOL, "ws map");

#define LAS __attribute__((address_space(3)))
typedef unsigned short bf16;
typedef unsigned u32x4 __attribute__((ext_vector_type(4)));
typedef unsigned u32x2 __attribute__((ext_vector_type(2)));
typedef float f32x4 __attribute__((ext_vector_type(4)));
typedef float f32x2 __attribute__((ext_vector_type(2)));
typedef short bf16x8 __attribute__((ext_vector_type(8)));

__device__ __forceinline__ float bflo(unsigned w) { return __uint_as_float(w << 16); }
__device__ __forceinline__ float bfhi(unsigned w) { return __uint_as_float(w & 0xffff0000u); }
typedef __bf16 bf16x2_t __attribute__((ext_vector_type(2)));
__device__ __forceinline__ unsigned pk(float lo, float hi) { const bf16x2_t v = __builtin_convertvector((f32x2){lo, hi}, bf16x2_t); return __builtin_bit_cast(unsigned, v); }
__device__ __forceinline__ float sigm(float x) { return 1.f / (1.f + __expf(-x)); }
__device__ __forceinline__ float silu(float x) { return x * sigm(x); }
__device__ __forceinline__ float wave_sum(float v) {
#pragma unroll
    for (int o = 1; o < 64; o <<= 1) v += __shfl_xor(v, o);
    return v;
}
__device__ __forceinline__ float dpp_shr1(float x) { return __int_as_float(__builtin_amdgcn_update_dpp(0, __float_as_int(x), 0x111, 0xf, 0xf, true)); }
#define LDS_WAIT() asm volatile("s_waitcnt lgkmcnt(0)" ::: "memory")
#define VM_WAIT() asm volatile("s_waitcnt vmcnt(0)" ::: "memory")

__device__ __forceinline__ float load_rs(const float* ssq, int row0, int lane) {
    const f32x4* p = (const f32x4*)(ssq + (size_t)(row0 + lane) * 16);
    const f32x4 a = p[0], b = p[1], c = p[2], d = p[3];
    const f32x4 s = (a + b) + (c + d);
    return rsqrtf(((s[0] + s[1]) + (s[2] + s[3])) * (1.f / D) + EPS);
}

struct EpiInMix {
    static constexpr bool PERM = true, AFTER_DRAIN = false;
    bf16 *u, *q, *v, *so; bf16* g; const float* ssq; const float* lb; bf16* gates; const float* bgate; int pn_off;
    __device__ __forceinline__ void operator()(const f32x4 (&acc)[2][2][4][2], const pg8::Unit& un0, int wr, int wc, int fr, int fq) const {
        const int lane = fr + 16 * fq;
        pg8::Unit un = un0; un.pn += pn_off;
        float rs[2]; rs[0] = load_rs(ssq, un.pm * 256 + wr * 64, lane); rs[1] = load_rs(ssq, un.pm * 256 + 128 + wr * 64, lane);
        const int sec = un.pn >> 1, colt = (un.pn & 1) * 256 + wc * 32 + 8 * fq, row0 = un.pm * 256 + wr * 64 + fr;
        if (un.pn >= 10) {
            const int col0 = (un.pn - 10) * 256 + wc * 32 + 8 * fq;
            f32x4 bv[2][2];
#pragma unroll
            for (int bj = 0; bj < 2; ++bj)
#pragma unroll
                for (int n = 0; n < 2; ++n) bv[bj][n] = *(const f32x4*)(bgate + col0 + bj * 128 + 4 * n);
#pragma unroll
            for (int ai = 0; ai < 2; ++ai)
#pragma unroll
                for (int m = 0; m < 4; ++m) {
                    const float r = __shfl(rs[ai], 16 * m + fr);
                    bf16* rowp = gates + (size_t)(row0 + ai * 128 + m * 16) * NGATE + col0;
#pragma unroll
                    for (int bj = 0; bj < 2; ++bj) {
                        f32x4 v0 = acc[ai][bj][m][0] * r + bv[bj][0], v1 = acc[ai][bj][m][1] * r + bv[bj][1];
#pragma unroll
                        for (int e = 0; e < 4; ++e) { v0[e] = sigm(v0[e]); v1[e] = sigm(v1[e]); }
                        u32x4 w; w.x = pk(v0[0], v0[1]); w.y = pk(v0[2], v0[3]); w.z = pk(v1[0], v1[1]); w.w = pk(v1[2], v1[3]);
                        *(u32x4*)(rowp + bj * 128) = w;
                    }
                }
        } else if (sec == 2) {
            f32x4 lbv[2][2];
#pragma unroll
            for (int bj = 0; bj < 2; ++bj)
#pragma unroll
                for (int n = 0; n < 2; ++n) lbv[bj][n] = *(const f32x4*)(lb + colt + bj * 128 + 4 * n);
#pragma unroll
            for (int ai = 0; ai < 2; ++ai)
#pragma unroll
                for (int m = 0; m < 4; ++m) {
                    const float r = __shfl(rs[ai], 16 * m + fr);
                    bf16* rowp = g + (size_t)(row0 + ai * 128 + m * 16) * 512 + colt;
#pragma unroll
                    for (int bj = 0; bj < 2; ++bj) {
                        float o[8];
#pragma unroll
                        for (int n = 0; n < 2; ++n) { const f32x4 z = acc[ai][bj][m][n] * r;
#pragma unroll
                            for (int e = 0; e < 4; ++e) { const float l = lbv[bj][n][e]; o[4 * n + e] = __logf(l + (1.f - l) * sigm(z[e])); } }
                        u32x4 w; w.x = pk(o[0], o[1]); w.y = pk(o[2], o[3]); w.z = pk(o[4], o[5]); w.w = pk(o[6], o[7]);
                        *(u32x4*)(rowp + bj * 128) = w;
                    }
                }
        } else {
            bf16* base = sec == 0 ? u : (sec == 1 ? q : (sec == 3 ? v : so));
            const bool act = (sec == 1 || sec == 4);
#pragma unroll
            for (int ai = 0; ai < 2; ++ai)
#pragma unroll
                for (int m = 0; m < 4; ++m) {
                    const float r = __shfl(rs[ai], 16 * m + fr);
                    bf16* rowp = base + (size_t)(row0 + ai * 128 + m * 16) * 512 + colt;
#pragma unroll
                    for (int bj = 0; bj < 2; ++bj) {
                        f32x4 v0 = acc[ai][bj][m][0] * r, v1 = acc[ai][bj][m][1] * r;
                        if (act) {
#pragma unroll
                            for (int e = 0; e < 4; ++e) { v0[e] = silu(v0[e]); v1[e] = silu(v1[e]); }
                        }
                        u32x4 w; w.x = pk(v0[0], v0[1]); w.y = pk(v0[2], v0[3]); w.z = pk(v1[0], v1[1]); w.w = pk(v1[2], v1[3]);
                        *(u32x4*)(rowp + bj * 128) = w;
                    }
                }
        }
    }
};


template <bool SECOND> struct EpiMerge {
    static constexpr bool PERM = true, AFTER_DRAIN = false;
    bf16* merged; const bf16* gates;
    __device__ __forceinline__ void operator()(const f32x4 (&acc)[2][2][4][2], const pg8::Unit& un, int wr, int wc, int fr, int fq) const {
        const int col0 = un.pn * 256 + wc * 32 + 8 * fq, row0 = un.pm * 256 + wr * 64 + fr;
#pragma unroll
        for (int ai = 0; ai < 2; ++ai)
#pragma unroll
            for (int m = 0; m < 4; ++m) {
                const size_t row = (size_t)(row0 + ai * 128 + m * 16);
#pragma unroll
                for (int bj = 0; bj < 2; ++bj) {
                    const u32x4 gw = *(const u32x4*)(gates + row * NGATE + (SECOND ? 1024 : 0) + col0 + bj * 128);
                    const f32x4 a0 = acc[ai][bj][m][0], a1 = acc[ai][bj][m][1];
                    float o[8];
                    o[0] = bflo(gw.x) * a0[0]; o[1] = bfhi(gw.x) * a0[1]; o[2] = bflo(gw.y) * a0[2]; o[3] = bfhi(gw.y) * a0[3];
                    o[4] = bflo(gw.z) * a1[0]; o[5] = bfhi(gw.z) * a1[1]; o[6] = bflo(gw.w) * a1[2]; o[7] = bfhi(gw.w) * a1[3];
                    bf16* mp = merged + row * D + col0 + bj * 128;
                    if (SECOND) {
                        const u32x4 ow = *(const u32x4*)mp;
                        o[0] += bflo(ow.x); o[1] += bfhi(ow.x); o[2] += bflo(ow.y); o[3] += bfhi(ow.y);
                        o[4] += bflo(ow.z); o[5] += bfhi(ow.z); o[6] += bflo(ow.w); o[7] += bfhi(ow.w);
                    }
                    u32x4 w; w.x = pk(o[0], o[1]); w.y = pk(o[2], o[3]); w.z = pk(o[4], o[5]); w.w = pk(o[6], o[7]);
                    *(u32x4*)mp = w;
                }
            }
    }
};

template <bool LAST> struct EpiRes {
    static constexpr bool PERM = true, AFTER_DRAIN = false;
    float* out; bf16* xb; float* ssq;
    __device__ __forceinline__ void operator()(const f32x4 (&acc)[2][2][4][2], const pg8::Unit& un, int wr, int wc, int fr, int fq) const {
        const int col0 = un.pn * 256 + wc * 32 + 8 * fq, row0 = un.pm * 256 + wr * 64 + fr;
#pragma unroll
        for (int ai = 0; ai < 2; ++ai)
#pragma unroll
            for (int m = 0; m < 4; ++m) {
                const size_t row = (size_t)(row0 + ai * 128 + m * 16);
                float s = 0.f;
#pragma unroll
                for (int bj = 0; bj < 2; ++bj) {
                    const size_t p = row * D + col0 + bj * 128;
                    const u32x4 bw = *(const u32x4*)(xb + p);
                    const f32x4 x0 = (f32x4){bflo(bw.x), bfhi(bw.x), bflo(bw.y), bfhi(bw.y)} + acc[ai][bj][m][0], x1 = (f32x4){bflo(bw.z), bfhi(bw.z), bflo(bw.w), bfhi(bw.w)} + acc[ai][bj][m][1];
                    s += (x0[0] * x0[0] + x0[1] * x0[1]) + (x0[2] * x0[2] + x0[3] * x0[3]) + (x1[0] * x1[0] + x1[1] * x1[1]) + (x1[2] * x1[2] + x1[3] * x1[3]);
                    if (LAST) { *(f32x4*)(out + p) = x0; *(f32x4*)(out + p + 4) = x1; }
                    else { u32x4 w; w.x = pk(x0[0], x0[1]); w.y = pk(x0[2], x0[3]); w.z = pk(x1[0], x1[1]); w.w = pk(x1[2], x1[3]); *(u32x4*)(xb + p) = w; }
                }
                s += __shfl_xor(s, 16); s += __shfl_xor(s, 32);
                if (fq == 0) ssq[row * 16 + un.pn * 4 + wc] = s;
            }
    }
};

struct EpiUpConv {
    static constexpr bool PERM = false, AFTER_DRAIN = false;
    bf16* act; bf16* hbnd; const float* ssq; const float* cw; const float* cb;
    __device__ __forceinline__ void operator()(f32x4 (&acc)[2][2][4][2], const pg8::Unit& un, int wr, int wc, int fr, int fq) const {
        const int lane = fr + 16 * fq;
        {
            const float rs0 = load_rs(ssq, un.pm * 256 + 128 * wr, lane), rs1 = load_rs(ssq, un.pm * 256 + 128 * wr + 64, lane);
#pragma unroll
            for (int j = 0; j < 8; ++j) { const int src = (8 * fr + j) & 63; const float a = __shfl(rs0, src), b = __shfl(rs1, src); const float r = fr < 8 ? a : b;
#pragma unroll
                for (int bj = 0; bj < 2; ++bj)
#pragma unroll
                    for (int n = 0; n < 2; ++n) acc[j >> 2][bj][j & 3][n] *= r; }
        }
        const size_t tok0 = (size_t)un.pm * 256 + 128 * wr + 8 * fr;
        const int blk = un.pm * 2 + wr;
#pragma unroll
        for (int n = 0; n < 2; ++n) {
            const int ch0 = un.pn * 128 + wc * 32 + 16 * n + 4 * fq;
            if (fr == 15) {
                bf16* hb = hbnd + ((size_t)(blk * 4 + 2) * 2) * DFF + ch0;
                const f32x4 hv6 = acc[1][0][2][n], hv7 = acc[1][0][3][n], hg6 = acc[1][1][2][n], hg7 = acc[1][1][3][n];
                *(u32x2*)(hb) = (u32x2){pk(hv6[0], hv6[1]), pk(hv6[2], hv6[3])}; *(u32x2*)(hb + DFF) = (u32x2){pk(hg6[0], hg6[1]), pk(hg6[2], hg6[3])};
                *(u32x2*)(hb + 2 * DFF) = (u32x2){pk(hv7[0], hv7[1]), pk(hv7[2], hv7[3])}; *(u32x2*)(hb + 3 * DFF) = (u32x2){pk(hg7[0], hg7[1]), pk(hg7[2], hg7[3])};
            }
            if (fr == 0) {
#pragma unroll
                for (int j = 0; j < 2; ++j) { bf16* hb = hbnd + ((size_t)(blk * 4 + j) * 2) * DFF + ch0; const f32x4 hv = acc[0][0][j][n], hg = acc[0][1][j][n];
                    *(u32x2*)(hb) = (u32x2){pk(hv[0], hv[1]), pk(hv[2], hv[3])}; *(u32x2*)(hb + DFF) = (u32x2){pk(hg[0], hg[1]), pk(hg[2], hg[3])}; }
            }
#pragma unroll
            for (int bj = 0; bj < 2; ++bj) {
                const float* cwp = cw + bj * DFF + ch0;
                const f32x4 w0 = *(const f32x4*)(cwp), w1 = *(const f32x4*)(cwp + NUP), w2 = *(const f32x4*)(cwp + 2 * NUP), bb = *(const f32x4*)(cb + bj * DFF + ch0);
                f32x4 m2, m1;
#pragma unroll
                for (int e = 0; e < 4; ++e) { m2[e] = dpp_shr1(acc[1][bj][2][n][e]); m1[e] = dpp_shr1(acc[1][bj][3][n][e]); }
#pragma unroll
                for (int j = 7; j >= 0; --j) {
                    const f32x4 h0 = acc[j >> 2][bj][j & 3][n];
                    const f32x4 hm1 = j >= 1 ? acc[(j - 1 + 8) % 8 >> 2][bj][(j - 1 + 8) % 8 & 3][n] : m1;
                    const f32x4 hm2 = j >= 2 ? acc[(j - 2 + 8) % 8 >> 2][bj][(j - 2 + 8) % 8 & 3][n] : (j == 1 ? m1 : m2);
                    acc[j >> 2][bj][j & 3][n] = w2 * h0 + w1 * hm1 + w0 * hm2 + bb;
                }
            }
#pragma unroll
            for (int j = 0; j < 8; ++j) {
                const f32x4 vc = acc[j >> 2][0][j & 3][n], gc = acc[j >> 2][1][j & 3][n];
                f32x4 a;
#pragma unroll
                for (int e = 0; e < 4; ++e) a[e] = vc[e] * silu(gc[e]);
                if (!(j < 2 && fr == 0)) *(u32x2*)(act + (tok0 + j) * DFF + ch0) = (u32x2){pk(a[0], a[1]), pk(a[2], a[3])};
            }
        }
    }
};

struct Args { const float* in[17]; float* out; unsigned char* ws; int ph_lo, ph_hi; };

struct TrItem { const float* W; const float* rscale; bf16* WT; int K, N, drow0, k0, n0; };
__device__ __forceinline__ void tr_load(const TrItem& t, int lane, float (&wv)[32]) {
#pragma unroll
    for (int i = 0; i < 32; ++i) { const int kk = 2 * i + (lane >> 5); wv[i] = t.W[(size_t)(t.k0 + kk) * t.N + t.n0 + (lane & 31)]; }
    if (t.rscale) {
#pragma unroll
        for (int i = 0; i < 32; ++i) wv[i] *= t.rscale[t.k0 + 2 * i + (lane >> 5)];
    }
}
__device__ __forceinline__ void tr_store(const TrItem& t, int lane, const float (&wv)[32], LAS float* scr) {
#pragma unroll
    for (int i = 0; i < 32; ++i) scr[(2 * i + (lane >> 5)) * 33 + (lane & 31)] = wv[i];
    LDS_WAIT(); asm volatile("" ::: "memory");
    const int c = lane & 7;
#pragma unroll
    for (int j = 0; j < 4; ++j) { const int n = (lane >> 3) + 8 * j; const LAS float* sp = scr + (8 * c) * 33 + n;
        u32x4 o; o.x = pk(sp[0 * 33], sp[1 * 33]); o.y = pk(sp[2 * 33], sp[3 * 33]); o.z = pk(sp[4 * 33], sp[5 * 33]); o.w = pk(sp[6 * 33], sp[7 * 33]);
        *(u32x4*)(t.WT + (size_t)(t.drow0 + n) * t.K + t.k0 + 8 * c) = o; }
    LDS_WAIT(); asm volatile("" ::: "memory");
}
constexpr int I_IN = (D / 64) * (IN_COLS / 32), I_PB = (HW / 64) * (D / 32), I_O = (D / 64) * (D / 32), I_UP = (D / 64) * (NUP / 32), I_DN = (DFF / 64) * (D / 32);
constexpr int I_LAYER = I_IN + I_PB + I_O + I_UP + I_DN;
__device__ __forceinline__ TrItem tr_decode(const Args& a, int it) {
    const int l = it / I_LAYER; int r = it % I_LAYER;
    unsigned char* wl = a.ws + WS_W + (size_t)l * W_LAYER;
    TrItem t;
    if (r < I_IN) { const int nb = IN_COLS / 32; t.k0 = 64 * (r / nb); t.n0 = 32 * (r % nb); t.W = a.in[2] + (size_t)l * D * IN_COLS; t.K = D; t.N = IN_COLS; t.rscale = a.in[1] + l * D; t.WT = (bf16*)(wl + WO_IN); t.drow0 = t.n0; return t; }
    r -= I_IN;
    if (r < I_PB) { const int nb = D / 32; t.k0 = 64 * (r / nb); t.n0 = 32 * (r % nb); t.W = a.in[9] + (size_t)l * HW * D; t.K = HW; t.N = D; t.rscale = nullptr; t.WT = (bf16*)(wl + WO_PB); t.drow0 = t.n0; return t; }
    r -= I_PB;
    if (r < I_O) { const int nb = D / 32; t.k0 = 64 * (r / nb); t.n0 = 32 * (r % nb); t.W = a.in[10] + (size_t)l * D * D; t.K = D; t.N = D; t.rscale = nullptr; t.WT = (bf16*)(wl + WO_O); t.drow0 = t.n0; return t; }
    r -= I_O;
    if (r < I_UP) { const int nb = NUP / 32; t.k0 = 64 * (r / nb); t.n0 = 32 * (r % nb); t.W = a.in[12] + (size_t)l * D * NUP; t.K = D; t.N = NUP; t.rscale = a.in[11] + l * D; t.WT = (bf16*)(wl + WO_UP);
        const int bjs = t.n0 / DFF, rr = t.n0 % DFF; t.drow0 = 256 * (rr / 128) + 128 * bjs + (rr % 128); return t; }
    r -= I_UP;
    { const int nb = D / 32; t.k0 = 64 * (r / nb); t.n0 = 32 * (r % nb); t.W = a.in[15] + (size_t)l * DFF * D; t.K = DFF; t.N = D; t.rscale = nullptr; t.WT = (bf16*)(wl + WO_DN); t.drow0 = t.n0; return t; }
}

__device__ __forceinline__ void phase_prologue(const Args& a, LAS unsigned char* lds, int G) {
    int tid = threadIdx.x; asm volatile("" : "+v"(tid));
    const int lane = tid & 63, wave = __builtin_amdgcn_readfirstlane(tid >> 6);
    unsigned char* ws = a.ws;
    const float *x = a.in[0], *pool_w = a.in[4], *pool_scale = a.in[5], *lb_logits = a.in[6], *w_pa = a.in[8];
    LAS float* scr = (LAS float*)(lds + wave * 16384);
    const int gw = blockIdx.x * NWAVES + wave, NGW = G * NWAVES;
    for (int it = gw; it < DEPTH * I_LAYER; it += 2 * NGW) {
        const bool two = it + NGW < DEPTH * I_LAYER;
        const TrItem t0 = tr_decode(a, it), t1 = tr_decode(a, two ? it + NGW : it);
        float w0[32], w1[32];
        tr_load(t0, lane, w0); if (two) tr_load(t1, lane, w1);
        tr_store(t0, lane, w0, scr); if (two) tr_store(t1, lane, w1, scr);
    }
    for (int gt = blockIdx.x * NTHREADS + tid; gt < DEPTH * 65536; gt += G * NTHREADS) {
        const int l = __builtin_amdgcn_readfirstlane(gt >> 16), rem = gt & 65535, d = rem & 1023, cg8 = __builtin_amdgcn_readfirstlane(rem >> 10), gi = cg8 >> 4, c0 = (cg8 & 15) * 8;
        const float* pw = pool_w + ((size_t)(l * 4 + gi) * 128 + c0) * 128;
        const float* ps = pool_scale + l * PW + gi * 128;
        const float* wp = w_pa + ((size_t)l * PW + gi * 128) * D + d;
        LAS float* pwl = scr;
#pragma unroll
        for (int j = 0; j < 4; ++j) { const int e = j * 256 + lane * 4; const f32x4 v = *(const f32x4*)(pw + e) * *(const f32x4*)(ps + (e & 127)); *(LAS f32x4*)(pwl + e) = v; }
        LDS_WAIT(); asm volatile("" ::: "memory");
        float sacc[8];
#pragma unroll
        for (int i = 0; i < 8; ++i) sacc[i] = 0.f;
#pragma unroll 4
        for (int cp = 0; cp < 128; cp += 4) {
            const float w0 = wp[(size_t)cp * D], w1 = wp[(size_t)(cp + 1) * D], w2 = wp[(size_t)(cp + 2) * D], w3 = wp[(size_t)(cp + 3) * D];
#pragma unroll
            for (int i = 0; i < 8; ++i) { const f32x4 p = *(const LAS f32x4*)(pwl + i * 128 + cp); sacc[i] += (p[0] * w0 + p[1] * w1) + (p[2] * w2 + p[3] * w3); }
        }
        u32x4 o; o.x = pk(sacc[0], sacc[1]); o.y = pk(sacc[2], sacc[3]); o.z = pk(sacc[4], sacc[5]); o.w = pk(sacc[6], sacc[7]);
        *(u32x4*)((bf16*)(ws + WS_W + (size_t)l * W_LAYER + WO_A) + (size_t)d * PW + cg8 * 8) = o;
        LDS_WAIT(); asm volatile("" ::: "memory");
    }
    if (blockIdx.x == 0) {
        const int chn = tid;
        float mx = -1e30f;
        for (int l = 0; l < DEPTH; ++l) mx = fmaxf(mx, lb_logits[l * HW + chn]);
        float sum = 0.f;
        for (int l = 0; l < DEPTH; ++l) sum += expf(lb_logits[l * HW + chn] - mx);
        float cum = 0.f, c0v = 0.f;
        for (int l = 0; l < DEPTH; ++l) { cum += expf(lb_logits[l * HW + chn] - mx) / sum; if (l == 0) c0v = cum; ((float*)(ws + WS_LB))[l * HW + chn] = cum - c0v; }
    }
    bf16* xb = (bf16*)(ws + WS_XB); float* ssq = (float*)(ws + WS_SSQ);
    for (int m = gw; m < M; m += 2 * NGW) {
        const int m1 = m + NGW;
        const bool two = m1 < M;
        const f32x4* xr0 = (const f32x4*)(x + (size_t)m * D) + lane; const f32x4* xr1 = (const f32x4*)(x + (size_t)(two ? m1 : m) * D) + lane;
        f32x4 v0[4], v1[4]; float s0 = 0.f, s1 = 0.f;
#pragma unroll
        for (int j = 0; j < 4; ++j) { v0[j] = xr0[64 * j]; v1[j] = xr1[64 * j]; }
#pragma unroll
        for (int j = 0; j < 4; ++j) { s0 += (v0[j][0] * v0[j][0] + v0[j][1] * v0[j][1]) + (v0[j][2] * v0[j][2] + v0[j][3] * v0[j][3]); s1 += (v1[j][0] * v1[j][0] + v1[j][1] * v1[j][1]) + (v1[j][2] * v1[j][2] + v1[j][3] * v1[j][3]); }
        s0 = wave_sum(s0); s1 = wave_sum(s1);
        u32x2* o0 = (u32x2*)(xb + (size_t)m * D) + lane;
#pragma unroll
        for (int j = 0; j < 4; ++j) o0[64 * j] = (u32x2){pk(v0[j][0], v0[j][1]), pk(v0[j][2], v0[j][3])};
        if (lane < 16) ssq[(size_t)m * 16 + lane] = lane == 0 ? s0 : 0.f;
        if (two) {
            u32x2* o1 = (u32x2*)(xb + (size_t)m1 * D) + lane;
#pragma unroll
            for (int j = 0; j < 4; ++j) o1[64 * j] = (u32x2){pk(v1[j][0], v1[j][1]), pk(v1[j][2], v1[j][3])};
            if (lane < 16) ssq[(size_t)m1 * 16 + lane] = lane == 0 ? s1 : 0.f;
        }
    }
}

__device__ __forceinline__ void phase_fir(const bf16* u, bf16* pooled, int G) {
    int tid = threadIdx.x; asm volatile("" : "+v"(tid));
    for (int item = blockIdx.x * NTHREADS + tid; item < (M / 8) * 64; item += G * NTHREADS) {
        const int cgp = item & 63, run = item >> 6, m0 = run * 8, ts = m0 & (SEQ - 1), w = 2 << (cgp >> 4);
        const bf16* up = u + (size_t)m0 * PW + cgp * 8;
        float s[8];
#pragma unroll
        for (int i = 0; i < 8; ++i) s[i] = 0.f;
        for (int d = 1; d < w; ++d) if (ts - d >= 0) {
            const u32x4 x = *(const u32x4*)(up - (size_t)d * PW);
            s[0] += bflo(x.x); s[1] += bfhi(x.x); s[2] += bflo(x.y); s[3] += bfhi(x.y); s[4] += bflo(x.z); s[5] += bfhi(x.z); s[6] += bflo(x.w); s[7] += bfhi(x.w);
        }
#pragma unroll
        for (int r = 0; r < 8; ++r) {
            const u32x4 x = *(const u32x4*)(up + (size_t)r * PW);
            float c[8] = {bflo(x.x), bfhi(x.x), bflo(x.y), bfhi(x.y), bflo(x.z), bfhi(x.z), bflo(x.w), bfhi(x.w)};
#pragma unroll
            for (int i = 0; i < 8; ++i) s[i] += c[i];
            const int cnt = (ts + r + 1) < w ? (ts + r + 1) : w; const float inv = 1.f / (float)cnt;
            u32x4 o; o.x = pk(s[0] * inv - c[0], s[1] * inv - c[1]); o.y = pk(s[2] * inv - c[2], s[3] * inv - c[3]);
            o.z = pk(s[4] * inv - c[4], s[5] * inv - c[5]); o.w = pk(s[6] * inv - c[6], s[7] * inv - c[7]);
            *(u32x4*)(pooled + (size_t)(m0 + r) * PW + cgp * 8) = o;
            if (ts + r - w + 1 >= 0) {
                const u32x4 y = *(const u32x4*)(up + ((ptrdiff_t)r - w + 1) * PW);
                s[0] -= bflo(y.x); s[1] -= bfhi(y.x); s[2] -= bflo(y.y); s[3] -= bfhi(y.y); s[4] -= bflo(y.z); s[5] -= bfhi(y.z); s[6] -= bflo(y.w); s[7] -= bfhi(y.w);
            }
        }
    }
}

__device__ __forceinline__ u32x4 pack_lo8(const unsigned (&v)[8]) { u32x4 o; o.x = (v[0] & 0xffffu) | (v[1] << 16); o.y = (v[2] & 0xffffu) | (v[3] << 16); o.z = (v[4] & 0xffffu) | (v[5] << 16); o.w = (v[6] & 0xffffu) | (v[7] << 16); return o; }
__device__ __forceinline__ u32x4 pack_hi8(const unsigned (&v)[8]) { u32x4 o; o.x = (v[0] >> 16) | (v[1] & 0xffff0000u); o.y = (v[2] >> 16) | (v[3] & 0xffff0000u); o.z = (v[4] >> 16) | (v[5] & 0xffff0000u); o.w = (v[6] >> 16) | (v[7] & 0xffff0000u); return o; }

#define WG_BAR() do { asm volatile("s_waitcnt lgkmcnt(0)" ::: "memory"); __builtin_amdgcn_s_barrier(); asm volatile("" ::: "memory"); } while (0)
__device__ __forceinline__ void phase_h1(LAS unsigned char* lds, const bf16* g, const bf16* vb, bf16* UT, float* dec, int G) {
    int tid = threadIdx.x; asm volatile("" : "+v"(tid));
    const int lane = tid & 63, w = __builtin_amdgcn_readfirstlane(tid >> 6), r16 = lane & 15, q4 = lane >> 4;
    LAS unsigned char* KT = lds; LAS unsigned char* VT = lds + 18432; LAS float* SEG = (LAS float*)(lds + 36864);
    f32x2 gg[8]; unsigned vv[8];
    int unit = blockIdx.x;
    if (unit < NUNIT) {
        const int bh = unit >> 7, c = unit & 127, b = bh >> 2, h = bh & 3;
        const size_t m0 = (size_t)b * SEQ + c * CH + 8 * w; const int col = h * HD + 2 * lane;
#pragma unroll
        for (int r = 0; r < 8; ++r) { { const unsigned gw_ = *(const unsigned*)(g + (m0 + r) * HW + col); gg[r] = (f32x2){bflo(gw_), bfhi(gw_)}; } vv[r] = *(const unsigned*)(vb + (m0 + r) * HW + col); }
    }
    for (; unit < NUNIT; unit += G) {
        f32x2 cs[8]; cs[0] = gg[0];
#pragma unroll
        for (int r = 1; r < 8; ++r) cs[r] = cs[r - 1] + gg[r];
        *(LAS f32x2*)(SEG + w * 128 + 2 * lane) = cs[7];
        *(LAS u32x4*)(VT + (2 * lane) * 144 + w * 16) = pack_lo8(vv); *(LAS u32x4*)(VT + (2 * lane + 1) * 144 + w * 16) = pack_hi8(vv);
        WG_BAR();
        f32x2 pre = {0.f, 0.f}, tot = {0.f, 0.f};
#pragma unroll
        for (int j = 0; j < 8; ++j) { const f32x2 sg = *(const LAS f32x2*)(SEG + j * 128 + 2 * lane); tot += sg; if (j < w) pre += sg; }
        unsigned kt[8];
#pragma unroll
        for (int r = 0; r < 8; ++r) { const f32x2 bb = pre + cs[r];
            kt[r] = pk((1.f - __expf(gg[r].x)) * __expf(tot.x - bb.x), (1.f - __expf(gg[r].y)) * __expf(tot.y - bb.y)); }
        *(LAS u32x4*)(KT + (2 * lane) * 144 + w * 16) = pack_lo8(kt); *(LAS u32x4*)(KT + (2 * lane + 1) * 144 + w * 16) = pack_hi8(kt);
        if (w == 0) *(f32x2*)(dec + (size_t)unit * HD + 2 * lane) = (f32x2){__expf(tot.x), __expf(tot.y)};
        const int nu = unit + G;
        if (nu < NUNIT) {
            const int bh = nu >> 7, c = nu & 127, b = bh >> 2, h = bh & 3;
            const size_t m0 = (size_t)b * SEQ + c * CH + 8 * w; const int col = h * HD + 2 * lane;
#pragma unroll
            for (int r = 0; r < 8; ++r) { { const unsigned gw_ = *(const unsigned*)(g + (m0 + r) * HW + col); gg[r] = (f32x2){bflo(gw_), bfhi(gw_)}; } vv[r] = *(const unsigned*)(vb + (m0 + r) * HW + col); }
        }
        WG_BAR();
        bf16x8 yv[2];
#pragma unroll
        for (int ks = 0; ks < 2; ++ks) yv[ks] = *(const LAS bf16x8*)(VT + (16 * w + r16) * 144 + ks * 64 + q4 * 16);
        bf16* ut = UT + (size_t)unit * (HD * HD) + (size_t)(16 * w + r16) * HD + 4 * q4;
#pragma unroll
        for (int nb = 0; nb < 8; ++nb) {
            f32x4 a = {0.f, 0.f, 0.f, 0.f};
#pragma unroll
            for (int ks = 0; ks < 2; ++ks) { const bf16x8 xk = *(const LAS bf16x8*)(KT + (16 * nb + r16) * 144 + ks * 64 + q4 * 16); a = __builtin_amdgcn_mfma_f32_16x16x32_bf16(xk, yv[ks], a, 0, 0, 0); }
            *(u32x2*)(ut + 16 * nb) = (u32x2){pk(a[0], a[1]), pk(a[2], a[3])};
        }
        WG_BAR();
    }
}

__device__ __forceinline__ void phase_h2(bf16* UT, const float* dec, int G) {
    int tid = threadIdx.x; asm volatile("" : "+v"(tid));
    for (int e = blockIdx.x * NTHREADS + tid; e < NBH * HD * HD; e += G * NTHREADS) {
        const int bh = e >> 14, idx = e & 16383, k = idx & 127;
        bf16* up = UT + (size_t)bh * NCH * (HD * HD) + idx; const float* dp = dec + (size_t)bh * NCH * HD + k;
        float S = 0.f;
        for (int c0 = 0; c0 < NCH; c0 += 16) {
            bf16 uu[16]; float dd[16];
#pragma unroll
            for (int i = 0; i < 16; ++i) { uu[i] = up[(size_t)(c0 + i) * (HD * HD)]; dd[i] = dp[(size_t)(c0 + i) * HD]; }
#pragma unroll
            for (int i = 0; i < 16; ++i) { up[(size_t)(c0 + i) * (HD * HD)] = (bf16)(pk(S, 0.f) & 0xffffu); S = dd[i] * S + __uint_as_float((unsigned)uu[i] << 16); }
        }
    }
}

__device__ __forceinline__ void phase_h3(LAS unsigned char* lds, const bf16* qb, const bf16* g, const bf16* vb, const bf16* sob, const bf16* ST, const float* ng, bf16* hg, int G) {
    constexpr int SR = 272;
    int tid = threadIdx.x; asm volatile("" : "+v"(tid));
    const int lane = tid & 63, w = __builtin_amdgcn_readfirstlane(tid >> 6), r16 = lane & 15, q4 = lane >> 4;
    LAS unsigned char* QH = lds; LAS unsigned char* QD = lds + 17408; LAS unsigned char* KD = lds + 34816; LAS unsigned char* KE = lds + 52224; LAS unsigned char* QO = lds + 69632;
    LAS unsigned char* VT = lds + 95744; LAS float* SEG = (LAS float*)(lds + 114176); LAS float* RMS = (LAS float*)(lds + 118272);
    const int bi = w >> 1, odd = w & 1;
    f32x2 gg[8]; unsigned qq[8], vv[8];
    int unit = blockIdx.x;
    if (unit < NUNIT) {
        const int bh = unit >> 7, c = unit & 127, b = bh >> 2, h = bh & 3;
        const size_t m0 = (size_t)b * SEQ + c * CH + 8 * w; const int col = h * HD + 2 * lane;
#pragma unroll
        for (int r = 0; r < 8; ++r) { { const unsigned gw_ = *(const unsigned*)(g + (m0 + r) * HW + col); gg[r] = (f32x2){bflo(gw_), bfhi(gw_)}; } qq[r] = *(const unsigned*)(qb + (m0 + r) * HW + col); vv[r] = *(const unsigned*)(vb + (m0 + r) * HW + col); }
    }
    for (; unit < NUNIT; unit += G) {
        const int bh = unit >> 7, c = unit & 127, b = bh >> 2, h = bh & 3;
        const size_t mu = (size_t)b * SEQ + c * CH;
        const bf16* STu = ST + (size_t)unit * (HD * HD) + (size_t)(64 * odd + r16) * HD + q4 * 8;
        bf16x8 xs[4][4];
#pragma unroll
        for (int ks = 0; ks < 4; ++ks)
#pragma unroll
            for (int nb = 0; nb < 4; ++nb) xs[ks][nb] = *(const bf16x8*)(STu + (size_t)(16 * nb) * HD + ks * 32);
        const size_t row = mu + 16 * bi + r16;
        u32x2 sv[4]; f32x4 ngv[4];
#pragma unroll
        for (int nb = 0; nb < 4; ++nb) { const int v0 = 64 * odd + 16 * nb + 4 * q4; ngv[nb] = *(const f32x4*)(ng + v0); sv[nb] = *(const u32x2*)(sob + row * HW + h * HD + v0); }
        f32x2 cs[8]; cs[0] = gg[0];
#pragma unroll
        for (int r = 1; r < 8; ++r) cs[r] = cs[r - 1] + gg[r];
        *(LAS f32x2*)(SEG + w * 128 + 2 * lane) = cs[7];
        *(LAS u32x4*)(VT + (2 * lane) * 144 + w * 16) = pack_lo8(vv); *(LAS u32x4*)(VT + (2 * lane + 1) * 144 + w * 16) = pack_hi8(vv);
        WG_BAR();
        f32x2 pre = {0.f, 0.f};
        for (int j = 0; j < w; ++j) pre += *(const LAS f32x2*)(SEG + j * 128 + 2 * lane);
        const f32x2 cmid = *(const LAS f32x2*)(SEG + (2 * bi) * 128 + 2 * lane);
        const f32x2 bsum = cmid + *(const LAS f32x2*)(SEG + (2 * bi + 1) * 128 + 2 * lane);
        f32x2 bsm1 = {0.f, 0.f}, bsm2 = {0.f, 0.f};
        if (bi >= 1) bsm1 = *(const LAS f32x2*)(SEG + (2 * bi - 2) * 128 + 2 * lane) + *(const LAS f32x2*)(SEG + (2 * bi - 1) * 128 + 2 * lane);
        if (bi >= 2) bsm2 = bsm1 + *(const LAS f32x2*)(SEG + (2 * bi - 4) * 128 + 2 * lane) + *(const LAS f32x2*)(SEG + (2 * bi - 3) * 128 + 2 * lane);
        const f32x2 cbase = odd ? cmid : (f32x2){0.f, 0.f};
        const int pbase = (bi * (bi - 1)) / 2;
#pragma unroll
        for (int r = 0; r < 8; ++r) {
            const int t = 8 * w + r, tl = 8 * odd + r;
            const f32x2 cl = cbase + cs[r], bf = pre + cs[r];
            const float qx = bflo(qq[r]), qy = bfhi(qq[r]);
            const float kx = 1.f - __expf(gg[r].x), ky = 1.f - __expf(gg[r].y);
            *(LAS unsigned*)(QH + t * SR + 4 * lane) = pk(qx * __expf(bf.x), qy * __expf(bf.y));
            *(LAS unsigned*)(QD + t * SR + 4 * lane) = pk(qx * __expf(fminf(cl.x - cmid.x, 80.f)), qy * __expf(fminf(cl.y - cmid.y, 80.f)));
            *(LAS unsigned*)(KD + t * SR + 4 * lane) = pk(kx * __expf(fminf(cmid.x - cl.x, 80.f)), ky * __expf(fminf(cmid.y - cl.y, 80.f)));
            if (bi < 3) *(LAS unsigned*)(KE + t * SR + 4 * lane) = pk(kx * __expf(bsum.x - cl.x), ky * __expf(bsum.y - cl.y));
            if (bi >= 1) *(LAS unsigned*)(QO + ((pbase + bi - 1) * 16 + tl) * SR + 4 * lane) = pk(qx * __expf(cl.x), qy * __expf(cl.y));
            if (bi >= 2) *(LAS unsigned*)(QO + ((pbase + bi - 2) * 16 + tl) * SR + 4 * lane) = pk(qx * __expf(cl.x + bsm1.x), qy * __expf(cl.y + bsm1.y));
            if (bi >= 3) *(LAS unsigned*)(QO + ((pbase + 0) * 16 + tl) * SR + 4 * lane) = pk(qx * __expf(cl.x + bsm2.x), qy * __expf(cl.y + bsm2.y));
        }
        WG_BAR();
        { const int nu = unit + G;
          if (nu < NUNIT) {
            const int bh2 = nu >> 7, c2 = nu & 127, b2 = bh2 >> 2, h2 = bh2 & 3;
            const size_t m0 = (size_t)b2 * SEQ + c2 * CH + 8 * w; const int col = h2 * HD + 2 * lane;
#pragma unroll
            for (int r = 0; r < 8; ++r) { { const unsigned gw_ = *(const unsigned*)(g + (m0 + r) * HW + col); gg[r] = (f32x2){bflo(gw_), bfhi(gw_)}; } qq[r] = *(const unsigned*)(qb + (m0 + r) * HW + col); vv[r] = *(const unsigned*)(vb + (m0 + r) * HW + col); }
          } }
        const int i = bi, vh = odd;
        f32x4 acc[4];
#pragma unroll
        for (int nb = 0; nb < 4; ++nb) acc[nb] = (f32x4){0.f, 0.f, 0.f, 0.f};
#pragma unroll
        for (int ks = 0; ks < 4; ++ks) {
            const bf16x8 y = *(const LAS bf16x8*)(QH + (16 * i + r16) * SR + ks * 64 + q4 * 16);
#pragma unroll
            for (int nb = 0; nb < 4; ++nb) acc[nb] = __builtin_amdgcn_mfma_f32_16x16x32_bf16(xs[ks][nb], y, acc[nb], 0, 0, 0);
        }
#pragma unroll
        for (int jp = 0; jp < 2; ++jp) {
            if (2 * jp <= i) {
                f32x4 p[2];
#pragma unroll
                for (int jj = 0; jj < 2; ++jj) {
                    const int j = 2 * jp + jj;
                    p[jj] = (f32x4){0.f, 0.f, 0.f, 0.f};
                    if (j <= i) {
                        const LAS unsigned char* Kb = (j == i ? KD : KE) + (16 * j + r16) * SR + q4 * 16;
                        const LAS unsigned char* Qb = (j == i ? QD + (16 * i + r16) * SR : QO + ((pbase + j) * 16 + r16) * SR) + q4 * 16;
#pragma unroll
                        for (int ks = 0; ks < 4; ++ks) { const bf16x8 xk = *(const LAS bf16x8*)(Kb + ks * 64); const bf16x8 yq = *(const LAS bf16x8*)(Qb + ks * 64); p[jj] = __builtin_amdgcn_mfma_f32_16x16x32_bf16(xk, yq, p[jj], 0, 0, 0); }
                        if (j == i) {
#pragma unroll
                            for (int e = 0; e < 4; ++e) if (4 * q4 + e > r16) p[jj][e] = 0.f;
                        }
                    }
                }
                u32x4 ypw; ypw.x = pk(p[0][0], p[0][1]); ypw.y = pk(p[0][2], p[0][3]); ypw.z = pk(p[1][0], p[1][1]); ypw.w = pk(p[1][2], p[1][3]);
                const bf16x8 yp = __builtin_bit_cast(bf16x8, ypw);
#pragma unroll
                for (int nb = 0; nb < 4; ++nb) {
                    const LAS unsigned char* vp = VT + (64 * vh + 16 * nb + r16) * 144 + (32 * jp + 4 * q4) * 2;
                    const u32x2 lo = *(const LAS u32x2*)vp, hi = *(const LAS u32x2*)(vp + 32);
                    const u32x4 xw = {lo.x, lo.y, hi.x, hi.y};
                    acc[nb] = __builtin_amdgcn_mfma_f32_16x16x32_bf16(__builtin_bit_cast(bf16x8, xw), yp, acc[nb], 0, 0, 0);
                }
            }
        }
        float ss = 0.f;
#pragma unroll
        for (int nb = 0; nb < 4; ++nb) ss += (acc[nb][0] * acc[nb][0] + acc[nb][1] * acc[nb][1]) + (acc[nb][2] * acc[nb][2] + acc[nb][3] * acc[nb][3]);
        ss += __shfl_xor(ss, 16); ss += __shfl_xor(ss, 32);
        if (q4 == 0) RMS[(16 * i + r16) * 2 + vh] = ss;
        WG_BAR();
        const float rstd = rsqrtf((RMS[(16 * i + r16) * 2] + RMS[(16 * i + r16) * 2 + 1]) * (1.f / HD) + EPS);
#pragma unroll
        for (int nb = 0; nb < 4; ++nb) {
            const int v0 = 64 * vh + 16 * nb + 4 * q4;
            const f32x4 o = acc[nb] * rstd * ngv[nb];
            *(u32x2*)(hg + row * HW + h * HD + v0) = (u32x2){pk(o[0] * bflo(sv[nb].x), o[1] * bfhi(sv[nb].x)), pk(o[2] * bflo(sv[nb].y), o[3] * bfhi(sv[nb].y))};
        }
        WG_BAR();
    }
}

__device__ __forceinline__ f32x4 bf4(u32x2 v) { return (f32x4){bflo(v.x), bfhi(v.x), bflo(v.y), bfhi(v.y)}; }
__device__ __forceinline__ void ffn_fixup(int pm, const bf16* hbnd, const float* cw, const float* cb, bf16* act) {
    int tid = threadIdx.x; asm volatile("" : "+v"(tid));
    for (int idx = tid; idx < DFF / 4; idx += NTHREADS) {
        const int c4 = idx * 4;
        const f32x4 wv0 = *(const f32x4*)(cw + c4), wv1 = *(const f32x4*)(cw + NUP + c4), wv2 = *(const f32x4*)(cw + 2 * NUP + c4), bv = *(const f32x4*)(cb + c4);
        const f32x4 wg0 = *(const f32x4*)(cw + DFF + c4), wg1 = *(const f32x4*)(cw + NUP + DFF + c4), wg2 = *(const f32x4*)(cw + 2 * NUP + DFF + c4), bg = *(const f32x4*)(cb + DFF + c4);
        u32x2 hv[2][4], hg[2][4];
#pragma unroll
        for (int bb = 0; bb < 2; ++bb) {
            const int blk = 2 * pm + bb; const bool first = (blk & 63) == 0;
#pragma unroll
            for (int k = 0; k < 4; ++k) {
                const int sb = k < 2 ? blk - 1 : blk, slot = k < 2 ? k + 2 : k - 2;
                const bf16* p = hbnd + ((size_t)(sb * 4 + slot) * 2) * DFF + c4;
                if (k < 2 && first) { hv[bb][k] = (u32x2){0u, 0u}; hg[bb][k] = (u32x2){0u, 0u}; }
                else { hv[bb][k] = *(const u32x2*)p; hg[bb][k] = *(const u32x2*)(p + DFF); }
            }
        }
#pragma unroll
        for (int bb = 0; bb < 2; ++bb)
#pragma unroll
            for (int dl = 0; dl < 2; ++dl) {
                const f32x4 vc = wv2 * bf4(hv[bb][2 + dl]) + wv1 * bf4(hv[bb][1 + dl]) + wv0 * bf4(hv[bb][dl]) + bv;
                const f32x4 gc = wg2 * bf4(hg[bb][2 + dl]) + wg1 * bf4(hg[bb][1 + dl]) + wg0 * bf4(hg[bb][dl]) + bg;
                f32x4 a;
#pragma unroll
                for (int e = 0; e < 4; ++e) a[e] = vc[e] * silu(gc[e]);
                *(u32x2*)(act + ((size_t)(2 * pm + bb) * 128 + dl) * DFF + c4) = (u32x2){pk(a[0], a[1]), pk(a[2], a[3])};
            }
    }
}

__device__ __forceinline__ void phase_final(const bf16* xb, float* out, const float* ssq, const float* fg, int G) {
    int tid = threadIdx.x; asm volatile("" : "+v"(tid));
    const int lane = tid & 63, wave = tid >> 6;
    for (int m = blockIdx.x * NWAVES + wave; m < M; m += G * NWAVES) {
        const f32x4* sp = (const f32x4*)(ssq + (size_t)m * 16);
        const f32x4 s = (sp[0] + sp[1]) + (sp[2] + sp[3]);
        const float rstd = rsqrtf(((s[0] + s[1]) + (s[2] + s[3])) * (1.f / D) + EPS);
        const u32x4* xr = (const u32x4*)(xb + (size_t)m * D) + lane; f32x4* orow = (f32x4*)(out + (size_t)m * D) + 2 * lane; const f32x4* gr = (const f32x4*)fg + 2 * lane;
#pragma unroll
        for (int j = 0; j < 2; ++j) { const u32x4 w = xr[64 * j];
            orow[128 * j] = (f32x4){bflo(w.x), bfhi(w.x), bflo(w.y), bfhi(w.y)} * rstd * gr[128 * j];
            orow[128 * j + 1] = (f32x4){bflo(w.z), bfhi(w.z), bflo(w.w), bfhi(w.w)} * rstd * gr[128 * j + 1]; }
    }
}


#ifndef DEBUG_SCAN
#define DEBUG_SCAN 0
#endif
__device__ __forceinline__ void scan_bf16(const bf16* p, size_t n, int* flags, int code, int G) {
    int tid = threadIdx.x; asm volatile("" : "+v"(tid));
    const u32x4* q = (const u32x4*)p; const size_t n16 = n / 8; bool bad = false, huge = false;
    for (size_t i = (size_t)blockIdx.x * NTHREADS + tid; i < n16; i += (size_t)G * NTHREADS) { const u32x4 w = q[i];
#pragma unroll
        for (int e = 0; e < 4; ++e) { const unsigned x = w[e]; if ((x & 0x7f80u) == 0x7f80u || (x & 0x7f800000u) == 0x7f800000u) bad = true; if (fabsf(bflo(x)) > 1e4f || fabsf(bfhi(x)) > 1e4f) huge = true; } }
    if (bad) flags[code] = 1; if (huge) flags[64 + code] = 1;
}
__device__ __forceinline__ void scan_f32(const float* p, size_t n, int* flags, int code, int G) {
    int tid = threadIdx.x; asm volatile("" : "+v"(tid));
    bool bad = false, huge = false;
    for (size_t i = (size_t)blockIdx.x * NTHREADS + tid; i < n; i += (size_t)G * NTHREADS) { const unsigned x = __float_as_uint(p[i]); if ((x & 0x7f800000u) == 0x7f800000u) bad = true; if (fabsf(p[i]) > 1e4f) huge = true; }
    if (bad) flags[code] = 1; if (huge) flags[64 + code] = 1;
}
#define XB_TMO      128
#define XB_XCNT(j)  (256  + 64 * (j))
#define XB_XSUB(j)  (1280 + 64 * (j))
#define XB_XGEN(j)  (2304 + 64 * (j))
#define XB_TOP      3328
#define XB_TOPGEN   3392
#define XCD_BAR_WORDS 3456
#define XB_SPIN_CAP (1u << 18)

__device__ __forceinline__ unsigned xb_ld(unsigned* p)              { return __hip_atomic_load(p, __ATOMIC_RELAXED, __HIP_MEMORY_SCOPE_AGENT); }
__device__ __forceinline__ unsigned xb_add(unsigned* p, unsigned v) { return __hip_atomic_fetch_add(p, v, __ATOMIC_RELAXED, __HIP_MEMORY_SCOPE_AGENT); }
__device__ __forceinline__ unsigned xb_xcc_id() { return (unsigned)__builtin_amdgcn_s_getreg((3 << 11) | 20) & 0xFu; }
#define XB_SPIN(cond, bar) do { unsigned _sp = 0; while (cond) { __builtin_amdgcn_s_sleep(1); \
    if ((++_sp & 255u) == 0u) { if (xb_ld(&(bar)[XB_TMO])) break; if (_sp > XB_SPIN_CAP) { atomicAdd(&(bar)[XB_TMO], 1u); break; } } } } while (0)

struct XcdBarrier {
    unsigned* bar; unsigned x;
    volatile LAS unsigned* st;
};

__device__ __forceinline__ XcdBarrier xcd_barrier_post(unsigned* bar, volatile LAS unsigned* st) {
    XcdBarrier b; b.bar = bar; b.x = xb_xcc_id(); b.st = st;
    if (threadIdx.x == 0) (void)xb_add(&bar[XB_XCNT(b.x)], 1u);
    return b;
}
__device__ __forceinline__ void xcd_barrier_complete(unsigned* bar, unsigned x, unsigned& nloc, unsigned& nx) {
    const unsigned G = gridDim.x * gridDim.y * gridDim.z;
    unsigned sum, cnt, mine, sp = 0u;
    for (;;) {
        sum = 0u; cnt = 0u; mine = 0u;
#pragma unroll
        for (unsigned j = 0; j < 16; ++j) { const unsigned c = xb_ld(&bar[XB_XCNT(j)]); sum += c; cnt += (c > 0u) ? 1u : 0u; mine = (j == x) ? c : mine; }
        if (sum == G) break;
        __builtin_amdgcn_s_sleep(1);
        if ((++sp & 255u) == 0u) { if (xb_ld(&bar[XB_TMO])) break; if (sp > XB_SPIN_CAP) { atomicAdd(&bar[XB_TMO], 1u); break; } }
    }
    nloc = mine > 0u ? mine : 1u; nx = cnt > 0u ? cnt : 1u;
}

__device__ __forceinline__ void xcd_barrier(const XcdBarrier& b) {
    asm volatile("s_waitcnt vmcnt(0)" ::: "memory");
    __syncthreads();
    if (threadIdx.x == 0) {
        unsigned* bar = b.bar;
        __builtin_amdgcn_s_waitcnt(0);
        unsigned nloc = b.st[0], nx = b.st[1];
        if (nloc == 0u) { xcd_barrier_complete(bar, b.x, nloc, nx); b.st[0] = nloc; b.st[1] = nx; }
        const unsigned old = xb_add(&bar[XB_XSUB(b.x)], 1u);
        const unsigned gen = old / nloc;
        if (old + 1u == (gen + 1u) * nloc) {
            __builtin_amdgcn_fence(__ATOMIC_RELEASE, "agent");
            asm volatile("s_waitcnt vmcnt(0)" ::: "memory");
            const unsigned og = xb_add(&bar[XB_TOP], 1u);
            const unsigned tg = og / nx;
            if (og + 1u == (tg + 1u) * nx) xb_add(&bar[XB_TOPGEN], 1u);
            else XB_SPIN(xb_ld(&bar[XB_TOPGEN]) == tg, bar);
            __builtin_amdgcn_fence(__ATOMIC_ACQUIRE, "agent");
            xb_add(&bar[XB_XGEN(b.x)], 1u);
            asm volatile("s_waitcnt vmcnt(0)" ::: "memory");
        } else {
            XB_SPIN(xb_ld(&bar[XB_XGEN(b.x)]) == gen, bar);
            __builtin_amdgcn_fence(__ATOMIC_ACQUIRE, "agent");
            asm volatile("s_waitcnt vmcnt(0)" ::: "memory");
        }
    }
    __syncthreads();
}

#ifndef ONE_LAUNCH
#define ONE_LAUNCH 1
#endif
constexpr int PH_PER_LAYER = 9, N_PHASES = 1 + DEPTH * PH_PER_LAYER + 1;

__global__ void __launch_bounds__(NTHREADS, 2) trunk_fwd(Args args) {
    extern __shared__ __attribute__((aligned(16))) unsigned char lds_raw[];
    LAS unsigned char* lds = (LAS unsigned char*)lds_raw;
    cg::grid_group grid = cg::this_grid();
    const int G = gridDim.x;
    unsigned char* ws = args.ws;
    float* out = args.out;
    const int lo = args.ph_lo, hi = args.ph_hi;
    float* ssq = (float*)(ws + WS_SSQ); float* dec = (float*)(ws + WS_DEC); bf16* hbnd = (bf16*)(ws + WS_HBND); bf16* xb = (bf16*)(ws + WS_XB);
    bf16 *ub = (bf16*)(ws + WS_U), *hgb = (bf16*)(ws + WS_HG), *qb = (bf16*)(ws + WS_Q), *vb = (bf16*)(ws + WS_V), *sob = (bf16*)(ws + WS_SO), *pooled = (bf16*)(ws + WS_POOL);
    bf16 *UT = (bf16*)(ws + WS_UT), *gates = (bf16*)(ws + WS_GATES), *merged = (bf16*)(ws + WS_MERGED), *act = (bf16*)(ws + WS_ACT);
    bf16* gl = (bf16*)(ws + WS_G);
#ifndef PHASE_MASK
#define PHASE_MASK 0xfff
#endif
#define EN(j) (((PHASE_MASK) >> (j)) & 1)
#define IN(k) (lo <= (k) && (k) < hi)
#define SC(k) (DEBUG_SCAN && lo == (k) && hi == (k) - 1)
    volatile LAS unsigned* MISC = (volatile LAS unsigned*)(lds + 131072 + 512);
    { int t_ = threadIdx.x; asm volatile("" : "+v"(t_)); if (t_ < 32) MISC[t_] = 0u; }
    __syncthreads();
    XcdBarrier bar = xcd_barrier_post((unsigned*)(ws + WS_BAR), MISC + 8);
#ifndef PROBE_A
#define PROBE_A -1
#define PROBE_B -1
#endif
    unsigned long long* tsb = (unsigned long long*)(ws + 4096);
#define STAMP(k) do { if (PROBE_A >= 0 && blockIdx.x == 0) { int t_ = threadIdx.x; asm volatile("" : "+v"(t_)); if (t_ == 0) tsb[(k)] = __builtin_amdgcn_s_memrealtime(); } } while (0)
#define SEAM(k) do { if (IN(k) && IN((k) + 1)) { if ((k) == 0) grid.sync(); else xcd_barrier(bar); } STAMP((k) + 1); } while (0)
    STAMP(0);

    int* dbg = (int*)ws;
    if (EN(9) && IN(0)) { if (DEBUG_SCAN && blockIdx.x == 0) { int t_ = threadIdx.x; asm volatile("" : "+v"(t_)); if (t_ < 128) dbg[t_] = 0; } phase_prologue(args, lds, G); }
    SEAM(0);
    for (int l = 0; l < DEPTH; ++l) {
        const int pb = 1 + l * PH_PER_LAYER;
        unsigned char* wl = ws + WS_W + (size_t)l * W_LAYER;
        const bf16* Win = (const bf16*)(wl + WO_IN);
        if (EN(0) && IN(pb + 0)) {
            pg8::Gemm g{xb, Win, M, NMIX, D}; pg8::StaticOrder S; S.init(M, NMIX, G, (int)blockIdx.x);
            EpiInMix E{ub, qb, vb, sob, gl, ssq, (const float*)(ws + WS_LB) + l * HW, gates, args.in[3] + l * NGATE, 0};
            pg8::gemm_phase<EpiInMix, pg8::StaticOrder, true, true>(lds, g, S, E);
        }
        SEAM(pb + 0);
        if (SC(pb + 1)) { const int cb_ = 20 * l; scan_bf16(ub, (size_t)M * 512, dbg, cb_ + 1, G); scan_bf16(qb, (size_t)M * 512, dbg, cb_ + 2, G); scan_bf16(vb, (size_t)M * 512, dbg, cb_ + 3, G); scan_bf16(sob, (size_t)M * 512, dbg, cb_ + 4, G); scan_bf16(gl, (size_t)M * 512, dbg, cb_ + 5, G); }
        if (EN(1) && IN(pb + 1)) { phase_fir(ub, pooled, G); phase_h1(lds, gl, vb, UT, dec, G); }
        SEAM(pb + 1);
        if (SC(pb + 2)) { const int cb_ = 20 * l; scan_bf16(pooled, (size_t)M * 512, dbg, cb_ + 6, G); scan_bf16(UT, (size_t)NUNIT * 16384, dbg, cb_ + 7, G); scan_f32(dec, (size_t)NUNIT * 128, dbg, cb_ + 8, G); }
        if (EN(2) && IN(pb + 2)) phase_h2(UT, dec, G);
        SEAM(pb + 2);
        if (SC(pb + 3)) { scan_bf16(UT, (size_t)NUNIT * 16384, dbg, 20 * l + 9, G); }
        if (EN(3) && IN(pb + 3)) phase_h3(lds, qb, gl, vb, sob, UT, args.in[7] + l * HD, hgb, G);
        SEAM(pb + 3);
        if (SC(pb + 4)) { scan_bf16(gates, (size_t)M * 2048, dbg, 20 * l + 11, G); }
        if (EN(4) && IN(pb + 4)) {
            pg8::Gemm g{xb, Win + (size_t)NMIX * D, M, NGATE, D}; pg8::StaticOrder S; S.init(M, NGATE, G, (int)blockIdx.x);
            EpiInMix E{ub, qb, vb, sob, gl, ssq, (const float*)(ws + WS_LB) + l * HW, gates, args.in[3] + l * NGATE, 10};
            pg8::gemm_phase<EpiInMix, pg8::StaticOrder, true, true>(lds, g, S, E);
        }
        SEAM(pb + 4);
        if (EN(5) && IN(pb + 5)) {
            { pg8::Gemm g{pooled, (const bf16*)(wl + WO_A), M, D, PW}; pg8::StaticOrder S; S.init(M, D, G, (int)blockIdx.x);
              EpiMerge<false> E{merged, gates};
              pg8::gemm_phase<EpiMerge<false>, pg8::StaticOrder, true, true>(lds, g, S, E); }
            VM_WAIT(); __syncthreads();
            { pg8::Gemm g{hgb, (const bf16*)(wl + WO_PB), M, D, HW}; pg8::StaticOrder S; S.init(M, D, G, (int)blockIdx.x);
              EpiMerge<true> E{merged, gates};
              pg8::gemm_phase<EpiMerge<true>, pg8::StaticOrder, true, true>(lds, g, S, E); }
        }
        SEAM(pb + 5);
        if (SC(pb + 6)) { scan_bf16(merged, (size_t)M * 1024, dbg, 20 * l + 12, G); }
        if (EN(6) && IN(pb + 6)) {
            pg8::Gemm g{merged, (const bf16*)(wl + WO_O), M, D, D}; pg8::StaticOrder S; S.init(M, D, G, (int)blockIdx.x);
            EpiRes<false> E{out, xb, ssq};
            pg8::gemm_phase<EpiRes<false>, pg8::StaticOrder, true, true>(lds, g, S, E);
        }
        SEAM(pb + 6);
        if (SC(pb + 7)) { scan_f32(out, (size_t)M * 1024, dbg, 20 * l + 13, G); scan_bf16(xb, (size_t)M * 1024, dbg, 20 * l + 14, G); scan_f32(ssq, (size_t)M * 16, dbg, 20 * l + 15, G); }
        if (EN(7) && IN(pb + 7)) {
            pg8::Gemm g{xb, (const bf16*)(wl + WO_UP), M, NUP, D}; pg8::StaticOrder S; S.init(M, NUP, G, (int)blockIdx.x);
            EpiUpConv E{act, hbnd, ssq, args.in[13] + (size_t)l * 3 * NUP, args.in[14] + (size_t)l * NUP};
            pg8::gemm_phase<EpiUpConv, pg8::StaticOrder, true, true, true>(lds, g, S, E);
        }
        SEAM(pb + 7);
        if (SC(pb + 8)) { scan_bf16(act, (size_t)M * DFF, dbg, 20 * l + 16, G); scan_bf16(hbnd, (size_t)128 * 4 * 2 * DFF, dbg, 20 * l + 17, G); }
        if (EN(8) && IN(pb + 8)) {
            pg8::StaticOrder S; S.init(M, D, G, (int)blockIdx.x);
            pg8::Unit un;
            for (int i = 0; S.next(i, un); ++i) ffn_fixup(un.pm, hbnd, args.in[13] + (size_t)l * 3 * NUP, args.in[14] + (size_t)l * NUP, act);
            VM_WAIT(); __builtin_amdgcn_fence(__ATOMIC_ACQ_REL, "agent"); __syncthreads();
            pg8::Gemm g{act, (const bf16*)(wl + WO_DN), M, D, DFF};
            EpiRes<false> E{out, xb, ssq}; pg8::gemm_phase<EpiRes<false>, pg8::StaticOrder, true, true>(lds, g, S, E);
        }
        SEAM(pb + 8);
    }
    if (SC(N_PHASES - 1)) {
        scan_f32(out, (size_t)M * 1024, dbg, 58, G); scan_f32(ssq, (size_t)M * 16, dbg, 59, G);
        __syncthreads();
    }
    if (EN(10) && IN(N_PHASES - 1)) phase_final(xb, out, ssq, args.in[16], G);
    if (DEBUG_SCAN && IN(N_PHASES)) {
        int t_ = threadIdx.x; asm volatile("" : "+v"(t_));
        int c1 = -1, c2 = -1; for (int i = 63; i >= 0; --i) { if (dbg[i]) c1 = i; if (dbg[64 + i]) c2 = i; }
        const float cval = 100.f * (float)(c2 + 2);
        for (size_t i = (size_t)blockIdx.x * NTHREADS + t_; i < (size_t)M * D; i += (size_t)G * NTHREADS) out[i] = (i == 0) ? 1e4f * (float)(c1 + 1) : cval;
    }
    if (PROBE_A >= 0 && blockIdx.x == 0) {
        int t_ = threadIdx.x; asm volatile("" : "+v"(t_));
        if (t_ == 0) {
            STAMP(N_PHASES);
            __builtin_amdgcn_fence(__ATOMIC_ACQ_REL, "agent");
            const unsigned long long da = tsb[PROBE_A + 1] - tsb[PROBE_A], db = PROBE_B >= 0 ? tsb[PROBE_B + 1] - tsb[PROBE_B] : 0ull;
            const unsigned long long spin = 4ull * da + 204800ull * (db / 3200ull);
            const unsigned long long t0 = __builtin_amdgcn_s_memrealtime();
            while (__builtin_amdgcn_s_memrealtime() - t0 < spin) __builtin_amdgcn_s_sleep(32);
        }
    }
#undef IN
#undef SEAM
}

extern "C" void kernel_launch(void* const* d_in, const int* in_sizes, int n_in, void* d_out, int out_size, void* d_ws, size_t ws_size, hipStream_t stream) {
    static int grid = 0;
    if (grid == 0) {
        if (n_in != 17 || in_sizes[0] != M * D || out_size != M * D || ws_size < WS_END) { fprintf(stderr, "kernel_launch: unexpected shapes (n_in %d, in0 %d, out %d, ws %zu)\n", n_in, n_in > 0 ? in_sizes[0] : -1, out_size, ws_size); grid = -1; return; }
        int dev = 0, cus = 0, per_cu = 0;
        hipGetDevice(&dev); hipDeviceGetAttribute(&cus, hipDeviceAttributeMultiprocessorCount, dev);
        if (hipFuncSetAttribute((const void*)trunk_fwd, hipFuncAttributeMaxDynamicSharedMemorySize, LDS_BYTES) != hipSuccess) { fprintf(stderr, "kernel_launch: hipFuncSetAttribute failed\n"); grid = -1; return; }
        if (hipOccupancyMaxActiveBlocksPerMultiprocessor(&per_cu, (const void*)trunk_fwd, NTHREADS, LDS_BYTES) != hipSuccess || per_cu < 1) { fprintf(stderr, "kernel_launch: occupancy query says %d\n", per_cu); per_cu = 1; }
        (void)hipGetLastError();
        grid = cus * 1;
        fprintf(stderr, "kernel_launch: grid %d (cus %d, per_cu %d)\n", grid, cus, per_cu);
    }
    if (grid < 0) return;
    Args a{};
    for (int i = 0; i < 17; ++i) a.in[i] = (const float*)d_in[i];
    a.out = (float*)d_out; a.ws = (unsigned char*)d_ws;
#if ONE_LAUNCH
    if (hipMemsetAsync((char*)d_ws + WS_BAR, 0, BAR_BYTES, stream) != hipSuccess) { fprintf(stderr, "kernel_launch: memset failed\n"); return; }
    a.ph_lo = 0; a.ph_hi = N_PHASES;
    void* kargs[] = {&a};
    hipError_t e = hipLaunchCooperativeKernel((const void*)trunk_fwd, dim3(grid), dim3(NTHREADS), kargs, LDS_BYTES, stream);
    if (e != hipSuccess) fprintf(stderr, "kernel_launch: cooperative launch failed: %s (grid %d)\n", hipGetErrorString(e), grid);
#else
    for (int p = 0; p < N_PHASES + (DEBUG_SCAN ? 1 : 0); ++p) {
        if (DEBUG_SCAN && p > 0 && p < N_PHASES) { a.ph_lo = p; a.ph_hi = p - 1; hipLaunchKernelGGL(trunk_fwd, dim3(grid), dim3(NTHREADS), LDS_BYTES, stream, a); }
        a.ph_lo = p; a.ph_hi = p + 1;
        hipLaunchKernelGGL(trunk_fwd, dim3(grid), dim3(NTHREADS), LDS_BYTES, stream, a);
    }
#endif
}
```

```cpp
#include <hip/hip_runtime.h>
#include <hip/hip_cooperative_groups.h>
#include <cstdio>
#include <cstdint>
namespace cg = cooperative_groups;
namespace pg8 {
#define PG8_LAS __attribute__((address_space(3)))
typedef unsigned short bf16_t;
typedef short bf16x8 __attribute__((ext_vector_type(8)));
typedef float f32x4 __attribute__((ext_vector_type(4)));
typedef unsigned u32x4 __attribute__((ext_vector_type(4)));
constexpr int BM = 256, BK = 64, HALF = 128, HTB = HALF * BK * 2  , STAGE_BYTES = 8 * HTB, NXCD = 8, WGM = 8;

__host__ __device__ __forceinline__ int lds_byte(int r, int c) { const int st = (r >> 4) * 2 + (c >> 5), rr = r & 15, cc = c & 31, ob = rr * 64 + cc * 2; return st * 1024 + (ob ^ (((ob >> 9) & 1) << 5)); }
__host__ __device__ __forceinline__ void stage_rc(int b, int& R, int& C) { const int st = b / 1024, sb = b % 1024, swz = sb ^ (((sb >> 9) & 1) << 5); R = (st >> 1) * 16 + swz / 64; C = (st & 1) * 32 + (swz % 64) / 2; }
__host__ __device__ __forceinline__ int perm32(int rho) { const int n = rho >> 4, i = rho & 15; return 8 * (i >> 2) + 4 * n + (i & 3); }

struct Unit { int pm, pn; };
struct Gemm { const bf16_t* A; const bf16_t* Bt; int M, N, K; };

struct StaticOrder {
    int nM, nN, nwg, G, c;
    __host__ __device__ void init(int M, int N, int G_, int c_) { nM = M / BM; nN = N / BM; nwg = nM * nN; G = G_; c = c_; }
    __host__ __device__ bool next(int i, Unit& u) const {
        const long L = (long)i * G + c; if (L >= nwg) return false;
        int wgid = (int)L; { const int q = nwg / NXCD, r = nwg % NXCD, xcd = wgid % NXCD, off = wgid / NXCD; wgid = (xcd < r ? xcd * (q + 1) : r * (q + 1) + (xcd - r) * q) + off; }
        const int nig = WGM * nN, gid = wgid / nig, fm = gid * WGM, gsz = (nM - fm) < WGM ? (nM - fm) : WGM;
        u.pm = fm + ((wgid % nig) % gsz); u.pn = (wgid % nig) / gsz; return true;
    }
    __device__ __forceinline__ void a_ready(const Unit&) const {}
    __device__ __forceinline__ void done(const Unit&) const {}
};

__device__ __forceinline__ unsigned cvt_pk_bf16(float lo, float hi) { unsigned r; asm volatile("v_cvt_pk_bf16_f32 %0, %1, %2" : "=v"(r) : "v"(lo), "v"(hi)); return r; }
typedef float f32x2 __attribute__((ext_vector_type(2)));
template <class Epi, class Sched, bool ALIGN_EPI = false, bool SP2 = false, bool ROWPERM = false>
__device__ __forceinline__ void gemm_phase(PG8_LAS unsigned char* lds, const Gemm g, const Sched& S, const Epi& E) {
    int tid = threadIdx.x; asm volatile("" : "+v"(tid));
    const int wid = __builtin_amdgcn_readfirstlane(tid >> 6), lane = tid & 63, wr = wid >> 2, wc = wid & 3, fr = lane & 15, fq = lane >> 4;
    const int K = g.K, nt = K / BK;
    unsigned voffA[2], voffB[2];
#pragma unroll
    for (int i = 0; i < 2; ++i) { int R, C; stage_rc(tid * 16 + i * 8192, R, C); const int Rb = Epi::PERM ? ((R & ~31) + perm32(R & 31)) : R;
        const int Ra = ROWPERM ? (128 * (R >> 6) + 8 * (R & 15) + ((R >> 4) & 3)) : R;
        voffA[i] = (unsigned)(Ra * K + C) * 2u; voffB[i] = (unsigned)(Rb * K + C) * 2u; }
    const size_t kstep = (size_t)(BK * 2);
    const size_t hstep = (size_t)HALF * K * 2;
    const size_t hstepA = ROWPERM ? (size_t)4 * K * 2 : hstep;
    const size_t tstep = 2 * hstep;
    const unsigned ldsw = (unsigned)wid * 1024u;
    const int aoff = lds_byte(wr * 64 + fr, fq * 8), boff = lds_byte(wc * 32 + fr, fq * 8);
#define PG8_SA(b, h) (((b) * 2 + (h)) * HTB)
#define PG8_SB(b, h) ((4 + (b) * 2 + (h)) * HTB)
#define PG8_STAGE(bufoff, gbase, voff) do { _Pragma("unroll") for (int _i = 0; _i < 2; ++_i) \
        __builtin_amdgcn_global_load_lds((const unsigned*)((const char*)(gbase) + (voff)[_i]), (PG8_LAS unsigned*)(lds + (bufoff) + ldsw + _i * 8192), 16, 0, 0); } while (0)
#define PG8_LDA(dst, b, h) do { _Pragma("unroll") for (int m = 0; m < 4; ++m) _Pragma("unroll") for (int k = 0; k < 2; ++k) dst[m][k] = *(const PG8_LAS bf16x8*)(lds + PG8_SA(b, h) + aoff + m * 2048 + k * 1024); } while (0)
#define PG8_LDB(dst, b, h) do { _Pragma("unroll") for (int n = 0; n < 2; ++n) _Pragma("unroll") for (int k = 0; k < 2; ++k) dst[n][k] = *(const PG8_LAS bf16x8*)(lds + PG8_SB(b, h) + boff + n * 2048 + k * 1024); } while (0)
#define PG8_MMA(ai, bj, At, Bt) do { __builtin_amdgcn_s_setprio(1); _Pragma("unroll") for (int m = 0; m < 4; ++m) _Pragma("unroll") for (int n = 0; n < 2; ++n) _Pragma("unroll") for (int k = 0; k < 2; ++k) \
        acc[ai][bj][m][n] = __builtin_amdgcn_mfma_f32_16x16x32_bf16(Bt[n][k], At[m][k], acc[ai][bj][m][n], 0, 0, 0); __builtin_amdgcn_s_setprio(0); } while (0)
#define PG8_WAIT_V(n) asm volatile("s_waitcnt vmcnt(" #n ")" ::: "memory")
#define PG8_WAIT_L(n) asm volatile("s_waitcnt lgkmcnt(" #n ")" ::: "memory")
#define PG8_BAR __builtin_amdgcn_s_barrier()
#define PG8_SCHED __builtin_amdgcn_sched_barrier(0)
    Unit cur, nxt; int ui = 0;
    if (!S.next(0, cur)) return;
    f32x4 acc[2][2][4][2];
#pragma unroll
    for (int a = 0; a < 2; ++a)
#pragma unroll
        for (int b = 0; b < 2; ++b)
#pragma unroll
            for (int m = 0; m < 4; ++m)
#pragma unroll
                for (int n = 0; n < 2; ++n) acc[a][b][m][n] = (f32x4){0.f, 0.f, 0.f, 0.f};
    bf16x8 At[4][2], B0[2][2], B1[2][2];
    const char* cA = (const char*)g.A + (size_t)cur.pm * tstep; const char* cB = (const char*)g.Bt + (size_t)cur.pn * tstep;
    S.a_ready(cur);
    if constexpr (SP2) {
        PG8_STAGE(PG8_SB(0, 0), cB, voffB); PG8_STAGE(PG8_SB(0, 1), cB + hstep, voffB); PG8_STAGE(PG8_SA(0, 0), cA, voffA); PG8_STAGE(PG8_SA(0, 1), cA + hstepA, voffA);
        if (wr == 1) PG8_BAR;
        PG8_WAIT_V(2); PG8_BAR;
        PG8_STAGE(PG8_SB(1, 0), cB + kstep, voffB); PG8_STAGE(PG8_SA(1, 0), cA + kstep, voffA); PG8_STAGE(PG8_SB(1, 1), cB + hstep + kstep, voffB);
        PG8_WAIT_V(6); PG8_BAR;
    } else {
        PG8_STAGE(PG8_SB(0, 0), cB, voffB); PG8_STAGE(PG8_SA(0, 0), cA, voffA); PG8_STAGE(PG8_SB(0, 1), cB + hstep, voffB); PG8_STAGE(PG8_SA(0, 1), cA + hstepA, voffA);
        if (wr == 1) PG8_BAR;
        PG8_WAIT_V(4); PG8_BAR;
        PG8_STAGE(PG8_SB(1, 0), cB + kstep, voffB); PG8_STAGE(PG8_SA(1, 0), cA + kstep, voffA); PG8_STAGE(PG8_SB(1, 1), cB + hstep + kstep, voffB);
        PG8_WAIT_V(6); PG8_BAR;
    }
    for (;;) {
        const bool has_next = S.next(ui + 1, nxt);
        const char* nA = has_next ? (const char*)g.A + (size_t)nxt.pm * tstep : cA; const char* nB = has_next ? (const char*)g.Bt + (size_t)nxt.pn * tstep : cB;
        for (int t = 0; t < nt; t += 2) {
            const bool last = (t == nt - 2);
            const char* a1 = cA + (size_t)(t + 1) * kstep;
            const char* a2 = last ? nA : cA + (size_t)(t + 2) * kstep; const char* b2 = last ? nB : cB + (size_t)(t + 2) * kstep;
            const char* a3 = a2 + kstep; const char* b3 = b2 + kstep;
            if (last && has_next) S.a_ready(nxt);
            if constexpr (SP2) {
            PG8_LDB(B0, 0, 0); PG8_LDB(B1, 0, 1); PG8_SCHED; PG8_LDA(At, 0, 0); PG8_STAGE(PG8_SA(1, 1), a1 + hstepA, voffA);
            PG8_WAIT_V(8); PG8_WAIT_L(0); PG8_BAR; PG8_MMA(0, 0, At, B0); PG8_MMA(0, 1, At, B1); PG8_BAR; PG8_SCHED;
            PG8_LDA(At, 0, 1); PG8_STAGE(PG8_SB(0, 0), b2, voffB); PG8_STAGE(PG8_SB(0, 1), b2 + hstep, voffB); PG8_STAGE(PG8_SA(0, 0), a2, voffA);
            PG8_WAIT_V(8); PG8_WAIT_L(0); PG8_BAR; PG8_MMA(1, 0, At, B0); PG8_MMA(1, 1, At, B1); PG8_BAR; PG8_SCHED;
            PG8_LDB(B0, 1, 0); PG8_LDB(B1, 1, 1); PG8_SCHED; PG8_LDA(At, 1, 0); PG8_STAGE(PG8_SA(0, 1), a2 + hstepA, voffA);
            PG8_WAIT_V(8); PG8_WAIT_L(0); PG8_BAR; PG8_MMA(0, 0, At, B0); PG8_MMA(0, 1, At, B1); PG8_BAR; PG8_SCHED;
            PG8_LDA(At, 1, 1); PG8_STAGE(PG8_SB(1, 0), b3, voffB); PG8_STAGE(PG8_SB(1, 1), b3 + hstep, voffB); PG8_STAGE(PG8_SA(1, 0), a3, voffA);
            PG8_WAIT_V(8); PG8_WAIT_L(0); PG8_BAR; PG8_MMA(1, 0, At, B0); PG8_MMA(1, 1, At, B1); PG8_BAR; PG8_SCHED;
            } else {
            PG8_LDB(B0, 0, 0); PG8_SCHED; PG8_LDA(At, 0, 0); PG8_STAGE(PG8_SA(1, 1), a1 + hstepA, voffA);
            PG8_WAIT_L(8); PG8_BAR; PG8_WAIT_L(0); PG8_MMA(0, 0, At, B0); PG8_BAR; PG8_SCHED;
            PG8_LDB(B1, 0, 1); PG8_STAGE(PG8_SB(0, 0), b2, voffB);
            PG8_BAR; PG8_WAIT_L(0); PG8_MMA(0, 1, At, B1); PG8_BAR;
            PG8_LDA(At, 0, 1); PG8_STAGE(PG8_SA(0, 0), a2, voffA);
            PG8_BAR; PG8_WAIT_L(0); PG8_MMA(1, 0, At, B0); PG8_BAR; PG8_SCHED;
            PG8_STAGE(PG8_SB(0, 1), b2 + hstep, voffB);
            PG8_WAIT_V(6); PG8_BAR; PG8_MMA(1, 1, At, B1); PG8_BAR;
            PG8_LDB(B0, 1, 0); PG8_SCHED; PG8_LDA(At, 1, 0); PG8_STAGE(PG8_SA(0, 1), a2 + hstepA, voffA);
            PG8_WAIT_L(8); PG8_BAR; PG8_WAIT_L(0); PG8_MMA(0, 0, At, B0); PG8_BAR; PG8_SCHED;
            PG8_LDB(B1, 1, 1); PG8_STAGE(PG8_SB(1, 0), b3, voffB);
            PG8_BAR; PG8_WAIT_L(0); PG8_MMA(0, 1, At, B1); PG8_BAR;
            PG8_LDA(At, 1, 1); PG8_STAGE(PG8_SA(1, 0), a3, voffA);
            PG8_BAR; PG8_WAIT_L(0); PG8_MMA(1, 0, At, B0); PG8_BAR; PG8_SCHED;
            PG8_STAGE(PG8_SB(1, 1), b3 + hstep, voffB);
            PG8_WAIT_V(6); PG8_BAR; PG8_MMA(1, 1, At, B1); PG8_BAR;
            }
        }
        if constexpr (ALIGN_EPI) { if (wr == 0) PG8_BAR; }
        if constexpr (!Epi::AFTER_DRAIN) { E(acc, cur, wr, wc, fr, fq); S.done(cur); }
        if (!has_next) break;
#pragma unroll
        for (int a = 0; a < 2; ++a)
#pragma unroll
            for (int b = 0; b < 2; ++b)
#pragma unroll
                for (int m = 0; m < 4; ++m)
#pragma unroll
                    for (int n = 0; n < 2; ++n) acc[a][b][m][n] = (f32x4){0.f, 0.f, 0.f, 0.f};
        cur = nxt; cA = nA; cB = nB; ++ui;
        if constexpr (ALIGN_EPI) { if (wr == 1) PG8_BAR; }
    }
    PG8_WAIT_V(0);
    if constexpr (!ALIGN_EPI) { if (wr == 0) PG8_BAR; }
    PG8_BAR;
    if constexpr (Epi::AFTER_DRAIN) { E.fused(acc, cur, wr, wc, fr, fq, lds, wid, lane); S.done(cur); }
#undef PG8_SA
#undef PG8_SB
#undef PG8_STAGE
#undef PG8_LDA
#undef PG8_LDB
#undef PG8_MMA
#undef PG8_WAIT_V
#undef PG8_WAIT_L
#undef PG8_BAR
#undef PG8_SCHED
}
}

constexpr int BATCH = 2, SEQ = 8192, D = 1024, M = BATCH * SEQ, DEPTH = 2;
constexpr int PW = 512, HW = 512, NH = 4, HD = 128, CH = 64, NCH = SEQ / CH, NBH = BATCH * NH, NUNIT = NBH * NCH;
constexpr int IN_COLS = 4608, NMIX = 2560, NGATE = 2048, DFF = 2816, NUP = 2 * DFF;
constexpr float EPS = 1e-6f;
constexpr int NWAVES = 8, NTHREADS = 512;
constexpr int LDS_BYTES = 147456;

constexpr size_t MiB = 1u << 20;
constexpr size_t WS_BAR = 512 * 1024, BAR_BYTES = 16384;
constexpr size_t WS_SSQ = 1 * MiB;
constexpr size_t WS_DEC = 2 * MiB;
constexpr size_t WS_LB = 2 * MiB + 768 * 1024;
constexpr size_t WS_HBND = 3 * MiB;
constexpr size_t WS_W = 9 * MiB, W_LAYER = 29 * MiB + 512 * 1024;
constexpr size_t WO_IN = 0, WO_A = 9 * MiB, WO_PB = 10 * MiB, WO_O = 11 * MiB, WO_UP = 13 * MiB, WO_DN = 24 * MiB;
constexpr size_t WS_XB = 68 * MiB;
constexpr size_t WS_R = 100 * MiB;
constexpr size_t WS_U = WS_R, WS_HG = WS_R, WS_Q = WS_R + 16 * MiB, WS_V = WS_R + 32 * MiB, WS_SO = WS_R + 48 * MiB, WS_G = WS_R + 64 * MiB;
constexpr size_t WS_POOL = WS_R + 96 * MiB, WS_UT = WS_R + 112 * MiB, WS_GATES = WS_R + 16 * MiB, WS_MERGED = WS_R + 112 * MiB, WS_ACT = WS_R;
constexpr size_t WS_XF = WS_R + 88 * MiB;
constexpr size_t WS_END = 256 * MiB;
static_assert(WS_UT + 32 * MiB <= WS_END && WS_ACT + (size_t)M * DFF * 2 <= WS_END && WS_GATES + 64 * MiB <= WS_POOL, "ws map");

#define LAS __attribute__((address_space(3)))
typedef unsigned short bf16;
typedef unsigned u32x4 __attribute__((ext_vector_type(4)));
typedef unsigned u32x2 __attribute__((ext_vector_type(2)));
typedef float f32x4 __attribute__((ext_vector_type(4)));
typedef float f32x2 __attribute__((ext_vector_type(2)));
typedef short bf16x8 __attribute__((ext_vector_type(8)));

__device__ __forceinline__ float bflo(unsigned w) { return __uint_as_float(w << 16); }
__device__ __forceinline__ float bfhi(unsigned w) { return __uint_as_float(w & 0xffff0000u); }
typedef __bf16 bf16x2_t __attribute__((ext_vector_type(2)));
__device__ __forceinline__ unsigned pk(float lo, float hi) { const bf16x2_t v = __builtin_convertvector((f32x2){lo, hi}, bf16x2_t); return __builtin_bit_cast(unsigned, v); }
__device__ __forceinline__ float sigm(float x) { return 1.f / (1.f + __expf(-x)); }
__device__ __forceinline__ float silu(float x) { return x * sigm(x); }
__device__ __forceinline__ float wave_sum(float v) {
#pragma unroll
    for (int o = 1; o < 64; o <<= 1) v += __shfl_xor(v, o);
    return v;
}
__device__ __forceinline__ float dpp_shr1(float x) { return __int_as_float(__builtin_amdgcn_update_dpp(0, __float_as_int(x), 0x111, 0xf, 0xf, true)); }
#define LDS_WAIT() asm volatile("s_waitcnt lgkmcnt(0)" ::: "memory")
#define VM_WAIT() asm volatile("s_waitcnt vmcnt(0)" ::: "memory")

__device__ __forceinline__ float load_rs(const float* ssq, int row0, int lane) {
    const f32x4* p = (const f32x4*)(ssq + (size_t)(row0 + lane) * 16);
    const f32x4 a = p[0], b = p[1], c = p[2], d = p[3];
    const f32x4 s = (a + b) + (c + d);
    return rsqrtf(((s[0] + s[1]) + (s[2] + s[3])) * (1.f / D) + EPS);
}

struct EpiInMix {
    static constexpr bool PERM = true, AFTER_DRAIN = false;
    bf16 *u, *q, *v, *so; bf16* g; const float* ssq; const float* lb; bf16* gates; const float* bgate; int pn_off;
    __device__ __forceinline__ void operator()(const f32x4 (&acc)[2][2][4][2], const pg8::Unit& un0, int wr, int wc, int fr, int fq) const {
        const int lane = fr + 16 * fq;
        pg8::Unit un = un0; un.pn += pn_off;
        float rs[2]; rs[0] = load_rs(ssq, un.pm * 256 + wr * 64, lane); rs[1] = load_rs(ssq, un.pm * 256 + 128 + wr * 64, lane);
        const int sec = un.pn >> 1, colt = (un.pn & 1) * 256 + wc * 32 + 8 * fq, row0 = un.pm * 256 + wr * 64 + fr;
        if (un.pn >= 10) {
            const int col0 = (un.pn - 10) * 256 + wc * 32 + 8 * fq;
            f32x4 bv[2][2];
#pragma unroll
            for (int bj = 0; bj < 2; ++bj)
#pragma unroll
                for (int n = 0; n < 2; ++n) bv[bj][n] = *(const f32x4*)(bgate + col0 + bj * 128 + 4 * n);
#pragma unroll
            for (int ai = 0; ai < 2; ++ai)
#pragma unroll
                for (int m = 0; m < 4; ++m) {
                    const float r = __shfl(rs[ai], 16 * m + fr);
                    bf16* rowp = gates + (size_t)(row0 + ai * 128 + m * 16) * NGATE + col0;
#pragma unroll
                    for (int bj = 0; bj < 2; ++bj) {
                        f32x4 v0 = acc[ai][bj][m][0] * r + bv[bj][0], v1 = acc[ai][bj][m][1] * r + bv[bj][1];
#pragma unroll
                        for (int e = 0; e < 4; ++e) { v0[e] = sigm(v0[e]); v1[e] = sigm(v1[e]); }
                        u32x4 w; w.x = pk(v0[0], v0[1]); w.y = pk(v0[2], v0[3]); w.z = pk(v1[0], v1[1]); w.w = pk(v1[2], v1[3]);
                        *(u32x4*)(rowp + bj * 128) = w;
                    }
                }
        } else if (sec == 2) {
            f32x4 lbv[2][2];
#pragma unroll
            for (int bj = 0; bj < 2; ++bj)
#pragma unroll
                for (int n = 0; n < 2; ++n) lbv[bj][n] = *(const f32x4*)(lb + colt + bj * 128 + 4 * n);
#pragma unroll
            for (int ai = 0; ai < 2; ++ai)
#pragma unroll
                for (int m = 0; m < 4; ++m) {
                    const float r = __shfl(rs[ai], 16 * m + fr);
                    bf16* rowp = g + (size_t)(row0 + ai * 128 + m * 16) * 512 + colt;
#pragma unroll
                    for (int bj = 0; bj < 2; ++bj) {
                        float o[8];
#pragma unroll
                        for (int n = 0; n < 2; ++n) { const f32x4 z = acc[ai][bj][m][n] * r;
#pragma unroll
                            for (int e = 0; e < 4; ++e) { const float l = lbv[bj][n][e]; o[4 * n + e] = __logf(l + (1.f - l) * sigm(z[e])); } }
                        u32x4 w; w.x = pk(o[0], o[1]); w.y = pk(o[2], o[3]); w.z = pk(o[4], o[5]); w.w = pk(o[6], o[7]);
                        *(u32x4*)(rowp + bj * 128) = w;
                    }
                }
        } else {
            bf16* base = sec == 0 ? u : (sec == 1 ? q : (sec == 3 ? v : so));
            const bool act = (sec == 1 || sec == 4);
#pragma unroll
            for (int ai = 0; ai < 2; ++ai)
#pragma unroll
                for (int m = 0; m < 4; ++m) {
                    const float r = __shfl(rs[ai], 16 * m + fr);
                    bf16* rowp = base + (size_t)(row0 + ai * 128 + m * 16) * 512 + colt;
#pragma unroll
                    for (int bj = 0; bj < 2; ++bj) {
                        f32x4 v0 = acc[ai][bj][m][0] * r, v1 = acc[ai][bj][m][1] * r;
                        if (act) {
#pragma unroll
                            for (int e = 0; e < 4; ++e) { v0[e] = silu(v0[e]); v1[e] = silu(v1[e]); }
                        }
                        u32x4 w; w.x = pk(v0[0], v0[1]); w.y = pk(v0[2], v0[3]); w.z = pk(v1[0], v1[1]); w.w = pk(v1[2], v1[3]);
                        *(u32x4*)(rowp + bj * 128) = w;
                    }
                }
        }
    }
};


template <bool SECOND> struct EpiMerge {
    static constexpr bool PERM = true, AFTER_DRAIN = false;
    bf16* merged; const bf16* gates;
    __device__ __forceinline__ void operator()(const f32x4 (&acc)[2][2][4][2], const pg8::Unit& un, int wr, int wc, int fr, int fq) const {
        const int col0 = un.pn * 256 + wc * 32 + 8 * fq, row0 = un.pm * 256 + wr * 64 + fr;
#pragma unroll
        for (int ai = 0; ai < 2; ++ai)
#pragma unroll
            for (int m = 0; m < 4; ++m) {
                const size_t row = (size_t)(row0 + ai * 128 + m * 16);
#pragma unroll
                for (int bj = 0; bj < 2; ++bj) {
                    const u32x4 gw = *(const u32x4*)(gates + row * NGATE + (SECOND ? 1024 : 0) + col0 + bj * 128);
                    const f32x4 a0 = acc[ai][bj][m][0], a1 = acc[ai][bj][m][1];
                    float o[8];
                    o[0] = bflo(gw.x) * a0[0]; o[1] = bfhi(gw.x) * a0[1]; o[2] = bflo(gw.y) * a0[2]; o[3] = bfhi(gw.y) * a0[3];
                    o[4] = bflo(gw.z) * a1[0]; o[5] = bfhi(gw.z) * a1[1]; o[6] = bflo(gw.w) * a1[2]; o[7] = bfhi(gw.w) * a1[3];
                    bf16* mp = merged + row * D + col0 + bj * 128;
                    if (SECOND) {
                        const u32x4 ow = *(const u32x4*)mp;
                        o[0] += bflo(ow.x); o[1] += bfhi(ow.x); o[2] += bflo(ow.y); o[3] += bfhi(ow.y);
                        o[4] += bflo(ow.z); o[5] += bfhi(ow.z); o[6] += bflo(ow.w); o[7] += bfhi(ow.w);
                    }
                    u32x4 w; w.x = pk(o[0], o[1]); w.y = pk(o[2], o[3]); w.z = pk(o[4], o[5]); w.w = pk(o[6], o[7]);
                    *(u32x4*)mp = w;
                }
            }
    }
};

template <bool LAST> struct EpiRes {
    static constexpr bool PERM = true, AFTER_DRAIN = false;
    float* out; bf16* xb; float* ssq;
    __device__ __forceinline__ void operator()(const f32x4 (&acc)[2][2][4][2], const pg8::Unit& un, int wr, int wc, int fr, int fq) const {
        const int col0 = un.pn * 256 + wc * 32 + 8 * fq, row0 = un.pm * 256 + wr * 64 + fr;
#pragma unroll
        for (int ai = 0; ai < 2; ++ai)
#pragma unroll
            for (int m = 0; m < 4; ++m) {
                const size_t row = (size_t)(row0 + ai * 128 + m * 16);
                float s = 0.f;
#pragma unroll
                for (int bj = 0; bj < 2; ++bj) {
                    const size_t p = row * D + col0 + bj * 128;
                    const u32x4 bw = *(const u32x4*)(xb + p);
                    const f32x4 x0 = (f32x4){bflo(bw.x), bfhi(bw.x), bflo(bw.y), bfhi(bw.y)} + acc[ai][bj][m][0], x1 = (f32x4){bflo(bw.z), bfhi(bw.z), bflo(bw.w), bfhi(bw.w)} + acc[ai][bj][m][1];
                    s += (x0[0] * x0[0] + x0[1] * x0[1]) + (x0[2] * x0[2] + x0[3] * x0[3]) + (x1[0] * x1[0] + x1[1] * x1[1]) + (x1[2] * x1[2] + x1[3] * x1[3]);
                    if (LAST) { *(f32x4*)(out + p) = x0; *(f32x4*)(out + p + 4) = x1; }
                    else { u32x4 w; w.x = pk(x0[0], x0[1]); w.y = pk(x0[2], x0[3]); w.z = pk(x1[0], x1[1]); w.w = pk(x1[2], x1[3]); *(u32x4*)(xb + p) = w; }
                }
                s += __shfl_xor(s, 16); s += __shfl_xor(s, 32);
                if (fq == 0) ssq[row * 16 + un.pn * 4 + wc] = s;
            }
    }
};

struct EpiUpConv {
    static constexpr bool PERM = false, AFTER_DRAIN = false;
    bf16* act; bf16* hbnd; const float* ssq; const float* cw; const float* cb;
    __device__ __forceinline__ void operator()(f32x4 (&acc)[2][2][4][2], const pg8::Unit& un, int wr, int wc, int fr, int fq) const {
        const int lane = fr + 16 * fq;
        {
            const float rs0 = load_rs(ssq, un.pm * 256 + 128 * wr, lane), rs1 = load_rs(ssq, un.pm * 256 + 128 * wr + 64, lane);
#pragma unroll
            for (int j = 0; j < 8; ++j) { const int src = (8 * fr + j) & 63; const float a = __shfl(rs0, src), b = __shfl(rs1, src); const float r = fr < 8 ? a : b;
#pragma unroll
                for (int bj = 0; bj < 2; ++bj)
#pragma unroll
                    for (int n = 0; n < 2; ++n) acc[j >> 2][bj][j & 3][n] *= r; }
        }
        const size_t tok0 = (size_t)un.pm * 256 + 128 * wr + 8 * fr;
        const int blk = un.pm * 2 + wr;
#pragma unroll
        for (int n = 0; n < 2; ++n) {
            const int ch0 = un.pn * 128 + wc * 32 + 16 * n + 4 * fq;
            if (fr == 15) {
                bf16* hb = hbnd + ((size_t)(blk * 4 + 2) * 2) * DFF + ch0;
                const f32x4 hv6 = acc[1][0][2][n], hv7 = acc[1][0][3][n], hg6 = acc[1][1][2][n], hg7 = acc[1][1][3][n];
                *(u32x2*)(hb) = (u32x2){pk(hv6[0], hv6[1]), pk(hv6[2], hv6[3])}; *(u32x2*)(hb + DFF) = (u32x2){pk(hg6[0], hg6[1]), pk(hg6[2], hg6[3])};
                *(u32x2*)(hb + 2 * DFF) = (u32x2){pk(hv7[0], hv7[1]), pk(hv7[2], hv7[3])}; *(u32x2*)(hb + 3 * DFF) = (u32x2){pk(hg7[0], hg7[1]), pk(hg7[2], hg7[3])};
            }
            if (fr == 0) {
#pragma unroll
                for (int j = 0; j < 2; ++j) { bf16* hb = hbnd + ((size_t)(blk * 4 + j) * 2) * DFF + ch0; const f32x4 hv = acc[0][0][j][n], hg = acc[0][1][j][n];
                    *(u32x2*)(hb) = (u32x2){pk(hv[0], hv[1]), pk(hv[2], hv[3])}; *(u32x2*)(hb + DFF) = (u32x2){pk(hg[0], hg[1]), pk(hg[2], hg[3])}; }
            }
#pragma unroll
            for (int bj = 0; bj < 2; ++bj) {
                const float* cwp = cw + bj * DFF + ch0;
                const f32x4 w0 = *(const f32x4*)(cwp), w1 = *(const f32x4*)(cwp + NUP), w2 = *(const f32x4*)(cwp + 2 * NUP), bb = *(const f32x4*)(cb + bj * DFF + ch0);
                f32x4 m2, m1;
#pragma unroll
                for (int e = 0; e < 4; ++e) { m2[e] = dpp_shr1(acc[1][bj][2][n][e]); m1[e] = dpp_shr1(acc[1][bj][3][n][e]); }
#pragma unroll
                for (int j = 7; j >= 0; --j) {
                    const f32x4 h0 = acc[j >> 2][bj][j & 3][n];
                    const f32x4 hm1 = j >= 1 ? acc[(j - 1 + 8) % 8 >> 2][bj][(j - 1 + 8) % 8 & 3][n] : m1;
                    const f32x4 hm2 = j >= 2 ? acc[(j - 2 + 8) % 8 >> 2][bj][(j - 2 + 8) % 8 & 3][n] : (j == 1 ? m1 : m2);
                    acc[j >> 2][bj][j & 3][n] = w2 * h0 + w1 * hm1 + w0 * hm2 + bb;
                }
            }
#pragma unroll
            for (int j = 0; j < 8; ++j) {
                const f32x4 vc = acc[j >> 2][0][j & 3][n], gc = acc[j >> 2][1][j & 3][n];
                f32x4 a;
#pragma unroll
                for (int e = 0; e < 4; ++e) a[e] = vc[e] * silu(gc[e]);
                if (!(j < 2 && fr == 0)) *(u32x2*)(act + (tok0 + j) * DFF + ch0) = (u32x2){pk(a[0], a[1]), pk(a[2], a[3])};
            }
        }
    }
};

struct Args { const float* in[17]; float* out; unsigned char* ws; int ph_lo, ph_hi; };

struct TrItem { const float* W; const float* rscale; bf16* WT; int K, N, drow0, k0, n0; };
__device__ __forceinline__ void tr_load(const TrItem& t, int lane, float (&wv)[32]) {
#pragma unroll
    for (int i = 0; i < 32; ++i) { const int kk = 2 * i + (lane >> 5); wv[i] = t.W[(size_t)(t.k0 + kk) * t.N + t.n0 + (lane & 31)]; }
    if (t.rscale) {
#pragma unroll
        for (int i = 0; i < 32; ++i) wv[i] *= t.rscale[t.k0 + 2 * i + (lane >> 5)];
    }
}
__device__ __forceinline__ void tr_store(const TrItem& t, int lane, const float (&wv)[32], LAS float* scr) {
#pragma unroll
    for (int i = 0; i < 32; ++i) scr[(2 * i + (lane >> 5)) * 33 + (lane & 31)] = wv[i];
    LDS_WAIT(); asm volatile("" ::: "memory");
    const int c = lane & 7;
#pragma unroll
    for (int j = 0; j < 4; ++j) { const int n = (lane >> 3) + 8 * j; const LAS float* sp = scr + (8 * c) * 33 + n;
        u32x4 o; o.x = pk(sp[0 * 33], sp[1 * 33]); o.y = pk(sp[2 * 33], sp[3 * 33]); o.z = pk(sp[4 * 33], sp[5 * 33]); o.w = pk(sp[6 * 33], sp[7 * 33]);
        *(u32x4*)(t.WT + (size_t)(t.drow0 + n) * t.K + t.k0 + 8 * c) = o; }
    LDS_WAIT(); asm volatile("" ::: "memory");
}
constexpr int I_IN = (D / 64) * (IN_COLS / 32), I_PB = (HW / 64) * (D / 32), I_O = (D / 64) * (D / 32), I_UP = (D / 64) * (NUP / 32), I_DN = (DFF / 64) * (D / 32);
constexpr int I_LAYER = I_IN + I_PB + I_O + I_UP + I_DN;
__device__ __forceinline__ TrItem tr_decode(const Args& a, int it) {
    const int l = it / I_LAYER; int r = it % I_LAYER;
    unsigned char* wl = a.ws + WS_W + (size_t)l * W_LAYER;
    TrItem t;
    if (r < I_IN) { const int nb = IN_COLS / 32; t.k0 = 64 * (r / nb); t.n0 = 32 * (r % nb); t.W = a.in[2] + (size_t)l * D * IN_COLS; t.K = D; t.N = IN_COLS; t.rscale = a.in[1] + l * D; t.WT = (bf16*)(wl + WO_IN); t.drow0 = t.n0; return t; }
    r -= I_IN;
    if (r < I_PB) { const int nb = D / 32; t.k0 = 64 * (r / nb); t.n0 = 32 * (r % nb); t.W = a.in[9] + (size_t)l * HW * D; t.K = HW; t.N = D; t.rscale = nullptr; t.WT = (bf16*)(wl + WO_PB); t.drow0 = t.n0; return t; }
    r -= I_PB;
    if (r < I_O) { const int nb = D / 32; t.k0 = 64 * (r / nb); t.n0 = 32 * (r % nb); t.W = a.in[10] + (size_t)l * D * D; t.K = D; t.N = D; t.rscale = nullptr; t.WT = (bf16*)(wl + WO_O); t.drow0 = t.n0; return t; }
    r -= I_O;
    if (r < I_UP) { const int nb = NUP / 32; t.k0 = 64 * (r / nb); t.n0 = 32 * (r % nb); t.W = a.in[12] + (size_t)l * D * NUP; t.K = D; t.N = NUP; t.rscale = a.in[11] + l * D; t.WT = (bf16*)(wl + WO_UP);
        const int bjs = t.n0 / DFF, rr = t.n0 % DFF; t.drow0 = 256 * (rr / 128) + 128 * bjs + (rr % 128); return t; }
    r -= I_UP;
    { const int nb = D / 32; t.k0 = 64 * (r / nb); t.n0 = 32 * (r % nb); t.W = a.in[15] + (size_t)l * DFF * D; t.K = DFF; t.N = D; t.rscale = nullptr; t.WT = (bf16*)(wl + WO_DN); t.drow0 = t.n0; return t; }
}

__device__ __forceinline__ void convert_items(const Args& a, LAS unsigned char* lds, int it0, int it1, int r, int nr) {
    int tid = threadIdx.x; asm volatile("" : "+v"(tid));
    const int lane = tid & 63, wave = __builtin_amdgcn_readfirstlane(tid >> 6);
    LAS float* scr = (LAS float*)(lds + wave * 16384);
    const int gw = r * NWAVES + wave, NGW = nr * NWAVES;
    for (int it = it0 + gw; it < it1; it += 2 * NGW) {
        const bool two = it + NGW < it1;
        const TrItem t0 = tr_decode(a, it), t1 = tr_decode(a, two ? it + NGW : it);
        float w0[32], w1[32];
        tr_load(t0, lane, w0); if (two) tr_load(t1, lane, w1);
        tr_store(t0, lane, w0, scr); if (two) tr_store(t1, lane, w1, scr);
    }
}
__device__ __forceinline__ void fold_pool(const Args& a, LAS unsigned char* lds, int l0, int l1, int r, int nr) {
    int tid = threadIdx.x; asm volatile("" : "+v"(tid));
    const int lane = tid & 63, wave = __builtin_amdgcn_readfirstlane(tid >> 6);
    unsigned char* ws = a.ws;
    const float *pool_w = a.in[4], *pool_scale = a.in[5], *w_pa = a.in[8];
    LAS float* scr = (LAS float*)(lds + wave * 16384);
    for (int gt = l0 * 65536 + r * NTHREADS + tid; gt < l1 * 65536; gt += nr * NTHREADS) {
        const int l = __builtin_amdgcn_readfirstlane(gt >> 16), rem = gt & 65535, d = rem & 1023, cg8 = __builtin_amdgcn_readfirstlane(rem >> 10), gi = cg8 >> 4, c0 = (cg8 & 15) * 8;
        const float* pw = pool_w + ((size_t)(l * 4 + gi) * 128 + c0) * 128;
        const float* ps = pool_scale + l * PW + gi * 128;
        const float* wp = w_pa + ((size_t)l * PW + gi * 128) * D + d;
        LAS float* pwl = scr;
#pragma unroll
        for (int j = 0; j < 4; ++j) { const int e = j * 256 + lane * 4; const f32x4 v = *(const f32x4*)(pw + e) * *(const f32x4*)(ps + (e & 127)); *(LAS f32x4*)(pwl + e) = v; }
        LDS_WAIT(); asm volatile("" ::: "memory");
        float sacc[8];
#pragma unroll
        for (int i = 0; i < 8; ++i) sacc[i] = 0.f;
#pragma unroll 4
        for (int cp = 0; cp < 128; cp += 4) {
            const float w0 = wp[(size_t)cp * D], w1 = wp[(size_t)(cp + 1) * D], w2 = wp[(size_t)(cp + 2) * D], w3 = wp[(size_t)(cp + 3) * D];
#pragma unroll
            for (int i = 0; i < 8; ++i) { const f32x4 p = *(const LAS f32x4*)(pwl + i * 128 + cp); sacc[i] += (p[0] * w0 + p[1] * w1) + (p[2] * w2 + p[3] * w3); }
        }
        u32x4 o; o.x = pk(sacc[0], sacc[1]); o.y = pk(sacc[2], sacc[3]); o.z = pk(sacc[4], sacc[5]); o.w = pk(sacc[6], sacc[7]);
        *(u32x4*)((bf16*)(ws + WS_W + (size_t)l * W_LAYER + WO_A) + (size_t)d * PW + cg8 * 8) = o;
        LDS_WAIT(); asm volatile("" ::: "memory");
    }
}

__device__ __forceinline__ void phase_prologue(const Args& a, LAS unsigned char* lds, int G, bool lazy) {
    int tid = threadIdx.x; asm volatile("" : "+v"(tid));
    const int lane = tid & 63, wave = __builtin_amdgcn_readfirstlane(tid >> 6);
    unsigned char* ws = a.ws;
    const float *x = a.in[0], *lb_logits = a.in[6];
    const int gw = blockIdx.x * NWAVES + wave, NGW = G * NWAVES;
    convert_items(a, lds, 0, lazy ? I_IN : DEPTH * I_LAYER, (int)blockIdx.x, G);
    if (!lazy) fold_pool(a, lds, 0, DEPTH, (int)blockIdx.x, G);
    if (blockIdx.x == 0) {
        const int chn = tid;
        float mx = -1e30f;
        for (int l = 0; l < DEPTH; ++l) mx = fmaxf(mx, lb_logits[l * HW + chn]);
        float sum = 0.f;
        for (int l = 0; l < DEPTH; ++l) sum += expf(lb_logits[l * HW + chn] - mx);
        float cum = 0.f, c0v = 0.f;
        for (int l = 0; l < DEPTH; ++l) { cum += expf(lb_logits[l * HW + chn] - mx) / sum; if (l == 0) c0v = cum; ((float*)(ws + WS_LB))[l * HW + chn] = cum - c0v; }
    }
    bf16* xb = (bf16*)(ws + WS_XB); float* ssq = (float*)(ws + WS_SSQ);
    for (int m = gw; m < M; m += 4 * NGW) {
        f32x4 v[4][4]; bool ok[4];
#pragma unroll
        for (int q = 0; q < 4; ++q) { const int mq = m + q * NGW; ok[q] = mq < M; const f32x4* xr = (const f32x4*)(x + (size_t)(ok[q] ? mq : m) * D) + lane;
#pragma unroll
            for (int j = 0; j < 4; ++j) v[q][j] = xr[64 * j]; }
#pragma unroll
        for (int q = 0; q < 4; ++q) {
            const int mq = m + q * NGW;
            float sq = 0.f;
#pragma unroll
            for (int j = 0; j < 4; ++j) sq += (v[q][j][0] * v[q][j][0] + v[q][j][1] * v[q][j][1]) + (v[q][j][2] * v[q][j][2] + v[q][j][3] * v[q][j][3]);
            sq = wave_sum(sq);
            if (ok[q]) {
                u32x2* o8 = (u32x2*)(xb + (size_t)mq * D) + lane;
#pragma unroll
                for (int j = 0; j < 4; ++j) o8[64 * j] = (u32x2){pk(v[q][j][0], v[q][j][1]), pk(v[q][j][2], v[q][j][3])};
                if (lane < 16) ssq[(size_t)mq * 16 + lane] = lane == 0 ? sq : 0.f;
            }
        }
    }
}

__device__ __forceinline__ void phase_fir(const bf16* u, bf16* pooled, int G) {
    int tid = threadIdx.x; asm volatile("" : "+v"(tid));
    for (int item = blockIdx.x * NTHREADS + tid; item < (M / 8) * 64; item += G * NTHREADS) {
        const int cgp = item & 63, run = item >> 6, m0 = run * 8, ts = m0 & (SEQ - 1), w = 2 << (cgp >> 4);
        const bf16* up = u + (size_t)m0 * PW + cgp * 8;
        float s[8];
#pragma unroll
        for (int i = 0; i < 8; ++i) s[i] = 0.f;
        for (int d = 1; d < w; ++d) if (ts - d >= 0) {
            const u32x4 x = *(const u32x4*)(up - (size_t)d * PW);
            s[0] += bflo(x.x); s[1] += bfhi(x.x); s[2] += bflo(x.y); s[3] += bfhi(x.y); s[4] += bflo(x.z); s[5] += bfhi(x.z); s[6] += bflo(x.w); s[7] += bfhi(x.w);
        }
#pragma unroll
        for (int r = 0; r < 8; ++r) {
            const u32x4 x = *(const u32x4*)(up + (size_t)r * PW);
            float c[8] = {bflo(x.x), bfhi(x.x), bflo(x.y), bfhi(x.y), bflo(x.z), bfhi(x.z), bflo(x.w), bfhi(x.w)};
#pragma unroll
            for (int i = 0; i < 8; ++i) s[i] += c[i];
            const int cnt = (ts + r + 1) < w ? (ts + r + 1) : w; const float inv = 1.f / (float)cnt;
            u32x4 o; o.x = pk(s[0] * inv - c[0], s[1] * inv - c[1]); o.y = pk(s[2] * inv - c[2], s[3] * inv - c[3]);
            o.z = pk(s[4] * inv - c[4], s[5] * inv - c[5]); o.w = pk(s[6] * inv - c[6], s[7] * inv - c[7]);
            *(u32x4*)(pooled + (size_t)(m0 + r) * PW + cgp * 8) = o;
            if (ts + r - w + 1 >= 0) {
                const u32x4 y = *(const u32x4*)(up + ((ptrdiff_t)r - w + 1) * PW);
                s[0] -= bflo(y.x); s[1] -= bfhi(y.x); s[2] -= bflo(y.y); s[3] -= bfhi(y.y); s[4] -= bflo(y.z); s[5] -= bfhi(y.z); s[6] -= bflo(y.w); s[7] -= bfhi(y.w);
            }
        }
    }
}

__device__ __forceinline__ u32x4 pack_lo8(const unsigned (&v)[8]) { u32x4 o; o.x = (v[0] & 0xffffu) | (v[1] << 16); o.y = (v[2] & 0xffffu) | (v[3] << 16); o.z = (v[4] & 0xffffu) | (v[5] << 16); o.w = (v[6] & 0xffffu) | (v[7] << 16); return o; }
__device__ __forceinline__ u32x4 pack_hi8(const unsigned (&v)[8]) { u32x4 o; o.x = (v[0] >> 16) | (v[1] & 0xffff0000u); o.y = (v[2] >> 16) | (v[3] & 0xffff0000u); o.z = (v[4] >> 16) | (v[5] & 0xffff0000u); o.w = (v[6] >> 16) | (v[7] & 0xffff0000u); return o; }

#define WG_BAR() do { asm volatile("s_waitcnt lgkmcnt(0)" ::: "memory"); __builtin_amdgcn_s_barrier(); asm volatile("" ::: "memory"); } while (0)
__device__ __forceinline__ void phase_h1(LAS unsigned char* lds, const bf16* g, const bf16* vb, bf16* UT, float* dec, int G) {
    int tid = threadIdx.x; asm volatile("" : "+v"(tid));
    const int lane = tid & 63, w = __builtin_amdgcn_readfirstlane(tid >> 6), r16 = lane & 15, q4 = lane >> 4;
    LAS unsigned char* KT = lds; LAS unsigned char* VT = lds + 18432; LAS float* SEG = (LAS float*)(lds + 36864);
    f32x2 gg[8]; unsigned vv[8];
    int unit = blockIdx.x;
    if (unit < NUNIT) {
        const int bh = unit >> 7, c = unit & 127, b = bh >> 2, h = bh & 3;
        const size_t m0 = (size_t)b * SEQ + c * CH + 8 * w; const int col = h * HD + 2 * lane;
#pragma unroll
        for (int r = 0; r < 8; ++r) { { const unsigned gw_ = *(const unsigned*)(g + (m0 + r) * HW + col); gg[r] = (f32x2){bflo(gw_), bfhi(gw_)}; } vv[r] = *(const unsigned*)(vb + (m0 + r) * HW + col); }
    }
    for (; unit < NUNIT; unit += G) {
        f32x2 cs[8]; cs[0] = gg[0];
#pragma unroll
        for (int r = 1; r < 8; ++r) cs[r] = cs[r - 1] + gg[r];
        *(LAS f32x2*)(SEG + w * 128 + 2 * lane) = cs[7];
        *(LAS u32x4*)(VT + (2 * lane) * 144 + w * 16) = pack_lo8(vv); *(LAS u32x4*)(VT + (2 * lane + 1) * 144 + w * 16) = pack_hi8(vv);
        WG_BAR();
        f32x2 pre = {0.f, 0.f}, tot = {0.f, 0.f};
#pragma unroll
        for (int j = 0; j < 8; ++j) { const f32x2 sg = *(const LAS f32x2*)(SEG + j * 128 + 2 * lane); tot += sg; if (j < w) pre += sg; }
        unsigned kt[8];
#pragma unroll
        for (int r = 0; r < 8; ++r) { const f32x2 bb = pre + cs[r];
            kt[r] = pk((1.f - __expf(gg[r].x)) * __expf(tot.x - bb.x), (1.f - __expf(gg[r].y)) * __expf(tot.y - bb.y)); }
        *(LAS u32x4*)(KT + (2 * lane) * 144 + w * 16) = pack_lo8(kt); *(LAS u32x4*)(KT + (2 * lane + 1) * 144 + w * 16) = pack_hi8(kt);
        if (w == 0) *(f32x2*)(dec + (size_t)unit * HD + 2 * lane) = (f32x2){__expf(tot.x), __expf(tot.y)};
        const int nu = unit + G;
        if (nu < NUNIT) {
            const int bh = nu >> 7, c = nu & 127, b = bh >> 2, h = bh & 3;
            const size_t m0 = (size_t)b * SEQ + c * CH + 8 * w; const int col = h * HD + 2 * lane;
#pragma unroll
            for (int r = 0; r < 8; ++r) { { const unsigned gw_ = *(const unsigned*)(g + (m0 + r) * HW + col); gg[r] = (f32x2){bflo(gw_), bfhi(gw_)}; } vv[r] = *(const unsigned*)(vb + (m0 + r) * HW + col); }
        }
        WG_BAR();
        bf16x8 yv[2];
#pragma unroll
        for (int ks = 0; ks < 2; ++ks) yv[ks] = *(const LAS bf16x8*)(VT + (16 * w + r16) * 144 + ks * 64 + q4 * 16);
        bf16* ut = UT + (size_t)unit * (HD * HD) + (size_t)(16 * w + r16) * HD + 4 * q4;
#pragma unroll
        for (int nb = 0; nb < 8; ++nb) {
            f32x4 a = {0.f, 0.f, 0.f, 0.f};
#pragma unroll
            for (int ks = 0; ks < 2; ++ks) { const bf16x8 xk = *(const LAS bf16x8*)(KT + (16 * nb + r16) * 144 + ks * 64 + q4 * 16); a = __builtin_amdgcn_mfma_f32_16x16x32_bf16(xk, yv[ks], a, 0, 0, 0); }
            *(u32x2*)(ut + 16 * nb) = (u32x2){pk(a[0], a[1]), pk(a[2], a[3])};
        }
        WG_BAR();
    }
}

__device__ __forceinline__ void phase_h2(bf16* UT, const float* dec, int G) {
    int tid = threadIdx.x; asm volatile("" : "+v"(tid));
    for (int e = blockIdx.x * NTHREADS + tid; e < NBH * HD * HD; e += G * NTHREADS) {
        const int bh = e >> 14, idx = e & 16383, k = idx & 127;
        bf16* up = UT + (size_t)bh * NCH * (HD * HD) + idx; const float* dp = dec + (size_t)bh * NCH * HD + k;
        float S = 0.f;
        for (int c0 = 0; c0 < NCH; c0 += 16) {
            bf16 uu[16]; float dd[16];
#pragma unroll
            for (int i = 0; i < 16; ++i) { uu[i] = up[(size_t)(c0 + i) * (HD * HD)]; dd[i] = dp[(size_t)(c0 + i) * HD]; }
#pragma unroll
            for (int i = 0; i < 16; ++i) { up[(size_t)(c0 + i) * (HD * HD)] = (bf16)(pk(S, 0.f) & 0xffffu); S = dd[i] * S + __uint_as_float((unsigned)uu[i] << 16); }
        }
    }
}

__device__ __forceinline__ void phase_h3(LAS unsigned char* lds, const bf16* qb, const bf16* g, const bf16* vb, const bf16* sob, const bf16* ST, const float* ng, bf16* hg, int G) {
    constexpr int SR = 272;
    int tid = threadIdx.x; asm volatile("" : "+v"(tid));
    const int lane = tid & 63, w = __builtin_amdgcn_readfirstlane(tid >> 6), r16 = lane & 15, q4 = lane >> 4;
    LAS unsigned char* QH = lds; LAS unsigned char* QD = lds + 17408; LAS unsigned char* KD = lds + 34816; LAS unsigned char* KE = lds + 52224; LAS unsigned char* QO = lds + 69632;
    LAS unsigned char* VT = lds + 95744; LAS float* SEG = (LAS float*)(lds + 114176); LAS float* RMS = (LAS float*)(lds + 118272);
    const int bi = w >> 1, odd = w & 1;
    f32x2 gg[8]; unsigned qq[8], vv[8];
    int unit = blockIdx.x;
    if (unit < NUNIT) {
        const int bh = unit >> 7, c = unit & 127, b = bh >> 2, h = bh & 3;
        const size_t m0 = (size_t)b * SEQ + c * CH + 8 * w; const int col = h * HD + 2 * lane;
#pragma unroll
        for (int r = 0; r < 8; ++r) { { const unsigned gw_ = *(const unsigned*)(g + (m0 + r) * HW + col); gg[r] = (f32x2){bflo(gw_), bfhi(gw_)}; } qq[r] = *(const unsigned*)(qb + (m0 + r) * HW + col); vv[r] = *(const unsigned*)(vb + (m0 + r) * HW + col); }
    }
    for (; unit < NUNIT; unit += G) {
        const int bh = unit >> 7, c = unit & 127, b = bh >> 2, h = bh & 3;
        const size_t mu = (size_t)b * SEQ + c * CH;
        const bf16* STu = ST + (size_t)unit * (HD * HD) + (size_t)(64 * odd + r16) * HD + q4 * 8;
        bf16x8 xs[4][4];
#pragma unroll
        for (int ks = 0; ks < 4; ++ks)
#pragma unroll
            for (int nb = 0; nb < 4; ++nb) xs[ks][nb] = *(const bf16x8*)(STu + (size_t)(16 * nb) * HD + ks * 32);
        const size_t row = mu + 16 * bi + r16;
        u32x2 sv[4]; f32x4 ngv[4];
#pragma unroll
        for (int nb = 0; nb < 4; ++nb) { const int v0 = 64 * odd + 16 * nb + 4 * q4; ngv[nb] = *(const f32x4*)(ng + v0); sv[nb] = *(const u32x2*)(sob + row * HW + h * HD + v0); }
        f32x2 cs[8]; cs[0] = gg[0];
#pragma unroll
        for (int r = 1; r < 8; ++r) cs[r] = cs[r - 1] + gg[r];
        *(LAS f32x2*)(SEG + w * 128 + 2 * lane) = cs[7];
        *(LAS u32x4*)(VT + (2 * lane) * 144 + w * 16) = pack_lo8(vv); *(LAS u32x4*)(VT + (2 * lane + 1) * 144 + w * 16) = pack_hi8(vv);
        WG_BAR();
        f32x2 pre = {0.f, 0.f};
        for (int j = 0; j < w; ++j) pre += *(const LAS f32x2*)(SEG + j * 128 + 2 * lane);
        const f32x2 cmid = *(const LAS f32x2*)(SEG + (2 * bi) * 128 + 2 * lane);
        const f32x2 bsum = cmid + *(const LAS f32x2*)(SEG + (2 * bi + 1) * 128 + 2 * lane);
        f32x2 bsm1 = {0.f, 0.f}, bsm2 = {0.f, 0.f};
        if (bi >= 1) bsm1 = *(const LAS f32x2*)(SEG + (2 * bi - 2) * 128 + 2 * lane) + *(const LAS f32x2*)(SEG + (2 * bi - 1) * 128 + 2 * lane);
        if (bi >= 2) bsm2 = bsm1 + *(const LAS f32x2*)(SEG + (2 * bi - 4) * 128 + 2 * lane) + *(const LAS f32x2*)(SEG + (2 * bi - 3) * 128 + 2 * lane);
        const f32x2 cbase = odd ? cmid : (f32x2){0.f, 0.f};
        const int pbase = (bi * (bi - 1)) / 2;
#pragma unroll
        for (int r = 0; r < 8; ++r) {
            const int t = 8 * w + r, tl = 8 * odd + r;
            const f32x2 cl = cbase + cs[r], bf = pre + cs[r];
            const float qx = bflo(qq[r]), qy = bfhi(qq[r]);
            const float kx = 1.f - __expf(gg[r].x), ky = 1.f - __expf(gg[r].y);
            *(LAS unsigned*)(QH + t * SR + 4 * lane) = pk(qx * __expf(bf.x), qy * __expf(bf.y));
            *(LAS unsigned*)(QD + t * SR + 4 * lane) = pk(qx * __expf(fminf(cl.x - cmid.x, 80.f)), qy * __expf(fminf(cl.y - cmid.y, 80.f)));
            *(LAS unsigned*)(KD + t * SR + 4 * lane) = pk(kx * __expf(fminf(cmid.x - cl.x, 80.f)), ky * __expf(fminf(cmid.y - cl.y, 80.f)));
            if (bi < 3) *(LAS unsigned*)(KE + t * SR + 4 * lane) = pk(kx * __expf(bsum.x - cl.x), ky * __expf(bsum.y - cl.y));
            if (bi >= 1) *(LAS unsigned*)(QO + ((pbase + bi - 1) * 16 + tl) * SR + 4 * lane) = pk(qx * __expf(cl.x), qy * __expf(cl.y));
            if (bi >= 2) *(LAS unsigned*)(QO + ((pbase + bi - 2) * 16 + tl) * SR + 4 * lane) = pk(qx * __expf(cl.x + bsm1.x), qy * __expf(cl.y + bsm1.y));
            if (bi >= 3) *(LAS unsigned*)(QO + ((pbase + 0) * 16 + tl) * SR + 4 * lane) = pk(qx * __expf(cl.x + bsm2.x), qy * __expf(cl.y + bsm2.y));
        }
        WG_BAR();
        { const int nu = unit + G;
          if (nu < NUNIT) {
            const int bh2 = nu >> 7, c2 = nu & 127, b2 = bh2 >> 2, h2 = bh2 & 3;
            const size_t m0 = (size_t)b2 * SEQ + c2 * CH + 8 * w; const int col = h2 * HD + 2 * lane;
#pragma unroll
            for (int r = 0; r < 8; ++r) { { const unsigned gw_ = *(const unsigned*)(g + (m0 + r) * HW + col); gg[r] = (f32x2){bflo(gw_), bfhi(gw_)}; } qq[r] = *(const unsigned*)(qb + (m0 + r) * HW + col); vv[r] = *(const unsigned*)(vb + (m0 + r) * HW + col); }
          } }
        const int i = bi, vh = odd;
        f32x4 acc[4];
#pragma unroll
        for (int nb = 0; nb < 4; ++nb) acc[nb] = (f32x4){0.f, 0.f, 0.f, 0.f};
#pragma unroll
        for (int ks = 0; ks < 4; ++ks) {
            const bf16x8 y = *(const LAS bf16x8*)(QH + (16 * i + r16) * SR + ks * 64 + q4 * 16);
#pragma unroll
            for (int nb = 0; nb < 4; ++nb) acc[nb] = __builtin_amdgcn_mfma_f32_16x16x32_bf16(xs[ks][nb], y, acc[nb], 0, 0, 0);
        }
#pragma unroll
        for (int jp = 0; jp < 2; ++jp) {
            if (2 * jp <= i) {
                f32x4 p[2];
#pragma unroll
                for (int jj = 0; jj < 2; ++jj) {
                    const int j = 2 * jp + jj;
                    p[jj] = (f32x4){0.f, 0.f, 0.f, 0.f};
                    if (j <= i) {
                        const LAS unsigned char* Kb = (j == i ? KD : KE) + (16 * j + r16) * SR + q4 * 16;
                        const LAS unsigned char* Qb = (j == i ? QD + (16 * i + r16) * SR : QO + ((pbase + j) * 16 + r16) * SR) + q4 * 16;
#pragma unroll
                        for (int ks = 0; ks < 4; ++ks) { const bf16x8 xk = *(const LAS bf16x8*)(Kb + ks * 64); const bf16x8 yq = *(const LAS bf16x8*)(Qb + ks * 64); p[jj] = __builtin_amdgcn_mfma_f32_16x16x32_bf16(xk, yq, p[jj], 0, 0, 0); }
                        if (j == i) {
#pragma unroll
                            for (int e = 0; e < 4; ++e) if (4 * q4 + e > r16) p[jj][e] = 0.f;
                        }
                    }
                }
                u32x4 ypw; ypw.x = pk(p[0][0], p[0][1]); ypw.y = pk(p[0][2], p[0][3]); ypw.z = pk(p[1][0], p[1][1]); ypw.w = pk(p[1][2], p[1][3]);
                const bf16x8 yp = __builtin_bit_cast(bf16x8, ypw);
#pragma unroll
                for (int nb = 0; nb < 4; ++nb) {
                    const LAS unsigned char* vp = VT + (64 * vh + 16 * nb + r16) * 144 + (32 * jp + 4 * q4) * 2;
                    const u32x2 lo = *(const LAS u32x2*)vp, hi = *(const LAS u32x2*)(vp + 32);
                    const u32x4 xw = {lo.x, lo.y, hi.x, hi.y};
                    acc[nb] = __builtin_amdgcn_mfma_f32_16x16x32_bf16(__builtin_bit_cast(bf16x8, xw), yp, acc[nb], 0, 0, 0);
                }
            }
        }
        float ss = 0.f;
#pragma unroll
        for (int nb = 0; nb < 4; ++nb) ss += (acc[nb][0] * acc[nb][0] + acc[nb][1] * acc[nb][1]) + (acc[nb][2] * acc[nb][2] + acc[nb][3] * acc[nb][3]);
        ss += __shfl_xor(ss, 16); ss += __shfl_xor(ss, 32);
        if (q4 == 0) RMS[(16 * i + r16) * 2 + vh] = ss;
        WG_BAR();
        const float rstd = rsqrtf((RMS[(16 * i + r16) * 2] + RMS[(16 * i + r16) * 2 + 1]) * (1.f / HD) + EPS);
#pragma unroll
        for (int nb = 0; nb < 4; ++nb) {
            const int v0 = 64 * vh + 16 * nb + 4 * q4;
            const f32x4 o = acc[nb] * rstd * ngv[nb];
            *(u32x2*)(hg + row * HW + h * HD + v0) = (u32x2){pk(o[0] * bflo(sv[nb].x), o[1] * bfhi(sv[nb].x)), pk(o[2] * bflo(sv[nb].y), o[3] * bfhi(sv[nb].y))};
        }
        WG_BAR();
    }
}

__device__ __forceinline__ f32x4 bf4(u32x2 v) { return (f32x4){bflo(v.x), bfhi(v.x), bflo(v.y), bfhi(v.y)}; }
__device__ __forceinline__ void ffn_fixup(int pm, const bf16* hbnd, const float* cw, const float* cb, bf16* act) {
    int tid = threadIdx.x; asm volatile("" : "+v"(tid));
    for (int idx = tid; idx < DFF / 4; idx += NTHREADS) {
        const int c4 = idx * 4;
        const f32x4 wv0 = *(const f32x4*)(cw + c4), wv1 = *(const f32x4*)(cw + NUP + c4), wv2 = *(const f32x4*)(cw + 2 * NUP + c4), bv = *(const f32x4*)(cb + c4);
        const f32x4 wg0 = *(const f32x4*)(cw + DFF + c4), wg1 = *(const f32x4*)(cw + NUP + DFF + c4), wg2 = *(const f32x4*)(cw + 2 * NUP + DFF + c4), bg = *(const f32x4*)(cb + DFF + c4);
        u32x2 hv[2][4], hg[2][4];
#pragma unroll
        for (int bb = 0; bb < 2; ++bb) {
            const int blk = 2 * pm + bb; const bool first = (blk & 63) == 0;
#pragma unroll
            for (int k = 0; k < 4; ++k) {
                const int sb = k < 2 ? blk - 1 : blk, slot = k < 2 ? k + 2 : k - 2;
                const bf16* p = hbnd + ((size_t)(sb * 4 + slot) * 2) * DFF + c4;
                if (k < 2 && first) { hv[bb][k] = (u32x2){0u, 0u}; hg[bb][k] = (u32x2){0u, 0u}; }
                else { hv[bb][k] = *(const u32x2*)p; hg[bb][k] = *(const u32x2*)(p + DFF); }
            }
        }
#pragma unroll
        for (int bb = 0; bb < 2; ++bb)
#pragma unroll
            for (int dl = 0; dl < 2; ++dl) {
                const f32x4 vc = wv2 * bf4(hv[bb][2 + dl]) + wv1 * bf4(hv[bb][1 + dl]) + wv0 * bf4(hv[bb][dl]) + bv;
                const f32x4 gc = wg2 * bf4(hg[bb][2 + dl]) + wg1 * bf4(hg[bb][1 + dl]) + wg0 * bf4(hg[bb][dl]) + bg;
                f32x4 a;
#pragma unroll
                for (int e = 0; e < 4; ++e) a[e] = vc[e] * silu(gc[e]);
                *(u32x2*)(act + ((size_t)(2 * pm + bb) * 128 + dl) * DFF + c4) = (u32x2){pk(a[0], a[1]), pk(a[2], a[3])};
            }
    }
}

__device__ __forceinline__ void phase_final(const bf16* xb, float* out, const float* ssq, const float* fg, int G) {
    int tid = threadIdx.x; asm volatile("" : "+v"(tid));
    const int lane = tid & 63, wave = tid >> 6;
    for (int m = blockIdx.x * NWAVES + wave; m < M; m += G * NWAVES) {
        const f32x4* sp = (const f32x4*)(ssq + (size_t)m * 16);
        const f32x4 s = (sp[0] + sp[1]) + (sp[2] + sp[3]);
        const float rstd = rsqrtf(((s[0] + s[1]) + (s[2] + s[3])) * (1.f / D) + EPS);
        const u32x4* xr = (const u32x4*)(xb + (size_t)m * D) + lane; f32x4* orow = (f32x4*)(out + (size_t)m * D) + 2 * lane; const f32x4* gr = (const f32x4*)fg + 2 * lane;
#pragma unroll
        for (int j = 0; j < 2; ++j) { const u32x4 w = xr[64 * j];
            orow[128 * j] = (f32x4){bflo(w.x), bfhi(w.x), bflo(w.y), bfhi(w.y)} * rstd * gr[128 * j];
            orow[128 * j + 1] = (f32x4){bflo(w.z), bfhi(w.z), bflo(w.w), bfhi(w.w)} * rstd * gr[128 * j + 1]; }
    }
}


#ifndef DEBUG_SCAN
#define DEBUG_SCAN 0
#endif
__device__ __forceinline__ void scan_bf16(const bf16* p, size_t n, int* flags, int code, int G) {
    int tid = threadIdx.x; asm volatile("" : "+v"(tid));
    const u32x4* q = (const u32x4*)p; const size_t n16 = n / 8; bool bad = false, huge = false;
    for (size_t i = (size_t)blockIdx.x * NTHREADS + tid; i < n16; i += (size_t)G * NTHREADS) { const u32x4 w = q[i];
#pragma unroll
        for (int e = 0; e < 4; ++e) { const unsigned x = w[e]; if ((x & 0x7f80u) == 0x7f80u || (x & 0x7f800000u) == 0x7f800000u) bad = true; if (fabsf(bflo(x)) > 1e4f || fabsf(bfhi(x)) > 1e4f) huge = true; } }
    if (bad) flags[code] = 1; if (huge) flags[64 + code] = 1;
}
__device__ __forceinline__ void scan_f32(const float* p, size_t n, int* flags, int code, int G) {
    int tid = threadIdx.x; asm volatile("" : "+v"(tid));
    bool bad = false, huge = false;
    for (size_t i = (size_t)blockIdx.x * NTHREADS + tid; i < n; i += (size_t)G * NTHREADS) { const unsigned x = __float_as_uint(p[i]); if ((x & 0x7f800000u) == 0x7f800000u) bad = true; if (fabsf(p[i]) > 1e4f) huge = true; }
    if (bad) flags[code] = 1; if (huge) flags[64 + code] = 1;
}
#define XB_TMO      128
#define XB_XCNT(j)  (256  + 64 * (j))
#define XB_XSUB(j)  (1280 + 64 * (j))
#define XB_XGEN(j)  (2304 + 64 * (j))
#define XB_TOP      3328
#define XB_TOPGEN   3392
#define XCD_BAR_WORDS 3456
#define XB_SPIN_CAP (1u << 18)

__device__ __forceinline__ unsigned xb_ld(unsigned* p)              { return __hip_atomic_load(p, __ATOMIC_RELAXED, __HIP_MEMORY_SCOPE_AGENT); }
__device__ __forceinline__ unsigned xb_add(unsigned* p, unsigned v) { return __hip_atomic_fetch_add(p, v, __ATOMIC_RELAXED, __HIP_MEMORY_SCOPE_AGENT); }
__device__ __forceinline__ unsigned xb_xcc_id() { return (unsigned)__builtin_amdgcn_s_getreg((3 << 11) | 20) & 0xFu; }
#define XB_SPIN(cond, bar) do { unsigned _sp = 0; while (cond) { __builtin_amdgcn_s_sleep(1); \
    if ((++_sp & 255u) == 0u) { if (xb_ld(&(bar)[XB_TMO])) break; if (_sp > XB_SPIN_CAP) { atomicAdd(&(bar)[XB_TMO], 1u); break; } } } } while (0)

struct XcdBarrier {
    unsigned* bar; unsigned x;
    volatile LAS unsigned* st;
};

__device__ __forceinline__ XcdBarrier xcd_barrier_post(unsigned* bar, volatile LAS unsigned* st) {
    XcdBarrier b; b.bar = bar; b.x = xb_xcc_id(); b.st = st;
    if (threadIdx.x == 0) (void)xb_add(&bar[XB_XCNT(b.x)], 1u);
    return b;
}
__device__ __forceinline__ void xcd_barrier_complete(unsigned* bar, unsigned x, unsigned& nloc, unsigned& nx) {
    const unsigned G = gridDim.x * gridDim.y * gridDim.z;
    unsigned sum, cnt, mine, sp = 0u;
    for (;;) {
        sum = 0u; cnt = 0u; mine = 0u;
#pragma unroll
        for (unsigned j = 0; j < 16; ++j) { const unsigned c = xb_ld(&bar[XB_XCNT(j)]); sum += c; cnt += (c > 0u) ? 1u : 0u; mine = (j == x) ? c : mine; }
        if (sum == G) break;
        __builtin_amdgcn_s_sleep(1);
        if ((++sp & 255u) == 0u) { if (xb_ld(&bar[XB_TMO])) break; if (sp > XB_SPIN_CAP) { atomicAdd(&bar[XB_TMO], 1u); break; } }
    }
    nloc = mine > 0u ? mine : 1u; nx = cnt > 0u ? cnt : 1u;
}

__device__ __forceinline__ void xcd_barrier(const XcdBarrier& b) {
    asm volatile("s_waitcnt vmcnt(0)" ::: "memory");
    __syncthreads();
    if (threadIdx.x == 0) {
        unsigned* bar = b.bar;
        __builtin_amdgcn_s_waitcnt(0);
        unsigned nloc = b.st[0], nx = b.st[1];
        if (nloc == 0u) { xcd_barrier_complete(bar, b.x, nloc, nx); b.st[0] = nloc; b.st[1] = nx; }
        const unsigned old = xb_add(&bar[XB_XSUB(b.x)], 1u);
        const unsigned gen = old / nloc;
        if (old + 1u == (gen + 1u) * nloc) {
            __builtin_amdgcn_fence(__ATOMIC_RELEASE, "agent");
            asm volatile("s_waitcnt vmcnt(0)" ::: "memory");
            const unsigned og = xb_add(&bar[XB_TOP], 1u);
            const unsigned tg = og / nx;
            if (og + 1u == (tg + 1u) * nx) xb_add(&bar[XB_TOPGEN], 1u);
            else XB_SPIN(xb_ld(&bar[XB_TOPGEN]) == tg, bar);
            __builtin_amdgcn_fence(__ATOMIC_ACQUIRE, "agent");
            xb_add(&bar[XB_XGEN(b.x)], 1u);
            asm volatile("s_waitcnt vmcnt(0)" ::: "memory");
        } else {
            XB_SPIN(xb_ld(&bar[XB_XGEN(b.x)]) == gen, bar);
            __builtin_amdgcn_fence(__ATOMIC_ACQUIRE, "agent");
            asm volatile("s_waitcnt vmcnt(0)" ::: "memory");
        }
    }
    __syncthreads();
}

#ifndef ONE_LAUNCH
#define ONE_LAUNCH 1
#endif
constexpr int PH_PER_LAYER = 9, N_PHASES = 1 + DEPTH * PH_PER_LAYER + 1;

__global__ void __launch_bounds__(NTHREADS, 2) trunk_fwd(Args args) {
    extern __shared__ __attribute__((aligned(16))) unsigned char lds_raw[];
    LAS unsigned char* lds = (LAS unsigned char*)lds_raw;
    cg::grid_group grid = cg::this_grid();
    const int G = gridDim.x;
    unsigned char* ws = args.ws;
    float* out = args.out;
    const int lo = args.ph_lo, hi = args.ph_hi;
    float* ssq = (float*)(ws + WS_SSQ); float* dec = (float*)(ws + WS_DEC); bf16* hbnd = (bf16*)(ws + WS_HBND); bf16* xb = (bf16*)(ws + WS_XB);
    bf16 *ub = (bf16*)(ws + WS_U), *hgb = (bf16*)(ws + WS_HG), *qb = (bf16*)(ws + WS_Q), *vb = (bf16*)(ws + WS_V), *sob = (bf16*)(ws + WS_SO), *pooled = (bf16*)(ws + WS_POOL);
    bf16 *UT = (bf16*)(ws + WS_UT), *gates = (bf16*)(ws + WS_GATES), *merged = (bf16*)(ws + WS_MERGED), *act = (bf16*)(ws + WS_ACT);
    bf16* gl = (bf16*)(ws + WS_G);
#ifndef PHASE_MASK
#define PHASE_MASK 0xfff
#endif
#define EN(j) (((PHASE_MASK) >> (j)) & 1)
#define IN(k) (lo <= (k) && (k) < hi)
#define SC(k) (DEBUG_SCAN && lo == (k) && hi == (k) - 1)
    volatile LAS unsigned* MISC = (volatile LAS unsigned*)(lds + 131072 + 512);
    { int t_ = threadIdx.x; asm volatile("" : "+v"(t_)); if (t_ < 32) MISC[t_] = 0u; }
    __syncthreads();
    XcdBarrier bar = xcd_barrier_post((unsigned*)(ws + WS_BAR), MISC + 8);
#ifndef PROBE_A
#define PROBE_A -1
#define PROBE_B -1
#endif
    unsigned long long* tsb = (unsigned long long*)(ws + 4096);
#define STAMP(k) do { if (PROBE_A >= 0 && blockIdx.x == 0) { int t_ = threadIdx.x; asm volatile("" : "+v"(t_)); if (t_ == 0) tsb[(k)] = __builtin_amdgcn_s_memrealtime(); } } while (0)
#define SEAM(k) do { if (IN(k) && IN((k) + 1)) { if ((k) == 0) grid.sync(); else xcd_barrier(bar); } STAMP((k) + 1); } while (0)
    STAMP(0);

    int* dbg = (int*)ws;
    static_assert(DEPTH == 2, "the lazy weight-copy schedule below is written for two layers");
    const bool lazy = (G == 256) && lo == 0 && hi == N_PHASES;
    if (EN(9) && IN(0)) { if (DEBUG_SCAN && blockIdx.x == 0) { int t_ = threadIdx.x; asm volatile("" : "+v"(t_)); if (t_ < 128) dbg[t_] = 0; } phase_prologue(args, lds, G, lazy); }
    SEAM(0);
    for (int l = 0; l < DEPTH; ++l) {
        const int pb = 1 + l * PH_PER_LAYER;
        unsigned char* wl = ws + WS_W + (size_t)l * W_LAYER;
        const bf16* Win = (const bf16*)(wl + WO_IN);
        if (EN(0) && IN(pb + 0)) {
            pg8::Gemm g{xb, Win, M, NMIX, D}; pg8::StaticOrder S; S.init(M, NMIX, G, (int)blockIdx.x);
            EpiInMix E{ub, qb, vb, sob, gl, ssq, (const float*)(ws + WS_LB) + l * HW, gates, args.in[3] + l * NGATE, 0};
            pg8::gemm_phase<EpiInMix, pg8::StaticOrder, true, true>(lds, g, S, E);
            if (lazy && l == 0 && blockIdx.x >= 128) {
                convert_items(args, lds, I_IN, I_LAYER, (int)blockIdx.x - 128, 128);
                fold_pool(args, lds, 0, 1, (int)blockIdx.x - 128, 128);
            }
        }
        SEAM(pb + 0);
        if (SC(pb + 1)) { const int cb_ = 20 * l; scan_bf16(ub, (size_t)M * 512, dbg, cb_ + 1, G); scan_bf16(qb, (size_t)M * 512, dbg, cb_ + 2, G); scan_bf16(vb, (size_t)M * 512, dbg, cb_ + 3, G); scan_bf16(sob, (size_t)M * 512, dbg, cb_ + 4, G); scan_bf16(gl, (size_t)M * 512, dbg, cb_ + 5, G); }
        if (EN(1) && IN(pb + 1)) { phase_fir(ub, pooled, G); phase_h1(lds, gl, vb, UT, dec, G); }
        SEAM(pb + 1);
        if (SC(pb + 2)) { const int cb_ = 20 * l; scan_bf16(pooled, (size_t)M * 512, dbg, cb_ + 6, G); scan_bf16(UT, (size_t)NUNIT * 16384, dbg, cb_ + 7, G); scan_f32(dec, (size_t)NUNIT * 128, dbg, cb_ + 8, G); }
        if (EN(2) && IN(pb + 2)) phase_h2(UT, dec, G);
        SEAM(pb + 2);
        if (SC(pb + 3)) { scan_bf16(UT, (size_t)NUNIT * 16384, dbg, 20 * l + 9, G); }
        if (EN(3) && IN(pb + 3)) phase_h3(lds, qb, gl, vb, sob, UT, args.in[7] + l * HD, hgb, G);
        SEAM(pb + 3);
        if (SC(pb + 4)) { scan_bf16(gates, (size_t)M * 2048, dbg, 20 * l + 11, G); }
        if (EN(4) && IN(pb + 4)) {
            pg8::Gemm g{xb, Win + (size_t)NMIX * D, M, NGATE, D}; pg8::StaticOrder S; S.init(M, NGATE, G, (int)blockIdx.x);
            EpiInMix E{ub, qb, vb, sob, gl, ssq, (const float*)(ws + WS_LB) + l * HW, gates, args.in[3] + l * NGATE, 10};
            pg8::gemm_phase<EpiInMix, pg8::StaticOrder, true, true>(lds, g, S, E);
        }
        SEAM(pb + 4);
        if (EN(5) && IN(pb + 5)) {
            { pg8::Gemm g{pooled, (const bf16*)(wl + WO_A), M, D, PW}; pg8::StaticOrder S; S.init(M, D, G, (int)blockIdx.x);
              EpiMerge<false> E{merged, gates};
              pg8::gemm_phase<EpiMerge<false>, pg8::StaticOrder, true, true>(lds, g, S, E); }
            VM_WAIT(); __syncthreads();
            { pg8::Gemm g{hgb, (const bf16*)(wl + WO_PB), M, D, HW}; pg8::StaticOrder S; S.init(M, D, G, (int)blockIdx.x);
              EpiMerge<true> E{merged, gates};
              pg8::gemm_phase<EpiMerge<true>, pg8::StaticOrder, true, true>(lds, g, S, E); }
        }
        SEAM(pb + 5);
        if (SC(pb + 6)) { scan_bf16(merged, (size_t)M * 1024, dbg, 20 * l + 12, G); }
        if (EN(6) && IN(pb + 6)) {
            pg8::Gemm g{merged, (const bf16*)(wl + WO_O), M, D, D}; pg8::StaticOrder S; S.init(M, D, G, (int)blockIdx.x);
            EpiRes<false> E{out, xb, ssq};
            pg8::gemm_phase<EpiRes<false>, pg8::StaticOrder, true, true>(lds, g, S, E);
        }
        SEAM(pb + 6);
        if (SC(pb + 7)) { scan_f32(out, (size_t)M * 1024, dbg, 20 * l + 13, G); scan_bf16(xb, (size_t)M * 1024, dbg, 20 * l + 14, G); scan_f32(ssq, (size_t)M * 16, dbg, 20 * l + 15, G); }
        if (EN(7) && IN(pb + 7)) {
            pg8::Gemm g{xb, (const bf16*)(wl + WO_UP), M, NUP, D}; pg8::StaticOrder S; S.init(M, NUP, G, (int)blockIdx.x);
            EpiUpConv E{act, hbnd, ssq, args.in[13] + (size_t)l * 3 * NUP, args.in[14] + (size_t)l * NUP};
            pg8::gemm_phase<EpiUpConv, pg8::StaticOrder, true, true, true>(lds, g, S, E);
            if (lazy && l == 0 && blockIdx.x >= 128) {
                convert_items(args, lds, I_LAYER, 2 * I_LAYER, (int)blockIdx.x - 128, 128);
                fold_pool(args, lds, 1, 2, (int)blockIdx.x - 128, 128);
            }
        }
        SEAM(pb + 7);
        if (SC(pb + 8)) { scan_bf16(act, (size_t)M * DFF, dbg, 20 * l + 16, G); scan_bf16(hbnd, (size_t)128 * 4 * 2 * DFF, dbg, 20 * l + 17, G); }
        if (EN(8) && IN(pb + 8)) {
            pg8::StaticOrder S; S.init(M, D, G, (int)blockIdx.x);
            pg8::Unit un;
            for (int i = 0; S.next(i, un); ++i) ffn_fixup(un.pm, hbnd, args.in[13] + (size_t)l * 3 * NUP, args.in[14] + (size_t)l * NUP, act);
            VM_WAIT(); __builtin_amdgcn_fence(__ATOMIC_ACQ_REL, "agent"); __syncthreads();
            pg8::Gemm g{act, (const bf16*)(wl + WO_DN), M, D, DFF};
            EpiRes<false> E{out, xb, ssq}; pg8::gemm_phase<EpiRes<false>, pg8::StaticOrder, true, true>(lds, g, S, E);
        }
        SEAM(pb + 8);
    }
    if (SC(N_PHASES - 1)) {
        scan_f32(out, (size_t)M * 1024, dbg, 58, G); scan_f32(ssq, (size_t)M * 16, dbg, 59, G);
        __syncthreads();
    }
    if (EN(10) && IN(N_PHASES - 1)) phase_final(xb, out, ssq, args.in[16], G);
    if (DEBUG_SCAN && IN(N_PHASES)) {
        int t_ = threadIdx.x; asm volatile("" : "+v"(t_));
        int c1 = -1, c2 = -1; for (int i = 63; i >= 0; --i) { if (dbg[i]) c1 = i; if (dbg[64 + i]) c2 = i; }
        const float cval = 100.f * (float)(c2 + 2);
        for (size_t i = (size_t)blockIdx.x * NTHREADS + t_; i < (size_t)M * D; i += (size_t)G * NTHREADS) out[i] = (i == 0) ? 1e4f * (float)(c1 + 1) : cval;
    }
    if (PROBE_A >= 0 && blockIdx.x == 0) {
        int t_ = threadIdx.x; asm volatile("" : "+v"(t_));
        if (t_ == 0) {
            STAMP(N_PHASES);
            __builtin_amdgcn_fence(__ATOMIC_ACQ_REL, "agent");
            const unsigned long long da = tsb[PROBE_A + 1] - tsb[PROBE_A], db = PROBE_B >= 0 ? tsb[PROBE_B + 1] - tsb[PROBE_B] : 0ull;
            const unsigned long long spin = 4ull * da + 204800ull * (db / 3200ull);
            const unsigned long long t0 = __builtin_amdgcn_s_memrealtime();
            while (__builtin_amdgcn_s_memrealtime() - t0 < spin) __builtin_amdgcn_s_sleep(32);
        }
    }
#undef IN
#undef SEAM
}

extern "C" void kernel_launch(void* const* d_in, const int* in_sizes, int n_in, void* d_out, int out_size, void* d_ws, size_t ws_size, hipStream_t stream) {
    static int grid = 0;
    if (grid == 0) {
        if (n_in != 17 || in_sizes[0] != M * D || out_size != M * D || ws_size < WS_END) { fprintf(stderr, "kernel_launch: unexpected shapes (n_in %d, in0 %d, out %d, ws %zu)\n", n_in, n_in > 0 ? in_sizes[0] : -1, out_size, ws_size); grid = -1; return; }
        int dev = 0, cus = 0, per_cu = 0;
        hipGetDevice(&dev); hipDeviceGetAttribute(&cus, hipDeviceAttributeMultiprocessorCount, dev);
        if (hipFuncSetAttribute((const void*)trunk_fwd, hipFuncAttributeMaxDynamicSharedMemorySize, LDS_BYTES) != hipSuccess) { fprintf(stderr, "kernel_launch: hipFuncSetAttribute failed\n"); grid = -1; return; }
        if (hipOccupancyMaxActiveBlocksPerMultiprocessor(&per_cu, (const void*)trunk_fwd, NTHREADS, LDS_BYTES) != hipSuccess || per_cu < 1) { fprintf(stderr, "kernel_launch: occupancy query says %d\n", per_cu); per_cu = 1; }
        (void)hipGetLastError();
        grid = cus * 1;
        fprintf(stderr, "kernel_launch: grid %d (cus %d, per_cu %d)\n", grid, cus, per_cu);
    }
    if (grid < 0) return;
    Args a{};
    for (int i = 0; i < 17; ++i) a.in[i] = (const float*)d_in[i];
    a.out = (float*)d_out; a.ws = (unsigned char*)d_ws;
#if ONE_LAUNCH
    if (hipMemsetAsync((char*)d_ws + WS_BAR, 0, BAR_BYTES, stream) != hipSuccess) { fprintf(stderr, "kernel_launch: memset failed\n"); return; }
    a.ph_lo = 0; a.ph_hi = N_PHASES;
    void* kargs[] = {&a};
    hipError_t e = hipLaunchCooperativeKernel((const void*)trunk_fwd, dim3(grid), dim3(NTHREADS), kargs, LDS_BYTES, stream);
    if (e != hipSuccess) fprintf(stderr, "kernel_launch: cooperative launch failed: %s (grid %d)\n", hipGetErrorString(e), grid);
#else
    for (int p = 0; p < N_PHASES + (DEBUG_SCAN ? 1 : 0); ++p) {
        if (DEBUG_SCAN && p > 0 && p < N_PHASES) { a.ph_lo = p; a.ph_hi = p - 1; hipLaunchKernelGGL(trunk_fwd, dim3(grid), dim3(NTHREADS), LDS_BYTES, stream, a); }
        a.ph_lo = p; a.ph_hi = p + 1;
        hipLaunchKernelGGL(trunk_fwd, dim3(grid), dim3(NTHREADS), LDS_BYTES, stream, a);
    }
#endif
}
```

```cpp
#include <hip/hip_runtime.h>
#include <hip/hip_cooperative_groups.h>
#include <cstdio>
#include <cstdint>
namespace cg = cooperative_groups;
namespace pg8 {
#define PG8_LAS __attribute__((address_space(3)))
typedef unsigned short bf16_t;
typedef short bf16x8 __attribute__((ext_vector_type(8)));
typedef float f32x4 __attribute__((ext_vector_type(4)));
typedef unsigned u32x4 __attribute__((ext_vector_type(4)));
constexpr int BM = 256, BK = 64, HALF = 128, HTB = HALF * BK * 2  , STAGE_BYTES = 8 * HTB, NXCD = 8, WGM = 8;

__host__ __device__ __forceinline__ int lds_byte(int r, int c) { const int st = (r >> 4) * 2 + (c >> 5), rr = r & 15, cc = c & 31, ob = rr * 64 + cc * 2; return st * 1024 + (ob ^ (((ob >> 9) & 1) << 5)); }
__host__ __device__ __forceinline__ void stage_rc(int b, int& R, int& C) { const int st = b / 1024, sb = b % 1024, swz = sb ^ (((sb >> 9) & 1) << 5); R = (st >> 1) * 16 + swz / 64; C = (st & 1) * 32 + (swz % 64) / 2; }
__host__ __device__ __forceinline__ int perm32(int rho) { const int n = rho >> 4, i = rho & 15; return 8 * (i >> 2) + 4 * n + (i & 3); }

struct Unit { int pm, pn; };
struct Gemm { const bf16_t* A; const bf16_t* Bt; int M, N, K; };

struct StaticOrder {
    int nM, nN, nwg, G, c;
    __host__ __device__ void init(int M, int N, int G_, int c_) { nM = M / BM; nN = N / BM; nwg = nM * nN; G = G_; c = c_; }
    __host__ __device__ bool next(int i, Unit& u) const {
        const long L = (long)i * G + c; if (L >= nwg) return false;
        int wgid = (int)L; { const int q = nwg / NXCD, r = nwg % NXCD, xcd = wgid % NXCD, off = wgid / NXCD; wgid = (xcd < r ? xcd * (q + 1) : r * (q + 1) + (xcd - r) * q) + off; }
        const int nig = WGM * nN, gid = wgid / nig, fm = gid * WGM, gsz = (nM - fm) < WGM ? (nM - fm) : WGM;
        u.pm = fm + ((wgid % nig) % gsz); u.pn = (wgid % nig) / gsz; return true;
    }
    __device__ __forceinline__ void a_ready(const Unit&) const {}
    __device__ __forceinline__ void done(const Unit&) const {}
};

__device__ __forceinline__ unsigned cvt_pk_bf16(float lo, float hi) { unsigned r; asm volatile("v_cvt_pk_bf16_f32 %0, %1, %2" : "=v"(r) : "v"(lo), "v"(hi)); return r; }
typedef float f32x2 __attribute__((ext_vector_type(2)));
template <class Epi, class Sched, bool ALIGN_EPI = false, bool SP2 = false, bool ROWPERM = false>
__device__ __forceinline__ void gemm_phase(PG8_LAS unsigned char* lds, const Gemm g, const Sched& S, const Epi& E) {
    int tid = threadIdx.x; asm volatile("" : "+v"(tid));
    const int wid = __builtin_amdgcn_readfirstlane(tid >> 6), lane = tid & 63, wr = wid >> 2, wc = wid & 3, fr = lane & 15, fq = lane >> 4;
    const int K = g.K, nt = K / BK;
    unsigned voffA[2], voffB[2];
#pragma unroll
    for (int i = 0; i < 2; ++i) { int R, C; stage_rc(tid * 16 + i * 8192, R, C); const int Rb = Epi::PERM ? ((R & ~31) + perm32(R & 31)) : R;
        const int Ra = ROWPERM ? (128 * (R >> 6) + 8 * (R & 15) + ((R >> 4) & 3)) : R;
        voffA[i] = (unsigned)(Ra * K + C) * 2u; voffB[i] = (unsigned)(Rb * K + C) * 2u; }
    const size_t kstep = (size_t)(BK * 2);
    const size_t hstep = (size_t)HALF * K * 2;
    const size_t hstepA = ROWPERM ? (size_t)4 * K * 2 : hstep;
    const size_t tstep = 2 * hstep;
    const unsigned ldsw = (unsigned)wid * 1024u;
    const int aoff = lds_byte(wr * 64 + fr, fq * 8), boff = lds_byte(wc * 32 + fr, fq * 8);
#define PG8_SA(b, h) (((b) * 2 + (h)) * HTB)
#define PG8_SB(b, h) ((4 + (b) * 2 + (h)) * HTB)
#define PG8_STAGE(bufoff, gbase, voff) do { _Pragma("unroll") for (int _i = 0; _i < 2; ++_i) \
        __builtin_amdgcn_global_load_lds((const unsigned*)((const char*)(gbase) + (voff)[_i]), (PG8_LAS unsigned*)(lds + (bufoff) + ldsw + _i * 8192), 16, 0, 0); } while (0)
#define PG8_LDA(dst, b, h) do { _Pragma("unroll") for (int m = 0; m < 4; ++m) _Pragma("unroll") for (int k = 0; k < 2; ++k) dst[m][k] = *(const PG8_LAS bf16x8*)(lds + PG8_SA(b, h) + aoff + m * 2048 + k * 1024); } while (0)
#define PG8_LDB(dst, b, h) do { _Pragma("unroll") for (int n = 0; n < 2; ++n) _Pragma("unroll") for (int k = 0; k < 2; ++k) dst[n][k] = *(const PG8_LAS bf16x8*)(lds + PG8_SB(b, h) + boff + n * 2048 + k * 1024); } while (0)
#define PG8_MMA(ai, bj, At, Bt) do { __builtin_amdgcn_s_setprio(1); _Pragma("unroll") for (int m = 0; m < 4; ++m) _Pragma("unroll") for (int n = 0; n < 2; ++n) _Pragma("unroll") for (int k = 0; k < 2; ++k) \
        acc[ai][bj][m][n] = __builtin_amdgcn_mfma_f32_16x16x32_bf16(Bt[n][k], At[m][k], acc[ai][bj][m][n], 0, 0, 0); __builtin_amdgcn_s_setprio(0); } while (0)
#define PG8_WAIT_V(n) asm volatile("s_waitcnt vmcnt(" #n ")" ::: "memory")
#define PG8_WAIT_L(n) asm volatile("s_waitcnt lgkmcnt(" #n ")" ::: "memory")
#define PG8_BAR __builtin_amdgcn_s_barrier()
#define PG8_SCHED __builtin_amdgcn_sched_barrier(0)
    Unit cur, nxt; int ui = 0;
    if (!S.next(0, cur)) return;
    f32x4 acc[2][2][4][2];
#pragma unroll
    for (int a = 0; a < 2; ++a)
#pragma unroll
        for (int b = 0; b < 2; ++b)
#pragma unroll
            for (int m = 0; m < 4; ++m)
#pragma unroll
                for (int n = 0; n < 2; ++n) acc[a][b][m][n] = (f32x4){0.f, 0.f, 0.f, 0.f};
    bf16x8 At[4][2], B0[2][2], B1[2][2];
    const char* cA = (const char*)g.A + (size_t)cur.pm * tstep; const char* cB = (const char*)g.Bt + (size_t)cur.pn * tstep;
    S.a_ready(cur);
    if constexpr (SP2) {
        PG8_STAGE(PG8_SB(0, 0), cB, voffB); PG8_STAGE(PG8_SB(0, 1), cB + hstep, voffB); PG8_STAGE(PG8_SA(0, 0), cA, voffA); PG8_STAGE(PG8_SA(0, 1), cA + hstepA, voffA);
        if (wr == 1) PG8_BAR;
        PG8_WAIT_V(2); PG8_BAR;
        PG8_STAGE(PG8_SB(1, 0), cB + kstep, voffB); PG8_STAGE(PG8_SA(1, 0), cA + kstep, voffA); PG8_STAGE(PG8_SB(1, 1), cB + hstep + kstep, voffB);
        PG8_WAIT_V(6); PG8_BAR;
    } else {
        PG8_STAGE(PG8_SB(0, 0), cB, voffB); PG8_STAGE(PG8_SA(0, 0), cA, voffA); PG8_STAGE(PG8_SB(0, 1), cB + hstep, voffB); PG8_STAGE(PG8_SA(0, 1), cA + hstepA, voffA);
        if (wr == 1) PG8_BAR;
        PG8_WAIT_V(4); PG8_BAR;
        PG8_STAGE(PG8_SB(1, 0), cB + kstep, voffB); PG8_STAGE(PG8_SA(1, 0), cA + kstep, voffA); PG8_STAGE(PG8_SB(1, 1), cB + hstep + kstep, voffB);
        PG8_WAIT_V(6); PG8_BAR;
    }
    for (;;) {
        const bool has_next = S.next(ui + 1, nxt);
        const char* nA = has_next ? (const char*)g.A + (size_t)nxt.pm * tstep : cA; const char* nB = has_next ? (const char*)g.Bt + (size_t)nxt.pn * tstep : cB;
        for (int t = 0; t < nt; t += 2) {
            const bool last = (t == nt - 2);
            const char* a1 = cA + (size_t)(t + 1) * kstep;
            const char* a2 = last ? nA : cA + (size_t)(t + 2) * kstep; const char* b2 = last ? nB : cB + (size_t)(t + 2) * kstep;
            const char* a3 = a2 + kstep; const char* b3 = b2 + kstep;
            if (last && has_next) S.a_ready(nxt);
            if constexpr (SP2) {
            PG8_LDB(B0, 0, 0); PG8_LDB(B1, 0, 1); PG8_SCHED; PG8_LDA(At, 0, 0); PG8_STAGE(PG8_SA(1, 1), a1 + hstepA, voffA);
            PG8_WAIT_V(8); PG8_WAIT_L(0); PG8_BAR; PG8_MMA(0, 0, At, B0); PG8_MMA(0, 1, At, B1); PG8_BAR; PG8_SCHED;
            PG8_LDA(At, 0, 1); PG8_STAGE(PG8_SB(0, 0), b2, voffB); PG8_STAGE(PG8_SB(0, 1), b2 + hstep, voffB); PG8_STAGE(PG8_SA(0, 0), a2, voffA);
            PG8_WAIT_V(8); PG8_WAIT_L(0); PG8_BAR; PG8_MMA(1, 0, At, B0); PG8_MMA(1, 1, At, B1); PG8_BAR; PG8_SCHED;
            PG8_LDB(B0, 1, 0); PG8_LDB(B1, 1, 1); PG8_SCHED; PG8_LDA(At, 1, 0); PG8_STAGE(PG8_SA(0, 1), a2 + hstepA, voffA);
            PG8_WAIT_V(8); PG8_WAIT_L(0); PG8_BAR; PG8_MMA(0, 0, At, B0); PG8_MMA(0, 1, At, B1); PG8_BAR; PG8_SCHED;
            PG8_LDA(At, 1, 1); PG8_STAGE(PG8_SB(1, 0), b3, voffB); PG8_STAGE(PG8_SB(1, 1), b3 + hstep, voffB); PG8_STAGE(PG8_SA(1, 0), a3, voffA);
            PG8_WAIT_V(8); PG8_WAIT_L(0); PG8_BAR; PG8_MMA(1, 0, At, B0); PG8_MMA(1, 1, At, B1); PG8_BAR; PG8_SCHED;
            } else {
            PG8_LDB(B0, 0, 0); PG8_SCHED; PG8_LDA(At, 0, 0); PG8_STAGE(PG8_SA(1, 1), a1 + hstepA, voffA);
            PG8_WAIT_L(8); PG8_BAR; PG8_WAIT_L(0); PG8_MMA(0, 0, At, B0); PG8_BAR; PG8_SCHED;
            PG8_LDB(B1, 0, 1); PG8_STAGE(PG8_SB(0, 0), b2, voffB);
            PG8_BAR; PG8_WAIT_L(0); PG8_MMA(0, 1, At, B1); PG8_BAR;
            PG8_LDA(At, 0, 1); PG8_STAGE(PG8_SA(0, 0), a2, voffA);
            PG8_BAR; PG8_WAIT_L(0); PG8_MMA(1, 0, At, B0); PG8_BAR; PG8_SCHED;
            PG8_STAGE(PG8_SB(0, 1), b2 + hstep, voffB);
            PG8_WAIT_V(6); PG8_BAR; PG8_MMA(1, 1, At, B1); PG8_BAR;
            PG8_LDB(B0, 1, 0); PG8_SCHED; PG8_LDA(At, 1, 0); PG8_STAGE(PG8_SA(0, 1), a2 + hstepA, voffA);
            PG8_WAIT_L(8); PG8_BAR; PG8_WAIT_L(0); PG8_MMA(0, 0, At, B0); PG8_BAR; PG8_SCHED;
            PG8_LDB(B1, 1, 1); PG8_STAGE(PG8_SB(1, 0), b3, voffB);
            PG8_BAR; PG8_WAIT_L(0); PG8_MMA(0, 1, At, B1); PG8_BAR;
            PG8_LDA(At, 1, 1); PG8_STAGE(PG8_SA(1, 0), a3, voffA);
            PG8_BAR; PG8_WAIT_L(0); PG8_MMA(1, 0, At, B0); PG8_BAR; PG8_SCHED;
            PG8_STAGE(PG8_SB(1, 1), b3 + hstep, voffB);
            PG8_WAIT_V(6); PG8_BAR; PG8_MMA(1, 1, At, B1); PG8_BAR;
            }
        }
        if constexpr (ALIGN_EPI) { if (wr == 0) PG8_BAR; }
        if constexpr (!Epi::AFTER_DRAIN) { E(acc, cur, wr, wc, fr, fq); S.done(cur); }
        if (!has_next) break;
#pragma unroll
        for (int a = 0; a < 2; ++a)
#pragma unroll
            for (int b = 0; b < 2; ++b)
#pragma unroll
                for (int m = 0; m < 4; ++m)
#pragma unroll
                    for (int n = 0; n < 2; ++n) acc[a][b][m][n] = (f32x4){0.f, 0.f, 0.f, 0.f};
        cur = nxt; cA = nA; cB = nB; ++ui;
        if constexpr (ALIGN_EPI) { if (wr == 1) PG8_BAR; }
    }
    PG8_WAIT_V(0);
    if constexpr (!ALIGN_EPI) { if (wr == 0) PG8_BAR; }
    PG8_BAR;
    if constexpr (Epi::AFTER_DRAIN) { E.fused(acc, cur, wr, wc, fr, fq, lds, wid, lane); S.done(cur); }
#undef PG8_SA
#undef PG8_SB
#undef PG8_STAGE
#undef PG8_LDA
#undef PG8_LDB
#undef PG8_MMA
#undef PG8_WAIT_V
#undef PG8_WAIT_L
#undef PG8_BAR
#undef PG8_SCHED
}
}

constexpr int BATCH = 2, SEQ = 8192, D = 1024, M = BATCH * SEQ, DEPTH = 2;
constexpr int PW = 512, HW = 512, NH = 4, HD = 128, CH = 64, NCH = SEQ / CH, NBH = BATCH * NH, NUNIT = NBH * NCH;
constexpr int IN_COLS = 4608, NMIX = 2560, NGATE = 2048, DFF = 2816, NUP = 2 * DFF;
constexpr float EPS = 1e-6f;
constexpr int NWAVES = 8, NTHREADS = 512;
constexpr int LDS_BYTES = 147456;

constexpr size_t MiB = 1u << 20;
constexpr size_t WS_BAR = 512 * 1024, BAR_BYTES = 16384;
constexpr size_t WS_SSQ = 1 * MiB;
constexpr size_t WS_DEC = 2 * MiB;
constexpr size_t WS_LB = 2 * MiB + 768 * 1024;
constexpr size_t WS_HBND = 3 * MiB;
constexpr size_t WS_W = 9 * MiB, W_LAYER = 29 * MiB + 512 * 1024;
constexpr size_t WO_IN = 0, WO_A = 9 * MiB, WO_PB = 10 * MiB, WO_O = 11 * MiB, WO_UP = 13 * MiB, WO_DN = 24 * MiB;
constexpr size_t WS_XB = 68 * MiB;
constexpr size_t WS_R = 100 * MiB;
constexpr size_t WS_U = WS_R, WS_HG = WS_R, WS_Q = WS_R + 16 * MiB, WS_V = WS_R + 32 * MiB, WS_SO = WS_R + 48 * MiB, WS_G = WS_R + 64 * MiB;
constexpr size_t WS_POOL = WS_R + 96 * MiB, WS_UT = WS_R + 112 * MiB, WS_GATES = WS_R + 16 * MiB, WS_MERGED = WS_R + 112 * MiB, WS_ACT = WS_R;
constexpr size_t WS_XF = WS_R + 88 * MiB;
constexpr size_t WS_END = 256 * MiB;
static_assert(WS_UT + 32 * MiB <= WS_END && WS_ACT + (size_t)M * DFF * 2 <= WS_END && WS_GATES + 64 * MiB <= WS_POOL, "ws map");

#define LAS __attribute__((address_space(3)))
typedef unsigned short bf16;
typedef unsigned u32x4 __attribute__((ext_vector_type(4)));
typedef unsigned u32x2 __attribute__((ext_vector_type(2)));
typedef float f32x4 __attribute__((ext_vector_type(4)));
typedef float f32x2 __attribute__((ext_vector_type(2)));
typedef short bf16x8 __attribute__((ext_vector_type(8)));

__device__ __forceinline__ float bflo(unsigned w) { return __uint_as_float(w << 16); }
__device__ __forceinline__ float bfhi(unsigned w) { return __uint_as_float(w & 0xffff0000u); }
typedef __bf16 bf16x2_t __attribute__((ext_vector_type(2)));
__device__ __forceinline__ unsigned pk(float lo, float hi) { const bf16x2_t v = __builtin_convertvector((f32x2){lo, hi}, bf16x2_t); return __builtin_bit_cast(unsigned, v); }
__device__ __forceinline__ float sigm(float x) { return 1.f / (1.f + __expf(-x)); }
__device__ __forceinline__ float silu(float x) { return x * sigm(x); }
__device__ __forceinline__ float wave_sum(float v) {
#pragma unroll
    for (int o = 1; o < 64; o <<= 1) v += __shfl_xor(v, o);
    return v;
}
__device__ __forceinline__ float dpp_shr1(float x) { return __int_as_float(__builtin_amdgcn_update_dpp(0, __float_as_int(x), 0x111, 0xf, 0xf, true)); }
#define LDS_WAIT() asm volatile("s_waitcnt lgkmcnt(0)" ::: "memory")
#define VM_WAIT() asm volatile("s_waitcnt vmcnt(0)" ::: "memory")

__device__ __forceinline__ float load_rs(const float* ssq, int row0, int lane) {
    const f32x4* p = (const f32x4*)(ssq + (size_t)(row0 + lane) * 16);
    const f32x4 a = p[0], b = p[1], c = p[2], d = p[3];
    const f32x4 s = (a + b) + (c + d);
    return rsqrtf(((s[0] + s[1]) + (s[2] + s[3])) * (1.f / D) + EPS);
}

struct EpiInMix {
    static constexpr bool PERM = true, AFTER_DRAIN = false;
    bf16 *u, *q, *v, *so; bf16* g; const float* ssq; const float* lb; bf16* gates; const float* bgate; int pn_off;
    __device__ __forceinline__ void operator()(const f32x4 (&acc)[2][2][4][2], const pg8::Unit& un0, int wr, int wc, int fr, int fq) const {
        const int lane = fr + 16 * fq;
        pg8::Unit un = un0; un.pn += pn_off;
        float rs[2]; rs[0] = load_rs(ssq, un.pm * 256 + wr * 64, lane); rs[1] = load_rs(ssq, un.pm * 256 + 128 + wr * 64, lane);
        const int sec = un.pn >> 1, colt = (un.pn & 1) * 256 + wc * 32 + 8 * fq, row0 = un.pm * 256 + wr * 64 + fr;
        if (un.pn >= 10) {
            const int col0 = (un.pn - 10) * 256 + wc * 32 + 8 * fq;
            f32x4 bv[2][2];
#pragma unroll
            for (int bj = 0; bj < 2; ++bj)
#pragma unroll
                for (int n = 0; n < 2; ++n) bv[bj][n] = *(const f32x4*)(bgate + col0 + bj * 128 + 4 * n);
#pragma unroll
            for (int ai = 0; ai < 2; ++ai)
#pragma unroll
                for (int m = 0; m < 4; ++m) {
                    const float r = __shfl(rs[ai], 16 * m + fr);
                    bf16* rowp = gates + (size_t)(row0 + ai * 128 + m * 16) * NGATE + col0;
#pragma unroll
                    for (int bj = 0; bj < 2; ++bj) {
                        f32x4 v0 = acc[ai][bj][m][0] * r + bv[bj][0], v1 = acc[ai][bj][m][1] * r + bv[bj][1];
#pragma unroll
                        for (int e = 0; e < 4; ++e) { v0[e] = sigm(v0[e]); v1[e] = sigm(v1[e]); }
                        u32x4 w; w.x = pk(v0[0], v0[1]); w.y = pk(v0[2], v0[3]); w.z = pk(v1[0], v1[1]); w.w = pk(v1[2], v1[3]);
                        *(u32x4*)(rowp + bj * 128) = w;
                    }
                }
        } else if (sec == 2) {
            f32x4 lbv[2][2];
#pragma unroll
            for (int bj = 0; bj < 2; ++bj)
#pragma unroll
                for (int n = 0; n < 2; ++n) lbv[bj][n] = *(const f32x4*)(lb + colt + bj * 128 + 4 * n);
#pragma unroll
            for (int ai = 0; ai < 2; ++ai)
#pragma unroll
                for (int m = 0; m < 4; ++m) {
                    const float r = __shfl(rs[ai], 16 * m + fr);
                    bf16* rowp = g + (size_t)(row0 + ai * 128 + m * 16) * 512 + colt;
#pragma unroll
                    for (int bj = 0; bj < 2; ++bj) {
                        float o[8];
#pragma unroll
                        for (int n = 0; n < 2; ++n) { const f32x4 z = acc[ai][bj][m][n] * r;
#pragma unroll
                            for (int e = 0; e < 4; ++e) { const float l = lbv[bj][n][e]; o[4 * n + e] = __logf(l + (1.f - l) * sigm(z[e])); } }
                        u32x4 w; w.x = pk(o[0], o[1]); w.y = pk(o[2], o[3]); w.z = pk(o[4], o[5]); w.w = pk(o[6], o[7]);
                        *(u32x4*)(rowp + bj * 128) = w;
                    }
                }
        } else {
            bf16* base = sec == 0 ? u : (sec == 1 ? q : (sec == 3 ? v : so));
            const bool act = (sec == 1 || sec == 4);
#pragma unroll
            for (int ai = 0; ai < 2; ++ai)
#pragma unroll
                for (int m = 0; m < 4; ++m) {
                    const float r = __shfl(rs[ai], 16 * m + fr);
                    bf16* rowp = base + (size_t)(row0 + ai * 128 + m * 16) * 512 + colt;
#pragma unroll
                    for (int bj = 0; bj < 2; ++bj) {
                        f32x4 v0 = acc[ai][bj][m][0] * r, v1 = acc[ai][bj][m][1] * r;
                        if (act) {
#pragma unroll
                            for (int e = 0; e < 4; ++e) { v0[e] = silu(v0[e]); v1[e] = silu(v1[e]); }
                        }
                        u32x4 w; w.x = pk(v0[0], v0[1]); w.y = pk(v0[2], v0[3]); w.z = pk(v1[0], v1[1]); w.w = pk(v1[2], v1[3]);
                        *(u32x4*)(rowp + bj * 128) = w;
                    }
                }
        }
    }
};


template <bool SECOND> struct EpiMerge {
    static constexpr bool PERM = true, AFTER_DRAIN = false;
    bf16* merged; const bf16* gates;
    __device__ __forceinline__ void operator()(const f32x4 (&acc)[2][2][4][2], const pg8::Unit& un, int wr, int wc, int fr, int fq) const {
        const int col0 = un.pn * 256 + wc * 32 + 8 * fq, row0 = un.pm * 256 + wr * 64 + fr;
#pragma unroll
        for (int ai = 0; ai < 2; ++ai)
#pragma unroll
            for (int m = 0; m < 4; ++m) {
                const size_t row = (size_t)(row0 + ai * 128 + m * 16);
#pragma unroll
                for (int bj = 0; bj < 2; ++bj) {
                    const u32x4 gw = *(const u32x4*)(gates + row * NGATE + (SECOND ? 1024 : 0) + col0 + bj * 128);
                    const f32x4 a0 = acc[ai][bj][m][0], a1 = acc[ai][bj][m][1];
                    float o[8];
                    o[0] = bflo(gw.x) * a0[0]; o[1] = bfhi(gw.x) * a0[1]; o[2] = bflo(gw.y) * a0[2]; o[3] = bfhi(gw.y) * a0[3];
                    o[4] = bflo(gw.z) * a1[0]; o[5] = bfhi(gw.z) * a1[1]; o[6] = bflo(gw.w) * a1[2]; o[7] = bfhi(gw.w) * a1[3];
                    bf16* mp = merged + row * D + col0 + bj * 128;
                    if (SECOND) {
                        const u32x4 ow = *(const u32x4*)mp;
                        o[0] += bflo(ow.x); o[1] += bfhi(ow.x); o[2] += bflo(ow.y); o[3] += bfhi(ow.y);
                        o[4] += bflo(ow.z); o[5] += bfhi(ow.z); o[6] += bflo(ow.w); o[7] += bfhi(ow.w);
                    }
                    u32x4 w; w.x = pk(o[0], o[1]); w.y = pk(o[2], o[3]); w.z = pk(o[4], o[5]); w.w = pk(o[6], o[7]);
                    *(u32x4*)mp = w;
                }
            }
    }
};

template <bool LAST> struct EpiRes {
    static constexpr bool PERM = true, AFTER_DRAIN = false;
    float* out; bf16* xb; float* ssq;
    __device__ __forceinline__ void operator()(const f32x4 (&acc)[2][2][4][2], const pg8::Unit& un, int wr, int wc, int fr, int fq) const {
        const int col0 = un.pn * 256 + wc * 32 + 8 * fq, row0 = un.pm * 256 + wr * 64 + fr;
#pragma unroll
        for (int ai = 0; ai < 2; ++ai)
#pragma unroll
            for (int m = 0; m < 4; ++m) {
                const size_t row = (size_t)(row0 + ai * 128 + m * 16);
                float s = 0.f;
#pragma unroll
                for (int bj = 0; bj < 2; ++bj) {
                    const size_t p = row * D + col0 + bj * 128;
                    const u32x4 bw = *(const u32x4*)(xb + p);
                    const f32x4 x0 = (f32x4){bflo(bw.x), bfhi(bw.x), bflo(bw.y), bfhi(bw.y)} + acc[ai][bj][m][0], x1 = (f32x4){bflo(bw.z), bfhi(bw.z), bflo(bw.w), bfhi(bw.w)} + acc[ai][bj][m][1];
                    s += (x0[0] * x0[0] + x0[1] * x0[1]) + (x0[2] * x0[2] + x0[3] * x0[3]) + (x1[0] * x1[0] + x1[1] * x1[1]) + (x1[2] * x1[2] + x1[3] * x1[3]);
                    if (LAST) { *(f32x4*)(out + p) = x0; *(f32x4*)(out + p + 4) = x1; }
                    else { u32x4 w; w.x = pk(x0[0], x0[1]); w.y = pk(x0[2], x0[3]); w.z = pk(x1[0], x1[1]); w.w = pk(x1[2], x1[3]); *(u32x4*)(xb + p) = w; }
                }
                s += __shfl_xor(s, 16); s += __shfl_xor(s, 32);
                if (fq == 0) ssq[row * 16 + un.pn * 4 + wc] = s;
            }
    }
};

struct EpiUpConv {
    static constexpr bool PERM = false, AFTER_DRAIN = false;
    bf16* act; bf16* hbnd; const float* ssq; const float* cw; const float* cb;
    __device__ __forceinline__ void operator()(f32x4 (&acc)[2][2][4][2], const pg8::Unit& un, int wr, int wc, int fr, int fq) const {
        const int lane = fr + 16 * fq;
        {
            const float rs0 = load_rs(ssq, un.pm * 256 + 128 * wr, lane), rs1 = load_rs(ssq, un.pm * 256 + 128 * wr + 64, lane);
#pragma unroll
            for (int j = 0; j < 8; ++j) { const int src = (8 * fr + j) & 63; const float a = __shfl(rs0, src), b = __shfl(rs1, src); const float r = fr < 8 ? a : b;
#pragma unroll
                for (int bj = 0; bj < 2; ++bj)
#pragma unroll
                    for (int n = 0; n < 2; ++n) acc[j >> 2][bj][j & 3][n] *= r; }
        }
        const size_t tok0 = (size_t)un.pm * 256 + 128 * wr + 8 * fr;
        const int blk = un.pm * 2 + wr;
#pragma unroll
        for (int n = 0; n < 2; ++n) {
            const int ch0 = un.pn * 128 + wc * 32 + 16 * n + 4 * fq;
            if (fr == 15) {
                bf16* hb = hbnd + ((size_t)(blk * 4 + 2) * 2) * DFF + ch0;
                const f32x4 hv6 = acc[1][0][2][n], hv7 = acc[1][0][3][n], hg6 = acc[1][1][2][n], hg7 = acc[1][1][3][n];
                *(u32x2*)(hb) = (u32x2){pk(hv6[0], hv6[1]), pk(hv6[2], hv6[3])}; *(u32x2*)(hb + DFF) = (u32x2){pk(hg6[0], hg6[1]), pk(hg6[2], hg6[3])};
                *(u32x2*)(hb + 2 * DFF) = (u32x2){pk(hv7[0], hv7[1]), pk(hv7[2], hv7[3])}; *(u32x2*)(hb + 3 * DFF) = (u32x2){pk(hg7[0], hg7[1]), pk(hg7[2], hg7[3])};
            }
            if (fr == 0) {
#pragma unroll
                for (int j = 0; j < 2; ++j) { bf16* hb = hbnd + ((size_t)(blk * 4 + j) * 2) * DFF + ch0; const f32x4 hv = acc[0][0][j][n], hg = acc[0][1][j][n];
                    *(u32x2*)(hb) = (u32x2){pk(hv[0], hv[1]), pk(hv[2], hv[3])}; *(u32x2*)(hb + DFF) = (u32x2){pk(hg[0], hg[1]), pk(hg[2], hg[3])}; }
            }
#pragma unroll
            for (int bj = 0; bj < 2; ++bj) {
                const float* cwp = cw + bj * DFF + ch0;
                const f32x4 w0 = *(const f32x4*)(cwp), w1 = *(const f32x4*)(cwp + NUP), w2 = *(const f32x4*)(cwp + 2 * NUP), bb = *(const f32x4*)(cb + bj * DFF + ch0);
                f32x4 m2, m1;
#pragma unroll
                for (int e = 0; e < 4; ++e) { m2[e] = dpp_shr1(acc[1][bj][2][n][e]); m1[e] = dpp_shr1(acc[1][bj][3][n][e]); }
#pragma unroll
                for (int j = 7; j >= 0; --j) {
                    const f32x4 h0 = acc[j >> 2][bj][j & 3][n];
                    const f32x4 hm1 = j >= 1 ? acc[(j - 1 + 8) % 8 >> 2][bj][(j - 1 + 8) % 8 & 3][n] : m1;
                    const f32x4 hm2 = j >= 2 ? acc[(j - 2 + 8) % 8 >> 2][bj][(j - 2 + 8) % 8 & 3][n] : (j == 1 ? m1 : m2);
                    acc[j >> 2][bj][j & 3][n] = w2 * h0 + w1 * hm1 + w0 * hm2 + bb;
                }
            }
#pragma unroll
            for (int j = 0; j < 8; ++j) {
                const f32x4 vc = acc[j >> 2][0][j & 3][n], gc = acc[j >> 2][1][j & 3][n];
                f32x4 a;
#pragma unroll
                for (int e = 0; e < 4; ++e) a[e] = vc[e] * silu(gc[e]);
                if (!(j < 2 && fr == 0)) *(u32x2*)(act + (tok0 + j) * DFF + ch0) = (u32x2){pk(a[0], a[1]), pk(a[2], a[3])};
            }
        }
    }
};

struct Args { const float* in[17]; float* out; unsigned char* ws; int ph_lo, ph_hi; };

struct TrItem { const float* W; const float* rscale; bf16* WT; int K, N, drow0, k0, n0; };
__device__ __forceinline__ void tr_load(const TrItem& t, int lane, float (&wv)[32]) {
#pragma unroll
    for (int i = 0; i < 32; ++i) { const int kk = 2 * i + (lane >> 5); wv[i] = t.W[(size_t)(t.k0 + kk) * t.N + t.n0 + (lane & 31)]; }
    if (t.rscale) {
#pragma unroll
        for (int i = 0; i < 32; ++i) wv[i] *= t.rscale[t.k0 + 2 * i + (lane >> 5)];
    }
}
__device__ __forceinline__ void tr_store(const TrItem& t, int lane, const float (&wv)[32], LAS float* scr) {
#pragma unroll
    for (int i = 0; i < 32; ++i) scr[(2 * i + (lane >> 5)) * 33 + (lane & 31)] = wv[i];
    LDS_WAIT(); asm volatile("" ::: "memory");
    const int c = lane & 7;
#pragma unroll
    for (int j = 0; j < 4; ++j) { const int n = (lane >> 3) + 8 * j; const LAS float* sp = scr + (8 * c) * 33 + n;
        u32x4 o; o.x = pk(sp[0 * 33], sp[1 * 33]); o.y = pk(sp[2 * 33], sp[3 * 33]); o.z = pk(sp[4 * 33], sp[5 * 33]); o.w = pk(sp[6 * 33], sp[7 * 33]);
        *(u32x4*)(t.WT + (size_t)(t.drow0 + n) * t.K + t.k0 + 8 * c) = o; }
    LDS_WAIT(); asm volatile("" ::: "memory");
}
constexpr int I_IN = (D / 64) * (IN_COLS / 32), I_PB = (HW / 64) * (D / 32), I_O = (D / 64) * (D / 32), I_UP = (D / 64) * (NUP / 32), I_DN = (DFF / 64) * (D / 32);
constexpr int I_LAYER = I_IN + I_PB + I_O + I_UP + I_DN;
__device__ __forceinline__ TrItem tr_decode(const Args& a, int it) {
    const int l = it / I_LAYER; int r = it % I_LAYER;
    unsigned char* wl = a.ws + WS_W + (size_t)l * W_LAYER;
    TrItem t;
    if (r < I_IN) { const int nb = IN_COLS / 32; t.k0 = 64 * (r / nb); t.n0 = 32 * (r % nb); t.W = a.in[2] + (size_t)l * D * IN_COLS; t.K = D; t.N = IN_COLS; t.rscale = a.in[1] + l * D; t.WT = (bf16*)(wl + WO_IN); t.drow0 = t.n0; return t; }
    r -= I_IN;
    if (r < I_PB) { const int nb = D / 32; t.k0 = 64 * (r / nb); t.n0 = 32 * (r % nb); t.W = a.in[9] + (size_t)l * HW * D; t.K = HW; t.N = D; t.rscale = nullptr; t.WT = (bf16*)(wl + WO_PB); t.drow0 = t.n0; return t; }
    r -= I_PB;
    if (r < I_O) { const int nb = D / 32; t.k0 = 64 * (r / nb); t.n0 = 32 * (r % nb); t.W = a.in[10] + (size_t)l * D * D; t.K = D; t.N = D; t.rscale = nullptr; t.WT = (bf16*)(wl + WO_O); t.drow0 = t.n0; return t; }
    r -= I_O;
    if (r < I_UP) { const int nb = NUP / 32; t.k0 = 64 * (r / nb); t.n0 = 32 * (r % nb); t.W = a.in[12] + (size_t)l * D * NUP; t.K = D; t.N = NUP; t.rscale = a.in[11] + l * D; t.WT = (bf16*)(wl + WO_UP);
        const int bjs = t.n0 / DFF, rr = t.n0 % DFF; t.drow0 = 256 * (rr / 128) + 128 * bjs + (rr % 128); return t; }
    r -= I_UP;
    { const int nb = D / 32; t.k0 = 64 * (r / nb); t.n0 = 32 * (r % nb); t.W = a.in[15] + (size_t)l * DFF * D; t.K = DFF; t.N = D; t.rscale = nullptr; t.WT = (bf16*)(wl + WO_DN); t.drow0 = t.n0; return t; }
}

__device__ __forceinline__ void convert_items(const Args& a, LAS unsigned char* lds, int it0, int it1, int r, int nr) {
    int tid = threadIdx.x; asm volatile("" : "+v"(tid));
    const int lane = tid & 63, wave = __builtin_amdgcn_readfirstlane(tid >> 6);
    LAS float* scr = (LAS float*)(lds + wave * 16384);
    const int gw = r * NWAVES + wave, NGW = nr * NWAVES;
    for (int it = it0 + gw; it < it1; it += 2 * NGW) {
        const bool two = it + NGW < it1;
        const TrItem t0 = tr_decode(a, it), t1 = tr_decode(a, two ? it + NGW : it);
        float w0[32], w1[32];
        tr_load(t0, lane, w0); if (two) tr_load(t1, lane, w1);
        tr_store(t0, lane, w0, scr); if (two) tr_store(t1, lane, w1, scr);
    }
}
__device__ __forceinline__ void fold_pool(const Args& a, LAS unsigned char* lds, int l0, int l1, int r, int nr) {
    int tid = threadIdx.x; asm volatile("" : "+v"(tid));
    const int lane = tid & 63, wave = __builtin_amdgcn_readfirstlane(tid >> 6);
    unsigned char* ws = a.ws;
    const float *pool_w = a.in[4], *pool_scale = a.in[5], *w_pa = a.in[8];
    LAS float* scr = (LAS float*)(lds + wave * 16384);
    for (int gt = l0 * 65536 + r * NTHREADS + tid; gt < l1 * 65536; gt += nr * NTHREADS) {
        const int l = __builtin_amdgcn_readfirstlane(gt >> 16), rem = gt & 65535, d = rem & 1023, cg8 = __builtin_amdgcn_readfirstlane(rem >> 10), gi = cg8 >> 4, c0 = (cg8 & 15) * 8;
        const float* pw = pool_w + ((size_t)(l * 4 + gi) * 128 + c0) * 128;
        const float* ps = pool_scale + l * PW + gi * 128;
        const float* wp = w_pa + ((size_t)l * PW + gi * 128) * D + d;
        LAS float* pwl = scr;
#pragma unroll
        for (int j = 0; j < 4; ++j) { const int e = j * 256 + lane * 4; const f32x4 v = *(const f32x4*)(pw + e) * *(const f32x4*)(ps + (e & 127)); *(LAS f32x4*)(pwl + e) = v; }
        LDS_WAIT(); asm volatile("" ::: "memory");
        float sacc[8];
#pragma unroll
        for (int i = 0; i < 8; ++i) sacc[i] = 0.f;
#pragma unroll 4
        for (int cp = 0; cp < 128; cp += 4) {
            const float w0 = wp[(size_t)cp * D], w1 = wp[(size_t)(cp + 1) * D], w2 = wp[(size_t)(cp + 2) * D], w3 = wp[(size_t)(cp + 3) * D];
#pragma unroll
            for (int i = 0; i < 8; ++i) { const f32x4 p = *(const LAS f32x4*)(pwl + i * 128 + cp); sacc[i] += (p[0] * w0 + p[1] * w1) + (p[2] * w2 + p[3] * w3); }
        }
        u32x4 o; o.x = pk(sacc[0], sacc[1]); o.y = pk(sacc[2], sacc[3]); o.z = pk(sacc[4], sacc[5]); o.w = pk(sacc[6], sacc[7]);
        *(u32x4*)((bf16*)(ws + WS_W + (size_t)l * W_LAYER + WO_A) + (size_t)d * PW + cg8 * 8) = o;
        LDS_WAIT(); asm volatile("" ::: "memory");
    }
}

__device__ __forceinline__ void phase_prologue(const Args& a, LAS unsigned char* lds, int G, bool lazy) {
    int tid = threadIdx.x; asm volatile("" : "+v"(tid));
    const int lane = tid & 63, wave = __builtin_amdgcn_readfirstlane(tid >> 6);
    unsigned char* ws = a.ws;
    const float *x = a.in[0], *lb_logits = a.in[6];
    const int gw = blockIdx.x * NWAVES + wave, NGW = G * NWAVES;
    convert_items(a, lds, 0, lazy ? I_IN : DEPTH * I_LAYER, (int)blockIdx.x, G);
    if (!lazy) fold_pool(a, lds, 0, DEPTH, (int)blockIdx.x, G);
    if (blockIdx.x == 0) {
        const int chn = tid;
        float mx = -1e30f;
        for (int l = 0; l < DEPTH; ++l) mx = fmaxf(mx, lb_logits[l * HW + chn]);
        float sum = 0.f;
        for (int l = 0; l < DEPTH; ++l) sum += expf(lb_logits[l * HW + chn] - mx);
        float cum = 0.f, c0v = 0.f;
        for (int l = 0; l < DEPTH; ++l) { cum += expf(lb_logits[l * HW + chn] - mx) / sum; if (l == 0) c0v = cum; ((float*)(ws + WS_LB))[l * HW + chn] = cum - c0v; }
    }
    bf16* xb = (bf16*)(ws + WS_XB); float* ssq = (float*)(ws + WS_SSQ);
    for (int m = gw; m < M; m += 4 * NGW) {
        f32x4 v[4][4]; bool ok[4];
#pragma unroll
        for (int q = 0; q < 4; ++q) { const int mq = m + q * NGW; ok[q] = mq < M; const f32x4* xr = (const f32x4*)(x + (size_t)(ok[q] ? mq : m) * D) + lane;
#pragma unroll
            for (int j = 0; j < 4; ++j) v[q][j] = xr[64 * j]; }
#pragma unroll
        for (int q = 0; q < 4; ++q) {
            const int mq = m + q * NGW;
            float sq = 0.f;
#pragma unroll
            for (int j = 0; j < 4; ++j) sq += (v[q][j][0] * v[q][j][0] + v[q][j][1] * v[q][j][1]) + (v[q][j][2] * v[q][j][2] + v[q][j][3] * v[q][j][3]);
            sq = wave_sum(sq);
            if (ok[q]) {
                u32x2* o8 = (u32x2*)(xb + (size_t)mq * D) + lane;
#pragma unroll
                for (int j = 0; j < 4; ++j) o8[64 * j] = (u32x2){pk(v[q][j][0], v[q][j][1]), pk(v[q][j][2], v[q][j][3])};
                if (lane < 16) ssq[(size_t)mq * 16 + lane] = lane == 0 ? sq : 0.f;
            }
        }
    }
}

__device__ __forceinline__ void phase_fir(const bf16* u, bf16* pooled, int G) {
    int tid = threadIdx.x; asm volatile("" : "+v"(tid));
    for (int item = blockIdx.x * NTHREADS + tid; item < (M / 8) * 64; item += G * NTHREADS) {
        const int cgp = item & 63, run = item >> 6, m0 = run * 8, ts = m0 & (SEQ - 1), w = 2 << (cgp >> 4);
        const bf16* up = u + (size_t)m0 * PW + cgp * 8;
        float s[8];
#pragma unroll
        for (int i = 0; i < 8; ++i) s[i] = 0.f;
        for (int d = 1; d < w; ++d) if (ts - d >= 0) {
            const u32x4 x = *(const u32x4*)(up - (size_t)d * PW);
            s[0] += bflo(x.x); s[1] += bfhi(x.x); s[2] += bflo(x.y); s[3] += bfhi(x.y); s[4] += bflo(x.z); s[5] += bfhi(x.z); s[6] += bflo(x.w); s[7] += bfhi(x.w);
        }
#pragma unroll
        for (int r = 0; r < 8; ++r) {
            const u32x4 x = *(const u32x4*)(up + (size_t)r * PW);
            float c[8] = {bflo(x.x), bfhi(x.x), bflo(x.y), bfhi(x.y), bflo(x.z), bfhi(x.z), bflo(x.w), bfhi(x.w)};
#pragma unroll
            for (int i = 0; i < 8; ++i) s[i] += c[i];
            const int cnt = (ts + r + 1) < w ? (ts + r + 1) : w; const float inv = 1.f / (float)cnt;
            u32x4 o; o.x = pk(s[0] * inv - c[0], s[1] * inv - c[1]); o.y = pk(s[2] * inv - c[2], s[3] * inv - c[3]);
            o.z = pk(s[4] * inv - c[4], s[5] * inv - c[5]); o.w = pk(s[6] * inv - c[6], s[7] * inv - c[7]);
            *(u32x4*)(pooled + (size_t)(m0 + r) * PW + cgp * 8) = o;
            if (ts + r - w + 1 >= 0) {
                const u32x4 y = *(const u32x4*)(up + ((ptrdiff_t)r - w + 1) * PW);
                s[0] -= bflo(y.x); s[1] -= bfhi(y.x); s[2] -= bflo(y.y); s[3] -= bfhi(y.y); s[4] -= bflo(y.z); s[5] -= bfhi(y.z); s[6] -= bflo(y.w); s[7] -= bfhi(y.w);
            }
        }
    }
}

__device__ __forceinline__ u32x4 pack_lo8(const unsigned (&v)[8]) { u32x4 o; o.x = (v[0] & 0xffffu) | (v[1] << 16); o.y = (v[2] & 0xffffu) | (v[3] << 16); o.z = (v[4] & 0xffffu) | (v[5] << 16); o.w = (v[6] & 0xffffu) | (v[7] << 16); return o; }
__device__ __forceinline__ u32x4 pack_hi8(const unsigned (&v)[8]) { u32x4 o; o.x = (v[0] >> 16) | (v[1] & 0xffff0000u); o.y = (v[2] >> 16) | (v[3] & 0xffff0000u); o.z = (v[4] >> 16) | (v[5] & 0xffff0000u); o.w = (v[6] >> 16) | (v[7] & 0xffff0000u); return o; }

#define WG_BAR() do { asm volatile("s_waitcnt lgkmcnt(0)" ::: "memory"); __builtin_amdgcn_s_barrier(); asm volatile("" ::: "memory"); } while (0)
__device__ __forceinline__ void phase_h1(LAS unsigned char* lds, const bf16* g, const bf16* vb, bf16* UT, float* dec, int G) {
    int tid = threadIdx.x; asm volatile("" : "+v"(tid));
    const int lane = tid & 63, w = __builtin_amdgcn_readfirstlane(tid >> 6), r16 = lane & 15, q4 = lane >> 4;
    LAS unsigned char* KT = lds; LAS unsigned char* VT = lds + 18432; LAS float* SEG = (LAS float*)(lds + 36864);
    f32x2 gg[8]; unsigned vv[8];
    int unit = blockIdx.x;
    if (unit < NUNIT) {
        const int bh = unit >> 7, c = unit & 127, b = bh >> 2, h = bh & 3;
        const size_t m0 = (size_t)b * SEQ + c * CH + 8 * w; const int col = h * HD + 2 * lane;
#pragma unroll
        for (int r = 0; r < 8; ++r) { { const unsigned gw_ = *(const unsigned*)(g + (m0 + r) * HW + col); gg[r] = (f32x2){bflo(gw_), bfhi(gw_)}; } vv[r] = *(const unsigned*)(vb + (m0 + r) * HW + col); }
    }
    for (; unit < NUNIT; unit += G) {
        f32x2 cs[8]; cs[0] = gg[0];
#pragma unroll
        for (int r = 1; r < 8; ++r) cs[r] = cs[r - 1] + gg[r];
        *(LAS f32x2*)(SEG + w * 128 + 2 * lane) = cs[7];
        *(LAS u32x4*)(VT + (2 * lane) * 144 + w * 16) = pack_lo8(vv); *(LAS u32x4*)(VT + (2 * lane + 1) * 144 + w * 16) = pack_hi8(vv);
        WG_BAR();
        f32x2 pre = {0.f, 0.f}, tot = {0.f, 0.f};
#pragma unroll
        for (int j = 0; j < 8; ++j) { const f32x2 sg = *(const LAS f32x2*)(SEG + j * 128 + 2 * lane); tot += sg; if (j < w) pre += sg; }
        unsigned kt[8];
#pragma unroll
        for (int r = 0; r < 8; ++r) { const f32x2 bb = pre + cs[r];
            kt[r] = pk((1.f - __expf(gg[r].x)) * __expf(tot.x - bb.x), (1.f - __expf(gg[r].y)) * __expf(tot.y - bb.y)); }
        *(LAS u32x4*)(KT + (2 * lane) * 144 + w * 16) = pack_lo8(kt); *(LAS u32x4*)(KT + (2 * lane + 1) * 144 + w * 16) = pack_hi8(kt);
        if (w == 0) *(f32x2*)(dec + (size_t)unit * HD + 2 * lane) = (f32x2){__expf(tot.x), __expf(tot.y)};
        const int nu = unit + G;
        if (nu < NUNIT) {
            const int bh = nu >> 7, c = nu & 127, b = bh >> 2, h = bh & 3;
            const size_t m0 = (size_t)b * SEQ + c * CH + 8 * w; const int col = h * HD + 2 * lane;
#pragma unroll
            for (int r = 0; r < 8; ++r) { { const unsigned gw_ = *(const unsigned*)(g + (m0 + r) * HW + col); gg[r] = (f32x2){bflo(gw_), bfhi(gw_)}; } vv[r] = *(const unsigned*)(vb + (m0 + r) * HW + col); }
        }
        WG_BAR();
        bf16x8 yv[2];
#pragma unroll
        for (int ks = 0; ks < 2; ++ks) yv[ks] = *(const LAS bf16x8*)(VT + (16 * w + r16) * 144 + ks * 64 + q4 * 16);
        bf16* ut = UT + (size_t)unit * (HD * HD) + (size_t)(16 * w + r16) * HD + 4 * q4;
#pragma unroll
        for (int nb = 0; nb < 8; ++nb) {
            f32x4 a = {0.f, 0.f, 0.f, 0.f};
#pragma unroll
            for (int ks = 0; ks < 2; ++ks) { const bf16x8 xk = *(const LAS bf16x8*)(KT + (16 * nb + r16) * 144 + ks * 64 + q4 * 16); a = __builtin_amdgcn_mfma_f32_16x16x32_bf16(xk, yv[ks], a, 0, 0, 0); }
            *(u32x2*)(ut + 16 * nb) = (u32x2){pk(a[0], a[1]), pk(a[2], a[3])};
        }
        WG_BAR();
    }
}

__device__ __forceinline__ void phase_h2(bf16* UT, const float* dec, int G) {
    int tid = threadIdx.x; asm volatile("" : "+v"(tid));
    for (int e = blockIdx.x * NTHREADS + tid; e < NBH * HD * HD; e += G * NTHREADS) {
        const int bh = e >> 14, idx = e & 16383, k = idx & 127;
        bf16* up = UT + (size_t)bh * NCH * (HD * HD) + idx; const float* dp = dec + (size_t)bh * NCH * HD + k;
        float S = 0.f;
        for (int c0 = 0; c0 < NCH; c0 += 16) {
            bf16 uu[16]; float dd[16];
#pragma unroll
            for (int i = 0; i < 16; ++i) { uu[i] = up[(size_t)(c0 + i) * (HD * HD)]; dd[i] = dp[(size_t)(c0 + i) * HD]; }
#pragma unroll
            for (int i = 0; i < 16; ++i) { up[(size_t)(c0 + i) * (HD * HD)] = (bf16)(pk(S, 0.f) & 0xffffu); S = dd[i] * S + __uint_as_float((unsigned)uu[i] << 16); }
        }
    }
}

__device__ __forceinline__ void phase_h3(LAS unsigned char* lds, const bf16* qb, const bf16* g, const bf16* vb, const bf16* sob, const bf16* ST, const float* ng, bf16* hg, int G) {
    constexpr int SR = 272;
    int tid = threadIdx.x; asm volatile("" : "+v"(tid));
    const int lane = tid & 63, w = __builtin_amdgcn_readfirstlane(tid >> 6), r16 = lane & 15, q4 = lane >> 4;
    LAS unsigned char* QH = lds; LAS unsigned char* QD = lds + 17408; LAS unsigned char* KD = lds + 34816; LAS unsigned char* KE = lds + 52224; LAS unsigned char* QO = lds + 69632;
    LAS unsigned char* VT = lds + 95744; LAS float* SEG = (LAS float*)(lds + 114176); LAS float* RMS = (LAS float*)(lds + 118272);
    const int bi = w >> 1, odd = w & 1;
    f32x2 gg[8]; unsigned qq[8], vv[8];
    int unit = blockIdx.x;
    if (unit < NUNIT) {
        const int bh = unit >> 7, c = unit & 127, b = bh >> 2, h = bh & 3;
        const size_t m0 = (size_t)b * SEQ + c * CH + 8 * w; const int col = h * HD + 2 * lane;
#pragma unroll
        for (int r = 0; r < 8; ++r) { { const unsigned gw_ = *(const unsigned*)(g + (m0 + r) * HW + col); gg[r] = (f32x2){bflo(gw_), bfhi(gw_)}; } qq[r] = *(const unsigned*)(qb + (m0 + r) * HW + col); vv[r] = *(const unsigned*)(vb + (m0 + r) * HW + col); }
    }
    for (; unit < NUNIT; unit += G) {
        const int bh = unit >> 7, c = unit & 127, b = bh >> 2, h = bh & 3;
        const size_t mu = (size_t)b * SEQ + c * CH;
        const bf16* STu = ST + (size_t)unit * (HD * HD) + (size_t)(64 * odd + r16) * HD + q4 * 8;
        bf16x8 xs[4][4];
#pragma unroll
        for (int ks = 0; ks < 4; ++ks)
#pragma unroll
            for (int nb = 0; nb < 4; ++nb) xs[ks][nb] = *(const bf16x8*)(STu + (size_t)(16 * nb) * HD + ks * 32);
        const size_t row = mu + 16 * bi + r16;
        u32x2 sv[4]; f32x4 ngv[4];
#pragma unroll
        for (int nb = 0; nb < 4; ++nb) { const int v0 = 64 * odd + 16 * nb + 4 * q4; ngv[nb] = *(const f32x4*)(ng + v0); sv[nb] = *(const u32x2*)(sob + row * HW + h * HD + v0); }
        f32x2 cs[8]; cs[0] = gg[0];
#pragma unroll
        for (int r = 1; r < 8; ++r) cs[r] = cs[r - 1] + gg[r];
        *(LAS f32x2*)(SEG + w * 128 + 2 * lane) = cs[7];
        *(LAS u32x4*)(VT + (2 * lane) * 144 + w * 16) = pack_lo8(vv); *(LAS u32x4*)(VT + (2 * lane + 1) * 144 + w * 16) = pack_hi8(vv);
        WG_BAR();
        f32x2 pre = {0.f, 0.f};
        for (int j = 0; j < w; ++j) pre += *(const LAS f32x2*)(SEG + j * 128 + 2 * lane);
        const f32x2 cmid = *(const LAS f32x2*)(SEG + (2 * bi) * 128 + 2 * lane);
        const f32x2 bsum = cmid + *(const LAS f32x2*)(SEG + (2 * bi + 1) * 128 + 2 * lane);
        f32x2 bsm1 = {0.f, 0.f}, bsm2 = {0.f, 0.f};
        if (bi >= 1) bsm1 = *(const LAS f32x2*)(SEG + (2 * bi - 2) * 128 + 2 * lane) + *(const LAS f32x2*)(SEG + (2 * bi - 1) * 128 + 2 * lane);
        if (bi >= 2) bsm2 = bsm1 + *(const LAS f32x2*)(SEG + (2 * bi - 4) * 128 + 2 * lane) + *(const LAS f32x2*)(SEG + (2 * bi - 3) * 128 + 2 * lane);
        const f32x2 cbase = odd ? cmid : (f32x2){0.f, 0.f};
        const int pbase = (bi * (bi - 1)) / 2;
#pragma unroll
        for (int r = 0; r < 8; ++r) {
            const int t = 8 * w + r, tl = 8 * odd + r;
            const f32x2 cl = cbase + cs[r], bf = pre + cs[r];
            const float qx = bflo(qq[r]), qy = bfhi(qq[r]);
            const float kx = 1.f - __expf(gg[r].x), ky = 1.f - __expf(gg[r].y);
            *(LAS unsigned*)(QH + t * SR + 4 * lane) = pk(qx * __expf(bf.x), qy * __expf(bf.y));
            *(LAS unsigned*)(QD + t * SR + 4 * lane) = pk(qx * __expf(fminf(cl.x - cmid.x, 80.f)), qy * __expf(fminf(cl.y - cmid.y, 80.f)));
            *(LAS unsigned*)(KD + t * SR + 4 * lane) = pk(kx * __expf(fminf(cmid.x - cl.x, 80.f)), ky * __expf(fminf(cmid.y - cl.y, 80.f)));
            if (bi < 3) *(LAS unsigned*)(KE + t * SR + 4 * lane) = pk(kx * __expf(bsum.x - cl.x), ky * __expf(bsum.y - cl.y));
            if (bi >= 1) *(LAS unsigned*)(QO + ((pbase + bi - 1) * 16 + tl) * SR + 4 * lane) = pk(qx * __expf(cl.x), qy * __expf(cl.y));
            if (bi >= 2) *(LAS unsigned*)(QO + ((pbase + bi - 2) * 16 + tl) * SR + 4 * lane) = pk(qx * __expf(cl.x + bsm1.x), qy * __expf(cl.y + bsm1.y));
            if (bi >= 3) *(LAS unsigned*)(QO + ((pbase + 0) * 16 + tl) * SR + 4 * lane) = pk(qx * __expf(cl.x + bsm2.x), qy * __expf(cl.y + bsm2.y));
        }
        WG_BAR();
        { const int nu = unit + G;
          if (nu < NUNIT) {
            const int bh2 = nu >> 7, c2 = nu & 127, b2 = bh2 >> 2, h2 = bh2 & 3;
            const size_t m0 = (size_t)b2 * SEQ + c2 * CH + 8 * w; const int col = h2 * HD + 2 * lane;
#pragma unroll
            for (int r = 0; r < 8; ++r) { { const unsigned gw_ = *(const unsigned*)(g + (m0 + r) * HW + col); gg[r] = (f32x2){bflo(gw_), bfhi(gw_)}; } qq[r] = *(const unsigned*)(qb + (m0 + r) * HW + col); vv[r] = *(const unsigned*)(vb + (m0 + r) * HW + col); }
          } }
        const int i = bi, vh = odd;
        f32x4 acc[4];
#pragma unroll
        for (int nb = 0; nb < 4; ++nb) acc[nb] = (f32x4){0.f, 0.f, 0.f, 0.f};
#pragma unroll
        for (int ks = 0; ks < 4; ++ks) {
            const bf16x8 y = *(const LAS bf16x8*)(QH + (16 * i + r16) * SR + ks * 64 + q4 * 16);
#pragma unroll
            for (int nb = 0; nb < 4; ++nb) acc[nb] = __builtin_amdgcn_mfma_f32_16x16x32_bf16(xs[ks][nb], y, acc[nb], 0, 0, 0);
        }
#pragma unroll
        for (int jp = 0; jp < 2; ++jp) {
            if (2 * jp <= i) {
                f32x4 p[2];
#pragma unroll
                for (int jj = 0; jj < 2; ++jj) {
                    const int j = 2 * jp + jj;
                    p[jj] = (f32x4){0.f, 0.f, 0.f, 0.f};
                    if (j <= i) {
                        const LAS unsigned char* Kb = (j == i ? KD : KE) + (16 * j + r16) * SR + q4 * 16;
                        const LAS unsigned char* Qb = (j == i ? QD + (16 * i + r16) * SR : QO + ((pbase + j) * 16 + r16) * SR) + q4 * 16;
#pragma unroll
                        for (int ks = 0; ks < 4; ++ks) { const bf16x8 xk = *(const LAS bf16x8*)(Kb + ks * 64); const bf16x8 yq = *(const LAS bf16x8*)(Qb + ks * 64); p[jj] = __builtin_amdgcn_mfma_f32_16x16x32_bf16(xk, yq, p[jj], 0, 0, 0); }
                        if (j == i) {
#pragma unroll
                            for (int e = 0; e < 4; ++e) if (4 * q4 + e > r16) p[jj][e] = 0.f;
                        }
                    }
                }
                u32x4 ypw; ypw.x = pk(p[0][0], p[0][1]); ypw.y = pk(p[0][2], p[0][3]); ypw.z = pk(p[1][0], p[1][1]); ypw.w = pk(p[1][2], p[1][3]);
                const bf16x8 yp = __builtin_bit_cast(bf16x8, ypw);
#pragma unroll
                for (int nb = 0; nb < 4; ++nb) {
                    const LAS unsigned char* vp = VT + (64 * vh + 16 * nb + r16) * 144 + (32 * jp + 4 * q4) * 2;
                    const u32x2 lo = *(const LAS u32x2*)vp, hi = *(const LAS u32x2*)(vp + 32);
                    const u32x4 xw = {lo.x, lo.y, hi.x, hi.y};
                    acc[nb] = __builtin_amdgcn_mfma_f32_16x16x32_bf16(__builtin_bit_cast(bf16x8, xw), yp, acc[nb], 0, 0, 0);
                }
            }
        }
        float ss = 0.f;
#pragma unroll
        for (int nb = 0; nb < 4; ++nb) ss += (acc[nb][0] * acc[nb][0] + acc[nb][1] * acc[nb][1]) + (acc[nb][2] * acc[nb][2] + acc[nb][3] * acc[nb][3]);
        ss += __shfl_xor(ss, 16); ss += __shfl_xor(ss, 32);
        if (q4 == 0) RMS[(16 * i + r16) * 2 + vh] = ss;
        WG_BAR();
        const float rstd = rsqrtf((RMS[(16 * i + r16) * 2] + RMS[(16 * i + r16) * 2 + 1]) * (1.f / HD) + EPS);
#pragma unroll
        for (int nb = 0; nb < 4; ++nb) {
            const int v0 = 64 * vh + 16 * nb + 4 * q4;
            const f32x4 o = acc[nb] * rstd * ngv[nb];
            *(u32x2*)(hg + row * HW + h * HD + v0) = (u32x2){pk(o[0] * bflo(sv[nb].x), o[1] * bfhi(sv[nb].x)), pk(o[2] * bflo(sv[nb].y), o[3] * bfhi(sv[nb].y))};
        }
        WG_BAR();
    }
}

__device__ __forceinline__ f32x4 bf4(u32x2 v) { return (f32x4){bflo(v.x), bfhi(v.x), bflo(v.y), bfhi(v.y)}; }
__device__ __forceinline__ void ffn_fixup(int pm, const bf16* hbnd, const float* cw, const float* cb, bf16* act) {
    int tid = threadIdx.x; asm volatile("" : "+v"(tid));
    for (int idx = tid; idx < DFF / 4; idx += NTHREADS) {
        const int c4 = idx * 4;
        const f32x4 wv0 = *(const f32x4*)(cw + c4), wv1 = *(const f32x4*)(cw + NUP + c4), wv2 = *(const f32x4*)(cw + 2 * NUP + c4), bv = *(const f32x4*)(cb + c4);
        const f32x4 wg0 = *(const f32x4*)(cw + DFF + c4), wg1 = *(const f32x4*)(cw + NUP + DFF + c4), wg2 = *(const f32x4*)(cw + 2 * NUP + DFF + c4), bg = *(const f32x4*)(cb + DFF + c4);
        u32x2 hv[2][4], hg[2][4];
#pragma unroll
        for (int bb = 0; bb < 2; ++bb) {
            const int blk = 2 * pm + bb; const bool first = (blk & 63) == 0;
#pragma unroll
            for (int k = 0; k < 4; ++k) {
                const int sb = k < 2 ? blk - 1 : blk, slot = k < 2 ? k + 2 : k - 2;
                const bf16* p = hbnd + ((size_t)(sb * 4 + slot) * 2) * DFF + c4;
                if (k < 2 && first) { hv[bb][k] = (u32x2){0u, 0u}; hg[bb][k] = (u32x2){0u, 0u}; }
                else { hv[bb][k] = *(const u32x2*)p; hg[bb][k] = *(const u32x2*)(p + DFF); }
            }
        }
#pragma unroll
        for (int bb = 0; bb < 2; ++bb)
#pragma unroll
            for (int dl = 0; dl < 2; ++dl) {
                const f32x4 vc = wv2 * bf4(hv[bb][2 + dl]) + wv1 * bf4(hv[bb][1 + dl]) + wv0 * bf4(hv[bb][dl]) + bv;
                const f32x4 gc = wg2 * bf4(hg[bb][2 + dl]) + wg1 * bf4(hg[bb][1 + dl]) + wg0 * bf4(hg[bb][dl]) + bg;
                f32x4 a;
#pragma unroll
                for (int e = 0; e < 4; ++e) a[e] = vc[e] * silu(gc[e]);
                *(u32x2*)(act + ((size_t)(2 * pm + bb) * 128 + dl) * DFF + c4) = (u32x2){pk(a[0], a[1]), pk(a[2], a[3])};
            }
    }
}

__device__ __forceinline__ void phase_final(const bf16* xb, float* out, const float* ssq, const float* fg, int G) {
    int tid = threadIdx.x; asm volatile("" : "+v"(tid));
    const int lane = tid & 63, wave = tid >> 6;
    for (int m = blockIdx.x * NWAVES + wave; m < M; m += G * NWAVES) {
        const f32x4* sp = (const f32x4*)(ssq + (size_t)m * 16);
        const f32x4 s = (sp[0] + sp[1]) + (sp[2] + sp[3]);
        const float rstd = rsqrtf(((s[0] + s[1]) + (s[2] + s[3])) * (1.f / D) + EPS);
        const u32x4* xr = (const u32x4*)(xb + (size_t)m * D) + lane; f32x4* orow = (f32x4*)(out + (size_t)m * D) + 2 * lane; const f32x4* gr = (const f32x4*)fg + 2 * lane;
#pragma unroll
        for (int j = 0; j < 2; ++j) { const u32x4 w = xr[64 * j];
            orow[128 * j] = (f32x4){bflo(w.x), bfhi(w.x), bflo(w.y), bfhi(w.y)} * rstd * gr[128 * j];
            orow[128 * j + 1] = (f32x4){bflo(w.z), bfhi(w.z), bflo(w.w), bfhi(w.w)} * rstd * gr[128 * j + 1]; }
    }
}


#ifndef DEBUG_SCAN
#define DEBUG_SCAN 0
#endif
__device__ __forceinline__ void scan_bf16(const bf16* p, size_t n, int* flags, int code, int G) {
    int tid = threadIdx.x; asm volatile("" : "+v"(tid));
    const u32x4* q = (const u32x4*)p; const size_t n16 = n / 8; bool bad = false, huge = false;
    for (size_t i = (size_t)blockIdx.x * NTHREADS + tid; i < n16; i += (size_t)G * NTHREADS) { const u32x4 w = q[i];
#pragma unroll
        for (int e = 0; e < 4; ++e) { const unsigned x = w[e]; if ((x & 0x7f80u) == 0x7f80u || (x & 0x7f800000u) == 0x7f800000u) bad = true; if (fabsf(bflo(x)) > 1e4f || fabsf(bfhi(x)) > 1e4f) huge = true; } }
    if (bad) flags[code] = 1; if (huge) flags[64 + code] = 1;
}
__device__ __forceinline__ void scan_f32(const float* p, size_t n, int* flags, int code, int G) {
    int tid = threadIdx.x; asm volatile("" : "+v"(tid));
    bool bad = false, huge = false;
    for (size_t i = (size_t)blockIdx.x * NTHREADS + tid; i < n; i += (size_t)G * NTHREADS) { const unsigned x = __float_as_uint(p[i]); if ((x & 0x7f800000u) == 0x7f800000u) bad = true; if (fabsf(p[i]) > 1e4f) huge = true; }
    if (bad) flags[code] = 1; if (huge) flags[64 + code] = 1;
}
#define XB_TMO      128
#define XB_XCNT(j)  (256  + 64 * (j))
#define XB_XSUB(j)  (1280 + 64 * (j))
#define XB_XGEN(j)  (2304 + 64 * (j))
#define XB_TOP      3328
#define XB_TOPGEN   3392
#define XCD_BAR_WORDS 3456
#define XB_SPIN_CAP (1u << 18)

__device__ __forceinline__ unsigned xb_ld(unsigned* p)              { return __hip_atomic_load(p, __ATOMIC_RELAXED, __HIP_MEMORY_SCOPE_AGENT); }
__device__ __forceinline__ unsigned xb_add(unsigned* p, unsigned v) { return __hip_atomic_fetch_add(p, v, __ATOMIC_RELAXED, __HIP_MEMORY_SCOPE_AGENT); }
__device__ __forceinline__ unsigned xb_xcc_id() { return (unsigned)__builtin_amdgcn_s_getreg((3 << 11) | 20) & 0xFu; }
#define XB_SPIN(cond, bar) do { unsigned _sp = 0; while (cond) { __builtin_amdgcn_s_sleep(1); \
    if ((++_sp & 255u) == 0u) { if (xb_ld(&(bar)[XB_TMO])) break; if (_sp > XB_SPIN_CAP) { atomicAdd(&(bar)[XB_TMO], 1u); break; } } } } while (0)

struct XcdBarrier {
    unsigned* bar; unsigned x;
    volatile LAS unsigned* st;
};

__device__ __forceinline__ XcdBarrier xcd_barrier_post(unsigned* bar, volatile LAS unsigned* st) {
    XcdBarrier b; b.bar = bar; b.x = xb_xcc_id(); b.st = st;
    if (threadIdx.x == 0) (void)xb_add(&bar[XB_XCNT(b.x)], 1u);
    return b;
}
__device__ __forceinline__ void xcd_barrier_complete(unsigned* bar, unsigned x, unsigned& nloc, unsigned& nx) {
    const unsigned G = gridDim.x * gridDim.y * gridDim.z;
    unsigned sum, cnt, mine, sp = 0u;
    for (;;) {
        sum = 0u; cnt = 0u; mine = 0u;
#pragma unroll
        for (unsigned j = 0; j < 16; ++j) { const unsigned c = xb_ld(&bar[XB_XCNT(j)]); sum += c; cnt += (c > 0u) ? 1u : 0u; mine = (j == x) ? c : mine; }
        if (sum == G) break;
        __builtin_amdgcn_s_sleep(1);
        if ((++sp & 255u) == 0u) { if (xb_ld(&bar[XB_TMO])) break; if (sp > XB_SPIN_CAP) { atomicAdd(&bar[XB_TMO], 1u); break; } }
    }
    nloc = mine > 0u ? mine : 1u; nx = cnt > 0u ? cnt : 1u;
}

__device__ __forceinline__ void xcd_barrier(const XcdBarrier& b) {
    asm volatile("s_waitcnt vmcnt(0)" ::: "memory");
    __syncthreads();
    if (threadIdx.x == 0) {
        unsigned* bar = b.bar;
        __builtin_amdgcn_s_waitcnt(0);
        unsigned nloc = b.st[0], nx = b.st[1];
        if (nloc == 0u) { xcd_barrier_complete(bar, b.x, nloc, nx); b.st[0] = nloc; b.st[1] = nx; }
        const unsigned old = xb_add(&bar[XB_XSUB(b.x)], 1u);
        const unsigned gen = old / nloc;
        if (old + 1u == (gen + 1u) * nloc) {
            __builtin_amdgcn_fence(__ATOMIC_RELEASE, "agent");
            asm volatile("s_waitcnt vmcnt(0)" ::: "memory");
            const unsigned og = xb_add(&bar[XB_TOP], 1u);
            const unsigned tg = og / nx;
            if (og + 1u == (tg + 1u) * nx) xb_add(&bar[XB_TOPGEN], 1u);
            else XB_SPIN(xb_ld(&bar[XB_TOPGEN]) == tg, bar);
            __builtin_amdgcn_fence(__ATOMIC_ACQUIRE, "agent");
            xb_add(&bar[XB_XGEN(b.x)], 1u);
            asm volatile("s_waitcnt vmcnt(0)" ::: "memory");
        } else {
            XB_SPIN(xb_ld(&bar[XB_XGEN(b.x)]) == gen, bar);
            __builtin_amdgcn_fence(__ATOMIC_ACQUIRE, "agent");
            asm volatile("s_waitcnt vmcnt(0)" ::: "memory");
        }
    }
    __syncthreads();
}

#ifndef ONE_LAUNCH
#define ONE_LAUNCH 1
#endif
constexpr int PH_PER_LAYER = 9, N_PHASES = 1 + DEPTH * PH_PER_LAYER + 1;

__global__ void __launch_bounds__(NTHREADS, 2) trunk_fwd(Args args) {
    extern __shared__ __attribute__((aligned(16))) unsigned char lds_raw[];
    LAS unsigned char* lds = (LAS unsigned char*)lds_raw;
    cg::grid_group grid = cg::this_grid();
    const int G = gridDim.x;
    unsigned char* ws = args.ws;
    float* out = args.out;
    const int lo = args.ph_lo, hi = args.ph_hi;
    float* ssq = (float*)(ws + WS_SSQ); float* dec = (float*)(ws + WS_DEC); bf16* hbnd = (bf16*)(ws + WS_HBND); bf16* xb = (bf16*)(ws + WS_XB);
    bf16 *ub = (bf16*)(ws + WS_U), *hgb = (bf16*)(ws + WS_HG), *qb = (bf16*)(ws + WS_Q), *vb = (bf16*)(ws + WS_V), *sob = (bf16*)(ws + WS_SO), *pooled = (bf16*)(ws + WS_POOL);
    bf16 *UT = (bf16*)(ws + WS_UT), *gates = (bf16*)(ws + WS_GATES), *merged = (bf16*)(ws + WS_MERGED), *act = (bf16*)(ws + WS_ACT);
    bf16* gl = (bf16*)(ws + WS_G);
#ifndef PHASE_MASK
#define PHASE_MASK 0xfff
#endif
#define EN(j) (((PHASE_MASK) >> (j)) & 1)
#define IN(k) (lo <= (k) && (k) < hi)
#define SC(k) (DEBUG_SCAN && lo == (k) && hi == (k) - 1)
    volatile LAS unsigned* MISC = (volatile LAS unsigned*)(lds + 131072 + 512);
    { int t_ = threadIdx.x; asm volatile("" : "+v"(t_)); if (t_ < 32) MISC[t_] = 0u; }
    __syncthreads();
    XcdBarrier bar = xcd_barrier_post((unsigned*)(ws + WS_BAR), MISC + 8);
#ifndef PROBE_A
#define PROBE_A -1
#define PROBE_B -1
#endif
    unsigned long long* tsb = (unsigned long long*)(ws + 4096);
#define STAMP(k) do { if (PROBE_A >= 0 && blockIdx.x == 0) { int t_ = threadIdx.x; asm volatile("" : "+v"(t_)); if (t_ == 0) tsb[(k)] = __builtin_amdgcn_s_memrealtime(); } } while (0)
#define SEAM(k) do { if (IN(k) && IN((k) + 1)) { if ((k) == 0) grid.sync(); else xcd_barrier(bar); } STAMP((k) + 1); } while (0)
    STAMP(0);

    int* dbg = (int*)ws;
    static_assert(DEPTH == 2, "the lazy weight-copy schedule below is written for two layers");
    const bool lazy = (G == 256) && lo == 0 && hi == N_PHASES;
    if (EN(9) && IN(0)) { if (DEBUG_SCAN && blockIdx.x == 0) { int t_ = threadIdx.x; asm volatile("" : "+v"(t_)); if (t_ < 128) dbg[t_] = 0; } phase_prologue(args, lds, G, lazy); }
    SEAM(0);
    for (int l = 0; l < DEPTH; ++l) {
        const int pb = 1 + l * PH_PER_LAYER;
        unsigned char* wl = ws + WS_W + (size_t)l * W_LAYER;
        const bf16* Win = (const bf16*)(wl + WO_IN);
        if (EN(0) && IN(pb + 0)) {
            pg8::Gemm g{xb, Win, M, NMIX, D}; pg8::StaticOrder S; S.init(M, NMIX, G, (int)blockIdx.x);
            EpiInMix E{ub, qb, vb, sob, gl, ssq, (const float*)(ws + WS_LB) + l * HW, gates, args.in[3] + l * NGATE, 0};
            pg8::gemm_phase<EpiInMix, pg8::StaticOrder, true, true>(lds, g, S, E);
            if (lazy && l == 0 && blockIdx.x >= 128) {
                convert_items(args, lds, I_IN, I_LAYER, (int)blockIdx.x - 128, 128);
                fold_pool(args, lds, 0, 1, (int)blockIdx.x - 128, 128);
            }
            if (lazy && l == 1 && blockIdx.x >= 128)
                convert_items(args, lds, I_LAYER + I_IN + I_PB + I_O, 2 * I_LAYER, (int)blockIdx.x - 128, 128);
        }
        SEAM(pb + 0);
        if (SC(pb + 1)) { const int cb_ = 20 * l; scan_bf16(ub, (size_t)M * 512, dbg, cb_ + 1, G); scan_bf16(qb, (size_t)M * 512, dbg, cb_ + 2, G); scan_bf16(vb, (size_t)M * 512, dbg, cb_ + 3, G); scan_bf16(sob, (size_t)M * 512, dbg, cb_ + 4, G); scan_bf16(gl, (size_t)M * 512, dbg, cb_ + 5, G); }
        if (EN(1) && IN(pb + 1)) { phase_fir(ub, pooled, G); phase_h1(lds, gl, vb, UT, dec, G); }
        SEAM(pb + 1);
        if (SC(pb + 2)) { const int cb_ = 20 * l; scan_bf16(pooled, (size_t)M * 512, dbg, cb_ + 6, G); scan_bf16(UT, (size_t)NUNIT * 16384, dbg, cb_ + 7, G); scan_f32(dec, (size_t)NUNIT * 128, dbg, cb_ + 8, G); }
        if (EN(2) && IN(pb + 2)) phase_h2(UT, dec, G);
        SEAM(pb + 2);
        if (SC(pb + 3)) { scan_bf16(UT, (size_t)NUNIT * 16384, dbg, 20 * l + 9, G); }
        if (EN(3) && IN(pb + 3)) phase_h3(lds, qb, gl, vb, sob, UT, args.in[7] + l * HD, hgb, G);
        SEAM(pb + 3);
        if (SC(pb + 4)) { scan_bf16(gates, (size_t)M * 2048, dbg, 20 * l + 11, G); }
        if (EN(4) && IN(pb + 4)) {
            pg8::Gemm g{xb, Win + (size_t)NMIX * D, M, NGATE, D}; pg8::StaticOrder S; S.init(M, NGATE, G, (int)blockIdx.x);
            EpiInMix E{ub, qb, vb, sob, gl, ssq, (const float*)(ws + WS_LB) + l * HW, gates, args.in[3] + l * NGATE, 10};
            pg8::gemm_phase<EpiInMix, pg8::StaticOrder, true, true>(lds, g, S, E);
        }
        SEAM(pb + 4);
        if (EN(5) && IN(pb + 5)) {
            { pg8::Gemm g{pooled, (const bf16*)(wl + WO_A), M, D, PW}; pg8::StaticOrder S; S.init(M, D, G, (int)blockIdx.x);
              EpiMerge<false> E{merged, gates};
              pg8::gemm_phase<EpiMerge<false>, pg8::StaticOrder, true, true>(lds, g, S, E); }
            VM_WAIT(); __syncthreads();
            { pg8::Gemm g{hgb, (const bf16*)(wl + WO_PB), M, D, HW}; pg8::StaticOrder S; S.init(M, D, G, (int)blockIdx.x);
              EpiMerge<true> E{merged, gates};
              pg8::gemm_phase<EpiMerge<true>, pg8::StaticOrder, true, true>(lds, g, S, E); }
        }
        SEAM(pb + 5);
        if (SC(pb + 6)) { scan_bf16(merged, (size_t)M * 1024, dbg, 20 * l + 12, G); }
        if (EN(6) && IN(pb + 6)) {
            pg8::Gemm g{merged, (const bf16*)(wl + WO_O), M, D, D}; pg8::StaticOrder S; S.init(M, D, G, (int)blockIdx.x);
            EpiRes<false> E{out, xb, ssq};
            pg8::gemm_phase<EpiRes<false>, pg8::StaticOrder, true, true>(lds, g, S, E);
        }
        SEAM(pb + 6);
        if (SC(pb + 7)) { scan_f32(out, (size_t)M * 1024, dbg, 20 * l + 13, G); scan_bf16(xb, (size_t)M * 1024, dbg, 20 * l + 14, G); scan_f32(ssq, (size_t)M * 16, dbg, 20 * l + 15, G); }
        if (EN(7) && IN(pb + 7)) {
            pg8::Gemm g{xb, (const bf16*)(wl + WO_UP), M, NUP, D}; pg8::StaticOrder S; S.init(M, NUP, G, (int)blockIdx.x);
            EpiUpConv E{act, hbnd, ssq, args.in[13] + (size_t)l * 3 * NUP, args.in[14] + (size_t)l * NUP};
            pg8::gemm_phase<EpiUpConv, pg8::StaticOrder, true, true, true>(lds, g, S, E);
            if (lazy && l == 0 && blockIdx.x >= 128) {
                convert_items(args, lds, I_LAYER, I_LAYER + I_IN + I_PB + I_O, (int)blockIdx.x - 128, 128);
                fold_pool(args, lds, 1, 2, (int)blockIdx.x - 128, 128);
            }
        }
        SEAM(pb + 7);
        if (SC(pb + 8)) { scan_bf16(act, (size_t)M * DFF, dbg, 20 * l + 16, G); scan_bf16(hbnd, (size_t)128 * 4 * 2 * DFF, dbg, 20 * l + 17, G); }
        if (EN(8) && IN(pb + 8)) {
            pg8::StaticOrder S; S.init(M, D, G, (int)blockIdx.x);
            pg8::Unit un;
            for (int i = 0; S.next(i, un); ++i) ffn_fixup(un.pm, hbnd, args.in[13] + (size_t)l * 3 * NUP, args.in[14] + (size_t)l * NUP, act);
            VM_WAIT(); __builtin_amdgcn_fence(__ATOMIC_ACQ_REL, "agent"); __syncthreads();
            pg8::Gemm g{act, (const bf16*)(wl + WO_DN), M, D, DFF};
            EpiRes<false> E{out, xb, ssq}; pg8::gemm_phase<EpiRes<false>, pg8::StaticOrder, true, true>(lds, g, S, E);
        }
        SEAM(pb + 8);
    }
    if (SC(N_PHASES - 1)) {
        scan_f32(out, (size_t)M * 1024, dbg, 58, G); scan_f32(ssq, (size_t)M * 16, dbg, 59, G);
        __syncthreads();
    }
    if (EN(10) && IN(N_PHASES - 1)) phase_final(xb, out, ssq, args.in[16], G);
    if (DEBUG_SCAN && IN(N_PHASES)) {
        int t_ = threadIdx.x; asm volatile("" : "+v"(t_));
        int c1 = -1, c2 = -1; for (int i = 63; i >= 0; --i) { if (dbg[i]) c1 = i; if (dbg[64 + i]) c2 = i; }
        const float cval = 100.f * (float)(c2 + 2);
        for (size_t i = (size_t)blockIdx.x * NTHREADS + t_; i < (size_t)M * D; i += (size_t)G * NTHREADS) out[i] = (i == 0) ? 1e4f * (float)(c1 + 1) : cval;
    }
    if (PROBE_A >= 0 && blockIdx.x == 0) {
        int t_ = threadIdx.x; asm volatile("" : "+v"(t_));
        if (t_ == 0) {
            STAMP(N_PHASES);
            __builtin_amdgcn_fence(__ATOMIC_ACQ_REL, "agent");
            const unsigned long long da = tsb[PROBE_A + 1] - tsb[PROBE_A], db = PROBE_B >= 0 ? tsb[PROBE_B + 1] - tsb[PROBE_B] : 0ull;
            const unsigned long long spin = 4ull * da + 204800ull * (db / 3200ull);
            const unsigned long long t0 = __builtin_amdgcn_s_memrealtime();
            while (__builtin_amdgcn_s_memrealtime() - t0 < spin) __builtin_amdgcn_s_sleep(32);
        }
    }
#undef IN
#undef SEAM
}

extern "C" void kernel_launch(void* const* d_in, const int* in_sizes, int n_in, void* d_out, int out_size, void* d_ws, size_t ws_size, hipStream_t stream) {
    static int grid = 0;
    if (grid == 0) {
        if (n_in != 17 || in_sizes[0] != M * D || out_size != M * D || ws_size < WS_END) { fprintf(stderr, "kernel_launch: unexpected shapes (n_in %d, in0 %d, out %d, ws %zu)\n", n_in, n_in > 0 ? in_sizes[0] : -1, out_size, ws_size); grid = -1; return; }
        int dev = 0, cus = 0, per_cu = 0;
        hipGetDevice(&dev); hipDeviceGetAttribute(&cus, hipDeviceAttributeMultiprocessorCount, dev);
        if (hipFuncSetAttribute((const void*)trunk_fwd, hipFuncAttributeMaxDynamicSharedMemorySize, LDS_BYTES) != hipSuccess) { fprintf(stderr, "kernel_launch: hipFuncSetAttribute failed\n"); grid = -1; return; }
        if (hipOccupancyMaxActiveBlocksPerMultiprocessor(&per_cu, (const void*)trunk_fwd, NTHREADS, LDS_BYTES) != hipSuccess || per_cu < 1) { fprintf(stderr, "kernel_launch: occupancy query says %d\n", per_cu); per_cu = 1; }
        (void)hipGetLastError();
        grid = cus * 1;
        fprintf(stderr, "kernel_launch: grid %d (cus %d, per_cu %d)\n", grid, cus, per_cu);
    }
    if (grid < 0) return;
    Args a{};
    for (int i = 0; i < 17; ++i) a.in[i] = (const float*)d_in[i];
    a.out = (float*)d_out; a.ws = (unsigned char*)d_ws;
#if ONE_LAUNCH
    if (hipMemsetAsync((char*)d_ws + WS_BAR, 0, BAR_BYTES, stream) != hipSuccess) { fprintf(stderr, "kernel_launch: memset failed\n"); return; }
    a.ph_lo = 0; a.ph_hi = N_PHASES;
    void* kargs[] = {&a};
    hipError_t e = hipLaunchCooperativeKernel((const void*)trunk_fwd, dim3(grid), dim3(NTHREADS), kargs, LDS_BYTES, stream);
    if (e != hipSuccess) fprintf(stderr, "kernel_launch: cooperative launch failed: %s (grid %d)\n", hipGetErrorString(e), grid);
#else
    for (int p = 0; p < N_PHASES + (DEBUG_SCAN ? 1 : 0); ++p) {
        if (DEBUG_SCAN && p > 0 && p < N_PHASES) { a.ph_lo = p; a.ph_hi = p - 1; hipLaunchKernelGGL(trunk_fwd, dim3(grid), dim3(NTHREADS), LDS_BYTES, stream, a); }
        a.ph_lo = p; a.ph_hi = p + 1;
        hipLaunchKernelGGL(trunk_fwd, dim3(grid), dim3(NTHREADS), LDS_BYTES, stream, a);
    }
#endif
}
```

```cpp
#include <hip/hip_runtime.h>
#include <hip/hip_cooperative_groups.h>
#include <cstdio>
#include <cstdint>
namespace cg = cooperative_groups;
namespace pg8 {
#define PG8_LAS __attribute__((address_space(3)))
typedef unsigned short bf16_t;
typedef short bf16x8 __attribute__((ext_vector_type(8)));
typedef float f32x4 __attribute__((ext_vector_type(4)));
typedef unsigned u32x4 __attribute__((ext_vector_type(4)));
constexpr int BM = 256, BK = 64, HALF = 128, HTB = HALF * BK * 2  , STAGE_BYTES = 8 * HTB, NXCD = 8, WGM = 8;

__host__ __device__ __forceinline__ int lds_byte(int r, int c) { const int st = (r >> 4) * 2 + (c >> 5), rr = r & 15, cc = c & 31, ob = rr * 64 + cc * 2; return st * 1024 + (ob ^ (((ob >> 9) & 1) << 5)); }
__host__ __device__ __forceinline__ void stage_rc(int b, int& R, int& C) { const int st = b / 1024, sb = b % 1024, swz = sb ^ (((sb >> 9) & 1) << 5); R = (st >> 1) * 16 + swz / 64; C = (st & 1) * 32 + (swz % 64) / 2; }
__host__ __device__ __forceinline__ int perm32(int rho) { const int n = rho >> 4, i = rho & 15; return 8 * (i >> 2) + 4 * n + (i & 3); }

struct Unit { int pm, pn; };
struct Gemm { const bf16_t* A; const bf16_t* Bt; int M, N, K; };

struct StaticOrder {
    int nM, nN, nwg, G, c;
    __host__ __device__ void init(int M, int N, int G_, int c_) { nM = M / BM; nN = N / BM; nwg = nM * nN; G = G_; c = c_; }
    __host__ __device__ bool next(int i, Unit& u) const {
        const long L = (long)i * G + c; if (L >= nwg) return false;
        int wgid = (int)L; { const int q = nwg / NXCD, r = nwg % NXCD, xcd = wgid % NXCD, off = wgid / NXCD; wgid = (xcd < r ? xcd * (q + 1) : r * (q + 1) + (xcd - r) * q) + off; }
        const int nig = WGM * nN, gid = wgid / nig, fm = gid * WGM, gsz = (nM - fm) < WGM ? (nM - fm) : WGM;
        u.pm = fm + ((wgid % nig) % gsz); u.pn = (wgid % nig) / gsz; return true;
    }
    __device__ __forceinline__ void a_ready(const Unit&) const {}
    __device__ __forceinline__ void done(const Unit&) const {}
};

__device__ __forceinline__ unsigned cvt_pk_bf16(float lo, float hi) { unsigned r; asm volatile("v_cvt_pk_bf16_f32 %0, %1, %2" : "=v"(r) : "v"(lo), "v"(hi)); return r; }
typedef float f32x2 __attribute__((ext_vector_type(2)));
template <class Epi, class Sched, bool ALIGN_EPI = false, bool SP2 = false, bool ROWPERM = false>
__device__ __forceinline__ void gemm_phase(PG8_LAS unsigned char* lds, const Gemm g, const Sched& S, const Epi& E) {
    int tid = threadIdx.x; asm volatile("" : "+v"(tid));
    const int wid = __builtin_amdgcn_readfirstlane(tid >> 6), lane = tid & 63, wr = wid >> 2, wc = wid & 3, fr = lane & 15, fq = lane >> 4;
    const int K = g.K, nt = K / BK;
    unsigned voffA[2], voffB[2];
#pragma unroll
    for (int i = 0; i < 2; ++i) { int R, C; stage_rc(tid * 16 + i * 8192, R, C); const int Rb = Epi::PERM ? ((R & ~31) + perm32(R & 31)) : R;
        const int Ra = ROWPERM ? (128 * (R >> 6) + 8 * (R & 15) + ((R >> 4) & 3)) : R;
        voffA[i] = (unsigned)(Ra * K + C) * 2u; voffB[i] = (unsigned)(Rb * K + C) * 2u; }
    const size_t kstep = (size_t)(BK * 2);
    const size_t hstep = (size_t)HALF * K * 2;
    const size_t hstepA = ROWPERM ? (size_t)4 * K * 2 : hstep;
    const size_t tstep = 2 * hstep;
    const unsigned ldsw = (unsigned)wid * 1024u;
    const int aoff = lds_byte(wr * 64 + fr, fq * 8), boff = lds_byte(wc * 32 + fr, fq * 8);
#define PG8_SA(b, h) (((b) * 2 + (h)) * HTB)
#define PG8_SB(b, h) ((4 + (b) * 2 + (h)) * HTB)
#define PG8_STAGE(bufoff, gbase, voff) do { _Pragma("unroll") for (int _i = 0; _i < 2; ++_i) \
        __builtin_amdgcn_global_load_lds((const unsigned*)((const char*)(gbase) + (voff)[_i]), (PG8_LAS unsigned*)(lds + (bufoff) + ldsw + _i * 8192), 16, 0, 0); } while (0)
#define PG8_LDA(dst, b, h) do { _Pragma("unroll") for (int m = 0; m < 4; ++m) _Pragma("unroll") for (int k = 0; k < 2; ++k) dst[m][k] = *(const PG8_LAS bf16x8*)(lds + PG8_SA(b, h) + aoff + m * 2048 + k * 1024); } while (0)
#define PG8_LDB(dst, b, h) do { _Pragma("unroll") for (int n = 0; n < 2; ++n) _Pragma("unroll") for (int k = 0; k < 2; ++k) dst[n][k] = *(const PG8_LAS bf16x8*)(lds + PG8_SB(b, h) + boff + n * 2048 + k * 1024); } while (0)
#define PG8_MMA(ai, bj, At, Bt) do { __builtin_amdgcn_s_setprio(1); _Pragma("unroll") for (int m = 0; m < 4; ++m) _Pragma("unroll") for (int n = 0; n < 2; ++n) _Pragma("unroll") for (int k = 0; k < 2; ++k) \
        acc[ai][bj][m][n] = __builtin_amdgcn_mfma_f32_16x16x32_bf16(Bt[n][k], At[m][k], acc[ai][bj][m][n], 0, 0, 0); __builtin_amdgcn_s_setprio(0); } while (0)
#define PG8_WAIT_V(n) asm volatile("s_waitcnt vmcnt(" #n ")" ::: "memory")
#define PG8_WAIT_L(n) asm volatile("s_waitcnt lgkmcnt(" #n ")" ::: "memory")
#define PG8_BAR __builtin_amdgcn_s_barrier()
#define PG8_SCHED __builtin_amdgcn_sched_barrier(0)
    Unit cur, nxt; int ui = 0;
    if (!S.next(0, cur)) return;
    f32x4 acc[2][2][4][2];
#pragma unroll
    for (int a = 0; a < 2; ++a)
#pragma unroll
        for (int b = 0; b < 2; ++b)
#pragma unroll
            for (int m = 0; m < 4; ++m)
#pragma unroll
                for (int n = 0; n < 2; ++n) acc[a][b][m][n] = (f32x4){0.f, 0.f, 0.f, 0.f};
    bf16x8 At[4][2], B0[2][2], B1[2][2];
    const char* cA = (const char*)g.A + (size_t)cur.pm * tstep; const char* cB = (const char*)g.Bt + (size_t)cur.pn * tstep;
    S.a_ready(cur);
    if constexpr (SP2) {
        PG8_STAGE(PG8_SB(0, 0), cB, voffB); PG8_STAGE(PG8_SB(0, 1), cB + hstep, voffB); PG8_STAGE(PG8_SA(0, 0), cA, voffA); PG8_STAGE(PG8_SA(0, 1), cA + hstepA, voffA);
        if (wr == 1) PG8_BAR;
        PG8_WAIT_V(2); PG8_BAR;
        PG8_STAGE(PG8_SB(1, 0), cB + kstep, voffB); PG8_STAGE(PG8_SA(1, 0), cA + kstep, voffA); PG8_STAGE(PG8_SB(1, 1), cB + hstep + kstep, voffB);
        PG8_WAIT_V(6); PG8_BAR;
    } else {
        PG8_STAGE(PG8_SB(0, 0), cB, voffB); PG8_STAGE(PG8_SA(0, 0), cA, voffA); PG8_STAGE(PG8_SB(0, 1), cB + hstep, voffB); PG8_STAGE(PG8_SA(0, 1), cA + hstepA, voffA);
        if (wr == 1) PG8_BAR;
        PG8_WAIT_V(4); PG8_BAR;
        PG8_STAGE(PG8_SB(1, 0), cB + kstep, voffB); PG8_STAGE(PG8_SA(1, 0), cA + kstep, voffA); PG8_STAGE(PG8_SB(1, 1), cB + hstep + kstep, voffB);
        PG8_WAIT_V(6); PG8_BAR;
    }
    for (;;) {
        const bool has_next = S.next(ui + 1, nxt);
        const char* nA = has_next ? (const char*)g.A + (size_t)nxt.pm * tstep : cA; const char* nB = has_next ? (const char*)g.Bt + (size_t)nxt.pn * tstep : cB;
        for (int t = 0; t < nt; t += 2) {
            const bool last = (t == nt - 2);
            const char* a1 = cA + (size_t)(t + 1) * kstep;
            const char* a2 = last ? nA : cA + (size_t)(t + 2) * kstep; const char* b2 = last ? nB : cB + (size_t)(t + 2) * kstep;
            const char* a3 = a2 + kstep; const char* b3 = b2 + kstep;
            if (last && has_next) S.a_ready(nxt);
            if constexpr (SP2) {
            PG8_LDB(B0, 0, 0); PG8_LDB(B1, 0, 1); PG8_SCHED; PG8_LDA(At, 0, 0); PG8_STAGE(PG8_SA(1, 1), a1 + hstepA, voffA);
            PG8_WAIT_V(8); PG8_WAIT_L(0); PG8_BAR; PG8_MMA(0, 0, At, B0); PG8_MMA(0, 1, At, B1); PG8_BAR; PG8_SCHED;
            PG8_LDA(At, 0, 1); PG8_STAGE(PG8_SB(0, 0), b2, voffB); PG8_STAGE(PG8_SB(0, 1), b2 + hstep, voffB); PG8_STAGE(PG8_SA(0, 0), a2, voffA);
            PG8_WAIT_V(8); PG8_WAIT_L(0); PG8_BAR; PG8_MMA(1, 0, At, B0); PG8_MMA(1, 1, At, B1); PG8_BAR; PG8_SCHED;
            PG8_LDB(B0, 1, 0); PG8_LDB(B1, 1, 1); PG8_SCHED; PG8_LDA(At, 1, 0); PG8_STAGE(PG8_SA(0, 1), a2 + hstepA, voffA);
            PG8_WAIT_V(8); PG8_WAIT_L(0); PG8_BAR; PG8_MMA(0, 0, At, B0); PG8_MMA(0, 1, At, B1); PG8_BAR; PG8_SCHED;
            PG8_LDA(At, 1, 1); PG8_STAGE(PG8_SB(1, 0), b3, voffB); PG8_STAGE(PG8_SB(1, 1), b3 + hstep, voffB); PG8_STAGE(PG8_SA(1, 0), a3, voffA);
            PG8_WAIT_V(8); PG8_WAIT_L(0); PG8_BAR; PG8_MMA(1, 0, At, B0); PG8_MMA(1, 1, At, B1); PG8_BAR; PG8_SCHED;
            } else {
            PG8_LDB(B0, 0, 0); PG8_SCHED; PG8_LDA(At, 0, 0); PG8_STAGE(PG8_SA(1, 1), a1 + hstepA, voffA);
            PG8_WAIT_L(8); PG8_BAR; PG8_WAIT_L(0); PG8_MMA(0, 0, At, B0); PG8_BAR; PG8_SCHED;
            PG8_LDB(B1, 0, 1); PG8_STAGE(PG8_SB(0, 0), b2, voffB);
            PG8_BAR; PG8_WAIT_L(0); PG8_MMA(0, 1, At, B1); PG8_BAR;
            PG8_LDA(At, 0, 1); PG8_STAGE(PG8_SA(0, 0), a2, voffA);
            PG8_BAR; PG8_WAIT_L(0); PG8_MMA(1, 0, At, B0); PG8_BAR; PG8_SCHED;
            PG8_STAGE(PG8_SB(0, 1), b2 + hstep, voffB);
            PG8_WAIT_V(6); PG8_BAR; PG8_MMA(1, 1, At, B1); PG8_BAR;
            PG8_LDB(B0, 1, 0); PG8_SCHED; PG8_LDA(At, 1, 0); PG8_STAGE(PG8_SA(0, 1), a2 + hstepA, voffA);
            PG8_WAIT_L(8); PG8_BAR; PG8_WAIT_L(0); PG8_MMA(0, 0, At, B0); PG8_BAR; PG8_SCHED;
            PG8_LDB(B1, 1, 1); PG8_STAGE(PG8_SB(1, 0), b3, voffB);
            PG8_BAR; PG8_WAIT_L(0); PG8_MMA(0, 1, At, B1); PG8_BAR;
            PG8_LDA(At, 1, 1); PG8_STAGE(PG8_SA(1, 0), a3, voffA);
            PG8_BAR; PG8_WAIT_L(0); PG8_MMA(1, 0, At, B0); PG8_BAR; PG8_SCHED;
            PG8_STAGE(PG8_SB(1, 1), b3 + hstep, voffB);
            PG8_WAIT_V(6); PG8_BAR; PG8_MMA(1, 1, At, B1); PG8_BAR;
            }
        }
        if constexpr (ALIGN_EPI) { if (wr == 0) PG8_BAR; }
        if constexpr (!Epi::AFTER_DRAIN) { E(acc, cur, wr, wc, fr, fq); S.done(cur); }
        if (!has_next) break;
#pragma unroll
        for (int a = 0; a < 2; ++a)
#pragma unroll
            for (int b = 0; b < 2; ++b)
#pragma unroll
                for (int m = 0; m < 4; ++m)
#pragma unroll
                    for (int n = 0; n < 2; ++n) acc[a][b][m][n] = (f32x4){0.f, 0.f, 0.f, 0.f};
        cur = nxt; cA = nA; cB = nB; ++ui;
        if constexpr (ALIGN_EPI) { if (wr == 1) PG8_BAR; }
    }
    PG8_WAIT_V(0);
    if constexpr (!ALIGN_EPI) { if (wr == 0) PG8_BAR; }
    PG8_BAR;
    if constexpr (Epi::AFTER_DRAIN) { E.fused(acc, cur, wr, wc, fr, fq, lds, wid, lane); S.done(cur); }
#undef PG8_SA
#undef PG8_SB
#undef PG8_STAGE
#undef PG8_LDA
#undef PG8_LDB
#undef PG8_MMA
#undef PG8_WAIT_V
#undef PG8_WAIT_L
#undef PG8_BAR
#undef PG8_SCHED
}
}

constexpr int BATCH = 2, SEQ = 8192, D = 1024, M = BATCH * SEQ, DEPTH = 2;
constexpr int PW = 512, HW = 512, NH = 4, HD = 128, CH = 64, NCH = SEQ / CH, NBH = BATCH * NH, NUNIT = NBH * NCH;
constexpr int IN_COLS = 4608, NMIX = 2560, NGATE = 2048, DFF = 2816, NUP = 2 * DFF;
constexpr float EPS = 1e-6f;
constexpr int NWAVES = 8, NTHREADS = 512;
constexpr int LDS_BYTES = 147456;

constexpr size_t MiB = 1u << 20;
constexpr size_t WS_BAR = 512 * 1024, BAR_BYTES = 16384;
constexpr size_t WS_SSQ = 1 * MiB;
constexpr size_t WS_DEC = 2 * MiB;
constexpr size_t WS_LB = 2 * MiB + 768 * 1024;
constexpr size_t WS_HBND = 3 * MiB;
constexpr size_t WS_W = 9 * MiB, W_LAYER = 29 * MiB + 512 * 1024;
constexpr size_t WO_IN = 0, WO_A = 9 * MiB, WO_PB = 10 * MiB, WO_O = 11 * MiB, WO_UP = 13 * MiB, WO_DN = 24 * MiB;
constexpr size_t WS_XB = 68 * MiB;
constexpr size_t WS_R = 100 * MiB;
constexpr size_t WS_U = WS_R, WS_HG = WS_R, WS_Q = WS_R + 16 * MiB, WS_V = WS_R + 32 * MiB, WS_SO = WS_R + 48 * MiB, WS_G = WS_R + 64 * MiB;
constexpr size_t WS_POOL = WS_R + 96 * MiB, WS_UT = WS_R + 112 * MiB, WS_GATES = WS_R + 16 * MiB, WS_MERGED = WS_R + 112 * MiB, WS_ACT = WS_R;
constexpr size_t WS_XF = WS_R + 88 * MiB;
constexpr size_t WS_END = 256 * MiB;
static_assert(WS_UT + 32 * MiB <= WS_END && WS_ACT + (size_t)M * DFF * 2 <= WS_END && WS_GATES + 64 * MiB <= WS_POOL, "ws map");

#define LAS __attribute__((address_space(3)))
typedef unsigned short bf16;
typedef unsigned u32x4 __attribute__((ext_vector_type(4)));
typedef unsigned u32x2 __attribute__((ext_vector_type(2)));
typedef float f32x4 __attribute__((ext_vector_type(4)));
typedef float f32x2 __attribute__((ext_vector_type(2)));
typedef short bf16x8 __attribute__((ext_vector_type(8)));

__device__ __forceinline__ float bflo(unsigned w) { return __uint_as_float(w << 16); }
__device__ __forceinline__ float bfhi(unsigned w) { return __uint_as_float(w & 0xffff0000u); }
typedef __bf16 bf16x2_t __attribute__((ext_vector_type(2)));
__device__ __forceinline__ unsigned pk(float lo, float hi) { const bf16x2_t v = __builtin_convertvector((f32x2){lo, hi}, bf16x2_t); return __builtin_bit_cast(unsigned, v); }
__device__ __forceinline__ float sigm(float x) { return 1.f / (1.f + __expf(-x)); }
__device__ __forceinline__ float silu(float x) { return x * sigm(x); }
__device__ __forceinline__ float wave_sum(float v) {
#pragma unroll
    for (int o = 1; o < 64; o <<= 1) v += __shfl_xor(v, o);
    return v;
}
__device__ __forceinline__ float dpp_shr1(float x) { return __int_as_float(__builtin_amdgcn_update_dpp(0, __float_as_int(x), 0x111, 0xf, 0xf, true)); }
#define LDS_WAIT() asm volatile("s_waitcnt lgkmcnt(0)" ::: "memory")
#define VM_WAIT() asm volatile("s_waitcnt vmcnt(0)" ::: "memory")

__device__ __forceinline__ float load_rs(const float* ssq, int row0, int lane) {
    const f32x4* p = (const f32x4*)(ssq + (size_t)(row0 + lane) * 16);
    const f32x4 a = p[0], b = p[1], c = p[2], d = p[3];
    const f32x4 s = (a + b) + (c + d);
    return rsqrtf(((s[0] + s[1]) + (s[2] + s[3])) * (1.f / D) + EPS);
}

struct EpiInMix {
    static constexpr bool PERM = true, AFTER_DRAIN = false;
    bf16 *u, *q, *v, *so; bf16* g; const float* ssq; const float* lb; bf16* gates; const float* bgate; int pn_off;
    __device__ __forceinline__ void operator()(const f32x4 (&acc)[2][2][4][2], const pg8::Unit& un0, int wr, int wc, int fr, int fq) const {
        const int lane = fr + 16 * fq;
        pg8::Unit un = un0; un.pn += pn_off;
        float rs[2]; rs[0] = load_rs(ssq, un.pm * 256 + wr * 64, lane); rs[1] = load_rs(ssq, un.pm * 256 + 128 + wr * 64, lane);
        const int sec = un.pn >> 1, colt = (un.pn & 1) * 256 + wc * 32 + 8 * fq, row0 = un.pm * 256 + wr * 64 + fr;
        if (un.pn >= 10) {
            const int col0 = (un.pn - 10) * 256 + wc * 32 + 8 * fq;
            f32x4 bv[2][2];
#pragma unroll
            for (int bj = 0; bj < 2; ++bj)
#pragma unroll
                for (int n = 0; n < 2; ++n) bv[bj][n] = *(const f32x4*)(bgate + col0 + bj * 128 + 4 * n);
#pragma unroll
            for (int ai = 0; ai < 2; ++ai)
#pragma unroll
                for (int m = 0; m < 4; ++m) {
                    const float r = __shfl(rs[ai], 16 * m + fr);
                    bf16* rowp = gates + (size_t)(row0 + ai * 128 + m * 16) * NGATE + col0;
#pragma unroll
                    for (int bj = 0; bj < 2; ++bj) {
                        f32x4 v0 = acc[ai][bj][m][0] * r + bv[bj][0], v1 = acc[ai][bj][m][1] * r + bv[bj][1];
#pragma unroll
                        for (int e = 0; e < 4; ++e) { v0[e] = sigm(v0[e]); v1[e] = sigm(v1[e]); }
                        u32x4 w; w.x = pk(v0[0], v0[1]); w.y = pk(v0[2], v0[3]); w.z = pk(v1[0], v1[1]); w.w = pk(v1[2], v1[3]);
                        *(u32x4*)(rowp + bj * 128) = w;
                    }
                }
        } else if (sec == 2) {
            f32x4 lbv[2][2];
#pragma unroll
            for (int bj = 0; bj < 2; ++bj)
#pragma unroll
                for (int n = 0; n < 2; ++n) lbv[bj][n] = *(const f32x4*)(lb + colt + bj * 128 + 4 * n);
#pragma unroll
            for (int ai = 0; ai < 2; ++ai)
#pragma unroll
                for (int m = 0; m < 4; ++m) {
                    const float r = __shfl(rs[ai], 16 * m + fr);
                    bf16* rowp = g + (size_t)(row0 + ai * 128 + m * 16) * 512 + colt;
#pragma unroll
                    for (int bj = 0; bj < 2; ++bj) {
                        float o[8];
#pragma unroll
                        for (int n = 0; n < 2; ++n) { const f32x4 z = acc[ai][bj][m][n] * r;
#pragma unroll
                            for (int e = 0; e < 4; ++e) { const float l = lbv[bj][n][e]; o[4 * n + e] = __logf(l + (1.f - l) * sigm(z[e])); } }
                        u32x4 w; w.x = pk(o[0], o[1]); w.y = pk(o[2], o[3]); w.z = pk(o[4], o[5]); w.w = pk(o[6], o[7]);
                        *(u32x4*)(rowp + bj * 128) = w;
                    }
                }
        } else {
            bf16* base = sec == 0 ? u : (sec == 1 ? q : (sec == 3 ? v : so));
            const bool act = (sec == 1 || sec == 4);
#pragma unroll
            for (int ai = 0; ai < 2; ++ai)
#pragma unroll
                for (int m = 0; m < 4; ++m) {
                    const float r = __shfl(rs[ai], 16 * m + fr);
                    bf16* rowp = base + (size_t)(row0 + ai * 128 + m * 16) * 512 + colt;
#pragma unroll
                    for (int bj = 0; bj < 2; ++bj) {
                        f32x4 v0 = acc[ai][bj][m][0] * r, v1 = acc[ai][bj][m][1] * r;
                        if (act) {
#pragma unroll
                            for (int e = 0; e < 4; ++e) { v0[e] = silu(v0[e]); v1[e] = silu(v1[e]); }
                        }
                        u32x4 w; w.x = pk(v0[0], v0[1]); w.y = pk(v0[2], v0[3]); w.z = pk(v1[0], v1[1]); w.w = pk(v1[2], v1[3]);
                        *(u32x4*)(rowp + bj * 128) = w;
                    }
                }
        }
    }
};


template <bool SECOND> struct EpiMerge {
    static constexpr bool PERM = true, AFTER_DRAIN = false;
    bf16* merged; const bf16* gates;
    __device__ __forceinline__ void operator()(const f32x4 (&acc)[2][2][4][2], const pg8::Unit& un, int wr, int wc, int fr, int fq) const {
        const int col0 = un.pn * 256 + wc * 32 + 8 * fq, row0 = un.pm * 256 + wr * 64 + fr;
#pragma unroll
        for (int ai = 0; ai < 2; ++ai)
#pragma unroll
            for (int m = 0; m < 4; ++m) {
                const size_t row = (size_t)(row0 + ai * 128 + m * 16);
#pragma unroll
                for (int bj = 0; bj < 2; ++bj) {
                    const u32x4 gw = *(const u32x4*)(gates + row * NGATE + (SECOND ? 1024 : 0) + col0 + bj * 128);
                    const f32x4 a0 = acc[ai][bj][m][0], a1 = acc[ai][bj][m][1];
                    float o[8];
                    o[0] = bflo(gw.x) * a0[0]; o[1] = bfhi(gw.x) * a0[1]; o[2] = bflo(gw.y) * a0[2]; o[3] = bfhi(gw.y) * a0[3];
                    o[4] = bflo(gw.z) * a1[0]; o[5] = bfhi(gw.z) * a1[1]; o[6] = bflo(gw.w) * a1[2]; o[7] = bfhi(gw.w) * a1[3];
                    bf16* mp = merged + row * D + col0 + bj * 128;
                    if (SECOND) {
                        const u32x4 ow = *(const u32x4*)mp;
                        o[0] += bflo(ow.x); o[1] += bfhi(ow.x); o[2] += bflo(ow.y); o[3] += bfhi(ow.y);
                        o[4] += bflo(ow.z); o[5] += bfhi(ow.z); o[6] += bflo(ow.w); o[7] += bfhi(ow.w);
                    }
                    u32x4 w; w.x = pk(o[0], o[1]); w.y = pk(o[2], o[3]); w.z = pk(o[4], o[5]); w.w = pk(o[6], o[7]);
                    *(u32x4*)mp = w;
                }
            }
    }
};

template <bool LAST> struct EpiRes {
    static constexpr bool PERM = true, AFTER_DRAIN = false;
    float* out; bf16* xb; float* ssq;
    __device__ __forceinline__ void operator()(const f32x4 (&acc)[2][2][4][2], const pg8::Unit& un, int wr, int wc, int fr, int fq) const {
        const int col0 = un.pn * 256 + wc * 32 + 8 * fq, row0 = un.pm * 256 + wr * 64 + fr;
#pragma unroll
        for (int ai = 0; ai < 2; ++ai)
#pragma unroll
            for (int m = 0; m < 4; ++m) {
                const size_t row = (size_t)(row0 + ai * 128 + m * 16);
                float s = 0.f;
#pragma unroll
                for (int bj = 0; bj < 2; ++bj) {
                    const size_t p = row * D + col0 + bj * 128;
                    const u32x4 bw = *(const u32x4*)(xb + p);
                    const f32x4 x0 = (f32x4){bflo(bw.x), bfhi(bw.x), bflo(bw.y), bfhi(bw.y)} + acc[ai][bj][m][0], x1 = (f32x4){bflo(bw.z), bfhi(bw.z), bflo(bw.w), bfhi(bw.w)} + acc[ai][bj][m][1];
                    s += (x0[0] * x0[0] + x0[1] * x0[1]) + (x0[2] * x0[2] + x0[3] * x0[3]) + (x1[0] * x1[0] + x1[1] * x1[1]) + (x1[2] * x1[2] + x1[3] * x1[3]);
                    if (LAST) { *(f32x4*)(out + p) = x0; *(f32x4*)(out + p + 4) = x1; }
                    else { u32x4 w; w.x = pk(x0[0], x0[1]); w.y = pk(x0[2], x0[3]); w.z = pk(x1[0], x1[1]); w.w = pk(x1[2], x1[3]); *(u32x4*)(xb + p) = w; }
                }
                s += __shfl_xor(s, 16); s += __shfl_xor(s, 32);
                if (fq == 0) ssq[row * 16 + un.pn * 4 + wc] = s;
            }
    }
};

struct EpiUpConv {
    static constexpr bool PERM = false, AFTER_DRAIN = false;
    bf16* act; bf16* hbnd; const float* ssq; const float* cw; const float* cb;
    __device__ __forceinline__ void operator()(f32x4 (&acc)[2][2][4][2], const pg8::Unit& un, int wr, int wc, int fr, int fq) const {
        const int lane = fr + 16 * fq;
        {
            const float rs0 = load_rs(ssq, un.pm * 256 + 128 * wr, lane), rs1 = load_rs(ssq, un.pm * 256 + 128 * wr + 64, lane);
#pragma unroll
            for (int j = 0; j < 8; ++j) { const int src = (8 * fr + j) & 63; const float a = __shfl(rs0, src), b = __shfl(rs1, src); const float r = fr < 8 ? a : b;
#pragma unroll
                for (int bj = 0; bj < 2; ++bj)
#pragma unroll
                    for (int n = 0; n < 2; ++n) acc[j >> 2][bj][j & 3][n] *= r; }
        }
        const size_t tok0 = (size_t)un.pm * 256 + 128 * wr + 8 * fr;
        const int blk = un.pm * 2 + wr;
#pragma unroll
        for (int n = 0; n < 2; ++n) {
            const int ch0 = un.pn * 128 + wc * 32 + 16 * n + 4 * fq;
            if (fr == 15) {
                bf16* hb = hbnd + ((size_t)(blk * 4 + 2) * 2) * DFF + ch0;
                const f32x4 hv6 = acc[1][0][2][n], hv7 = acc[1][0][3][n], hg6 = acc[1][1][2][n], hg7 = acc[1][1][3][n];
                *(u32x2*)(hb) = (u32x2){pk(hv6[0], hv6[1]), pk(hv6[2], hv6[3])}; *(u32x2*)(hb + DFF) = (u32x2){pk(hg6[0], hg6[1]), pk(hg6[2], hg6[3])};
                *(u32x2*)(hb + 2 * DFF) = (u32x2){pk(hv7[0], hv7[1]), pk(hv7[2], hv7[3])}; *(u32x2*)(hb + 3 * DFF) = (u32x2){pk(hg7[0], hg7[1]), pk(hg7[2], hg7[3])};
            }
            if (fr == 0) {
#pragma unroll
                for (int j = 0; j < 2; ++j) { bf16* hb = hbnd + ((size_t)(blk * 4 + j) * 2) * DFF + ch0; const f32x4 hv = acc[0][0][j][n], hg = acc[0][1][j][n];
                    *(u32x2*)(hb) = (u32x2){pk(hv[0], hv[1]), pk(hv[2], hv[3])}; *(u32x2*)(hb + DFF) = (u32x2){pk(hg[0], hg[1]), pk(hg[2], hg[3])}; }
            }
#pragma unroll
            for (int bj = 0; bj < 2; ++bj) {
                const float* cwp = cw + bj * DFF + ch0;
                const f32x4 w0 = *(const f32x4*)(cwp), w1 = *(const f32x4*)(cwp + NUP), w2 = *(const f32x4*)(cwp + 2 * NUP), bb = *(const f32x4*)(cb + bj * DFF + ch0);
                f32x4 m2, m1;
#pragma unroll
                for (int e = 0; e < 4; ++e) { m2[e] = dpp_shr1(acc[1][bj][2][n][e]); m1[e] = dpp_shr1(acc[1][bj][3][n][e]); }
#pragma unroll
                for (int j = 7; j >= 0; --j) {
                    const f32x4 h0 = acc[j >> 2][bj][j & 3][n];
                    const f32x4 hm1 = j >= 1 ? acc[(j - 1 + 8) % 8 >> 2][bj][(j - 1 + 8) % 8 & 3][n] : m1;
                    const f32x4 hm2 = j >= 2 ? acc[(j - 2 + 8) % 8 >> 2][bj][(j - 2 + 8) % 8 & 3][n] : (j == 1 ? m1 : m2);
                    acc[j >> 2][bj][j & 3][n] = w2 * h0 + w1 * hm1 + w0 * hm2 + bb;
                }
            }
#pragma unroll
            for (int j = 0; j < 8; ++j) {
                const f32x4 vc = acc[j >> 2][0][j & 3][n], gc = acc[j >> 2][1][j & 3][n];
                f32x4 a;
#pragma unroll
                for (int e = 0; e < 4; ++e) a[e] = vc[e] * silu(gc[e]);
                if (!(j < 2 && fr == 0)) *(u32x2*)(act + (tok0 + j) * DFF + ch0) = (u32x2){pk(a[0], a[1]), pk(a[2], a[3])};
            }
        }
    }
};

struct Args { const float* in[17]; float* out; unsigned char* ws; int ph_lo, ph_hi; };

struct TrItem { const float* W; const float* rscale; bf16* WT; int K, N, drow0, k0, n0; };
__device__ __forceinline__ void tr_load(const TrItem& t, int lane, float (&wv)[32]) {
#pragma unroll
    for (int i = 0; i < 32; ++i) { const int kk = 2 * i + (lane >> 5); wv[i] = t.W[(size_t)(t.k0 + kk) * t.N + t.n0 + (lane & 31)]; }
    if (t.rscale) {
#pragma unroll
        for (int i = 0; i < 32; ++i) wv[i] *= t.rscale[t.k0 + 2 * i + (lane >> 5)];
    }
}
__device__ __forceinline__ void tr_store(const TrItem& t, int lane, const float (&wv)[32], LAS float* scr) {
#pragma unroll
    for (int i = 0; i < 32; ++i) scr[(2 * i + (lane >> 5)) * 33 + (lane & 31)] = wv[i];
    LDS_WAIT(); asm volatile("" ::: "memory");
    const int c = lane & 7;
#pragma unroll
    for (int j = 0; j < 4; ++j) { const int n = (lane >> 3) + 8 * j; const LAS float* sp = scr + (8 * c) * 33 + n;
        u32x4 o; o.x = pk(sp[0 * 33], sp[1 * 33]); o.y = pk(sp[2 * 33], sp[3 * 33]); o.z = pk(sp[4 * 33], sp[5 * 33]); o.w = pk(sp[6 * 33], sp[7 * 33]);
        *(u32x4*)(t.WT + (size_t)(t.drow0 + n) * t.K + t.k0 + 8 * c) = o; }
    LDS_WAIT(); asm volatile("" ::: "memory");
}
constexpr int I_IN = (D / 64) * (IN_COLS / 32), I_PB = (HW / 64) * (D / 32), I_O = (D / 64) * (D / 32), I_UP = (D / 64) * (NUP / 32), I_DN = (DFF / 64) * (D / 32);
constexpr int I_LAYER = I_IN + I_PB + I_O + I_UP + I_DN;
__device__ __forceinline__ TrItem tr_decode(const Args& a, int it) {
    const int l = it / I_LAYER; int r = it % I_LAYER;
    unsigned char* wl = a.ws + WS_W + (size_t)l * W_LAYER;
    TrItem t;
    if (r < I_IN) { const int nb = IN_COLS / 32; t.k0 = 64 * (r / nb); t.n0 = 32 * (r % nb); t.W = a.in[2] + (size_t)l * D * IN_COLS; t.K = D; t.N = IN_COLS; t.rscale = a.in[1] + l * D; t.WT = (bf16*)(wl + WO_IN); t.drow0 = t.n0; return t; }
    r -= I_IN;
    if (r < I_PB) { const int nb = D / 32; t.k0 = 64 * (r / nb); t.n0 = 32 * (r % nb); t.W = a.in[9] + (size_t)l * HW * D; t.K = HW; t.N = D; t.rscale = nullptr; t.WT = (bf16*)(wl + WO_PB); t.drow0 = t.n0; return t; }
    r -= I_PB;
    if (r < I_O) { const int nb = D / 32; t.k0 = 64 * (r / nb); t.n0 = 32 * (r % nb); t.W = a.in[10] + (size_t)l * D * D; t.K = D; t.N = D; t.rscale = nullptr; t.WT = (bf16*)(wl + WO_O); t.drow0 = t.n0; return t; }
    r -= I_O;
    if (r < I_UP) { const int nb = NUP / 32; t.k0 = 64 * (r / nb); t.n0 = 32 * (r % nb); t.W = a.in[12] + (size_t)l * D * NUP; t.K = D; t.N = NUP; t.rscale = a.in[11] + l * D; t.WT = (bf16*)(wl + WO_UP);
        const int bjs = t.n0 / DFF, rr = t.n0 % DFF; t.drow0 = 256 * (rr / 128) + 128 * bjs + (rr % 128); return t; }
    r -= I_UP;
    { const int nb = D / 32; t.k0 = 64 * (r / nb); t.n0 = 32 * (r % nb); t.W = a.in[15] + (size_t)l * DFF * D; t.K = DFF; t.N = D; t.rscale = nullptr; t.WT = (bf16*)(wl + WO_DN); t.drow0 = t.n0; return t; }
}

__device__ __forceinline__ void convert_items(const Args& a, LAS unsigned char* lds, int it0, int it1, int r, int nr) {
    int tid = threadIdx.x; asm volatile("" : "+v"(tid));
    const int lane = tid & 63, wave = __builtin_amdgcn_readfirstlane(tid >> 6);
    LAS float* scr = (LAS float*)(lds + wave * 16384);
    const int gw = r * NWAVES + wave, NGW = nr * NWAVES;
    for (int it = it0 + gw; it < it1; it += 2 * NGW) {
        const bool two = it + NGW < it1;
        const TrItem t0 = tr_decode(a, it), t1 = tr_decode(a, two ? it + NGW : it);
        float w0[32], w1[32];
        tr_load(t0, lane, w0); if (two) tr_load(t1, lane, w1);
        tr_store(t0, lane, w0, scr); if (two) tr_store(t1, lane, w1, scr);
    }
}
__device__ __forceinline__ void fold_pool(const Args& a, LAS unsigned char* lds, int l0, int l1, int r, int nr) {
    int tid = threadIdx.x; asm volatile("" : "+v"(tid));
    const int lane = tid & 63, wave = __builtin_amdgcn_readfirstlane(tid >> 6);
    unsigned char* ws = a.ws;
    const float *pool_w = a.in[4], *pool_scale = a.in[5], *w_pa = a.in[8];
    LAS float* scr = (LAS float*)(lds + wave * 16384);
    for (int gt = l0 * 65536 + r * NTHREADS + tid; gt < l1 * 65536; gt += nr * NTHREADS) {
        const int l = __builtin_amdgcn_readfirstlane(gt >> 16), rem = gt & 65535, d = rem & 1023, cg8 = __builtin_amdgcn_readfirstlane(rem >> 10), gi = cg8 >> 4, c0 = (cg8 & 15) * 8;
        const float* pw = pool_w + ((size_t)(l * 4 + gi) * 128 + c0) * 128;
        const float* ps = pool_scale + l * PW + gi * 128;
        const float* wp = w_pa + ((size_t)l * PW + gi * 128) * D + d;
        LAS float* pwl = scr;
#pragma unroll
        for (int j = 0; j < 4; ++j) { const int e = j * 256 + lane * 4; const f32x4 v = *(const f32x4*)(pw + e) * *(const f32x4*)(ps + (e & 127)); *(LAS f32x4*)(pwl + e) = v; }
        LDS_WAIT(); asm volatile("" ::: "memory");
        float sacc[8];
#pragma unroll
        for (int i = 0; i < 8; ++i) sacc[i] = 0.f;
#pragma unroll 4
        for (int cp = 0; cp < 128; cp += 4) {
            const float w0 = wp[(size_t)cp * D], w1 = wp[(size_t)(cp + 1) * D], w2 = wp[(size_t)(cp + 2) * D], w3 = wp[(size_t)(cp + 3) * D];
#pragma unroll
            for (int i = 0; i < 8; ++i) { const f32x4 p = *(const LAS f32x4*)(pwl + i * 128 + cp); sacc[i] += (p[0] * w0 + p[1] * w1) + (p[2] * w2 + p[3] * w3); }
        }
        u32x4 o; o.x = pk(sacc[0], sacc[1]); o.y = pk(sacc[2], sacc[3]); o.z = pk(sacc[4], sacc[5]); o.w = pk(sacc[6], sacc[7]);
        *(u32x4*)((bf16*)(ws + WS_W + (size_t)l * W_LAYER + WO_A) + (size_t)d * PW + cg8 * 8) = o;
        LDS_WAIT(); asm volatile("" ::: "memory");
    }
}

__device__ __forceinline__ void phase_prologue(const Args& a, LAS unsigned char* lds, int G, bool lazy) {
    int tid = threadIdx.x; asm volatile("" : "+v"(tid));
    const int lane = tid & 63, wave = __builtin_amdgcn_readfirstlane(tid >> 6);
    unsigned char* ws = a.ws;
    const float *x = a.in[0], *lb_logits = a.in[6];
    const int gw = blockIdx.x * NWAVES + wave, NGW = G * NWAVES;
    convert_items(a, lds, 0, lazy ? I_IN : DEPTH * I_LAYER, (int)blockIdx.x, G);
    if (!lazy) fold_pool(a, lds, 0, DEPTH, (int)blockIdx.x, G);
    if (blockIdx.x == 0) {
        const int chn = tid;
        float mx = -1e30f;
        for (int l = 0; l < DEPTH; ++l) mx = fmaxf(mx, lb_logits[l * HW + chn]);
        float sum = 0.f;
        for (int l = 0; l < DEPTH; ++l) sum += expf(lb_logits[l * HW + chn] - mx);
        float cum = 0.f, c0v = 0.f;
        for (int l = 0; l < DEPTH; ++l) { cum += expf(lb_logits[l * HW + chn] - mx) / sum; if (l == 0) c0v = cum; ((float*)(ws + WS_LB))[l * HW + chn] = cum - c0v; }
    }
    bf16* xb = (bf16*)(ws + WS_XB); float* ssq = (float*)(ws + WS_SSQ);
    for (int m = gw; m < M; m += 4 * NGW) {
        f32x4 v[4][4]; bool ok[4];
#pragma unroll
        for (int q = 0; q < 4; ++q) { const int mq = m + q * NGW; ok[q] = mq < M; const f32x4* xr = (const f32x4*)(x + (size_t)(ok[q] ? mq : m) * D) + lane;
#pragma unroll
            for (int j = 0; j < 4; ++j) v[q][j] = xr[64 * j]; }
#pragma unroll
        for (int q = 0; q < 4; ++q) {
            const int mq = m + q * NGW;
            float sq = 0.f;
#pragma unroll
            for (int j = 0; j < 4; ++j) sq += (v[q][j][0] * v[q][j][0] + v[q][j][1] * v[q][j][1]) + (v[q][j][2] * v[q][j][2] + v[q][j][3] * v[q][j][3]);
            sq = wave_sum(sq);
            if (ok[q]) {
                u32x2* o8 = (u32x2*)(xb + (size_t)mq * D) + lane;
#pragma unroll
                for (int j = 0; j < 4; ++j) o8[64 * j] = (u32x2){pk(v[q][j][0], v[q][j][1]), pk(v[q][j][2], v[q][j][3])};
                if (lane < 16) ssq[(size_t)mq * 16 + lane] = lane == 0 ? sq : 0.f;
            }
        }
    }
}

__device__ __forceinline__ void phase_fir(const bf16* u, bf16* pooled, int G) {
    int tid = threadIdx.x; asm volatile("" : "+v"(tid));
    for (int item = blockIdx.x * NTHREADS + tid; item < (M / 8) * 64; item += G * NTHREADS) {
        const int cgp = item & 63, run = item >> 6, m0 = run * 8, ts = m0 & (SEQ - 1), w = 2 << (cgp >> 4);
        const bf16* up = u + (size_t)m0 * PW + cgp * 8;
        float s[8];
#pragma unroll
        for (int i = 0; i < 8; ++i) s[i] = 0.f;
        for (int d = 1; d < w; ++d) if (ts - d >= 0) {
            const u32x4 x = *(const u32x4*)(up - (size_t)d * PW);
            s[0] += bflo(x.x); s[1] += bfhi(x.x); s[2] += bflo(x.y); s[3] += bfhi(x.y); s[4] += bflo(x.z); s[5] += bfhi(x.z); s[6] += bflo(x.w); s[7] += bfhi(x.w);
        }
#pragma unroll
        for (int r = 0; r < 8; ++r) {
            const u32x4 x = *(const u32x4*)(up + (size_t)r * PW);
            float c[8] = {bflo(x.x), bfhi(x.x), bflo(x.y), bfhi(x.y), bflo(x.z), bfhi(x.z), bflo(x.w), bfhi(x.w)};
#pragma unroll
            for (int i = 0; i < 8; ++i) s[i] += c[i];
            const int cnt = (ts + r + 1) < w ? (ts + r + 1) : w; const float inv = 1.f / (float)cnt;
            u32x4 o; o.x = pk(s[0] * inv - c[0], s[1] * inv - c[1]); o.y = pk(s[2] * inv - c[2], s[3] * inv - c[3]);
            o.z = pk(s[4] * inv - c[4], s[5] * inv - c[5]); o.w = pk(s[6] * inv - c[6], s[7] * inv - c[7]);
            *(u32x4*)(pooled + (size_t)(m0 + r) * PW + cgp * 8) = o;
            if (ts + r - w + 1 >= 0) {
                const u32x4 y = *(const u32x4*)(up + ((ptrdiff_t)r - w + 1) * PW);
                s[0] -= bflo(y.x); s[1] -= bfhi(y.x); s[2] -= bflo(y.y); s[3] -= bfhi(y.y); s[4] -= bflo(y.z); s[5] -= bfhi(y.z); s[6] -= bflo(y.w); s[7] -= bfhi(y.w);
            }
        }
    }
}

__device__ __forceinline__ u32x4 pack_lo8(const unsigned (&v)[8]) { u32x4 o; o.x = (v[0] & 0xffffu) | (v[1] << 16); o.y = (v[2] & 0xffffu) | (v[3] << 16); o.z = (v[4] & 0xffffu) | (v[5] << 16); o.w = (v[6] & 0xffffu) | (v[7] << 16); return o; }
__device__ __forceinline__ u32x4 pack_hi8(const unsigned (&v)[8]) { u32x4 o; o.x = (v[0] >> 16) | (v[1] & 0xffff0000u); o.y = (v[2] >> 16) | (v[3] & 0xffff0000u); o.z = (v[4] >> 16) | (v[5] & 0xffff0000u); o.w = (v[6] >> 16) | (v[7] & 0xffff0000u); return o; }

#define WG_BAR() do { asm volatile("s_waitcnt lgkmcnt(0)" ::: "memory"); __builtin_amdgcn_s_barrier(); asm volatile("" ::: "memory"); } while (0)
__device__ __forceinline__ void phase_h1(LAS unsigned char* lds, const bf16* g, const bf16* vb, bf16* UT, float* dec, int G) {
    int tid = threadIdx.x; asm volatile("" : "+v"(tid));
    const int lane = tid & 63, w = __builtin_amdgcn_readfirstlane(tid >> 6), r16 = lane & 15, q4 = lane >> 4;
    LAS unsigned char* KT = lds; LAS unsigned char* VT = lds + 18432; LAS float* SEG = (LAS float*)(lds + 36864);
    f32x2 gg[8]; unsigned vv[8];
    int unit = blockIdx.x;
    if (unit < NUNIT) {
        const int bh = unit >> 7, c = unit & 127, b = bh >> 2, h = bh & 3;
        const size_t m0 = (size_t)b * SEQ + c * CH + 8 * w; const int col = h * HD + 2 * lane;
#pragma unroll
        for (int r = 0; r < 8; ++r) { { const unsigned gw_ = *(const unsigned*)(g + (m0 + r) * HW + col); gg[r] = (f32x2){bflo(gw_), bfhi(gw_)}; } vv[r] = *(const unsigned*)(vb + (m0 + r) * HW + col); }
    }
    for (; unit < NUNIT; unit += G) {
        f32x2 cs[8]; cs[0] = gg[0];
#pragma unroll
        for (int r = 1; r < 8; ++r) cs[r] = cs[r - 1] + gg[r];
        *(LAS f32x2*)(SEG + w * 128 + 2 * lane) = cs[7];
        *(LAS u32x4*)(VT + (2 * lane) * 144 + w * 16) = pack_lo8(vv); *(LAS u32x4*)(VT + (2 * lane + 1) * 144 + w * 16) = pack_hi8(vv);
        WG_BAR();
        f32x2 pre = {0.f, 0.f}, tot = {0.f, 0.f};
#pragma unroll
        for (int j = 0; j < 8; ++j) { const f32x2 sg = *(const LAS f32x2*)(SEG + j * 128 + 2 * lane); tot += sg; if (j < w) pre += sg; }
        unsigned kt[8];
#pragma unroll
        for (int r = 0; r < 8; ++r) { const f32x2 bb = pre + cs[r];
            kt[r] = pk((1.f - __expf(gg[r].x)) * __expf(tot.x - bb.x), (1.f - __expf(gg[r].y)) * __expf(tot.y - bb.y)); }
        *(LAS u32x4*)(KT + (2 * lane) * 144 + w * 16) = pack_lo8(kt); *(LAS u32x4*)(KT + (2 * lane + 1) * 144 + w * 16) = pack_hi8(kt);
        if (w == 0) *(f32x2*)(dec + (size_t)unit * HD + 2 * lane) = (f32x2){__expf(tot.x), __expf(tot.y)};
        const int nu = unit + G;
        if (nu < NUNIT) {
            const int bh = nu >> 7, c = nu & 127, b = bh >> 2, h = bh & 3;
            const size_t m0 = (size_t)b * SEQ + c * CH + 8 * w; const int col = h * HD + 2 * lane;
#pragma unroll
            for (int r = 0; r < 8; ++r) { { const unsigned gw_ = *(const unsigned*)(g + (m0 + r) * HW + col); gg[r] = (f32x2){bflo(gw_), bfhi(gw_)}; } vv[r] = *(const unsigned*)(vb + (m0 + r) * HW + col); }
        }
        WG_BAR();
        bf16x8 yv[2];
#pragma unroll
        for (int ks = 0; ks < 2; ++ks) yv[ks] = *(const LAS bf16x8*)(VT + (16 * w + r16) * 144 + ks * 64 + q4 * 16);
        bf16* ut = UT + (size_t)unit * (HD * HD) + (size_t)(16 * w + r16) * HD + 4 * q4;
#pragma unroll
        for (int nb = 0; nb < 8; ++nb) {
            f32x4 a = {0.f, 0.f, 0.f, 0.f};
#pragma unroll
            for (int ks = 0; ks < 2; ++ks) { const bf16x8 xk = *(const LAS bf16x8*)(KT + (16 * nb + r16) * 144 + ks * 64 + q4 * 16); a = __builtin_amdgcn_mfma_f32_16x16x32_bf16(xk, yv[ks], a, 0, 0, 0); }
            *(u32x2*)(ut + 16 * nb) = (u32x2){pk(a[0], a[1]), pk(a[2], a[3])};
        }
        WG_BAR();
    }
}

__device__ __forceinline__ void phase_h2(bf16* UT, const float* dec, int G) {
    int tid = threadIdx.x; asm volatile("" : "+v"(tid));
    for (int e = blockIdx.x * NTHREADS + tid; e < NBH * HD * HD; e += G * NTHREADS) {
        const int bh = e >> 14, idx = e & 16383, k = idx & 127;
        bf16* up = UT + (size_t)bh * NCH * (HD * HD) + idx; const float* dp = dec + (size_t)bh * NCH * HD + k;
        float S = 0.f;
        for (int c0 = 0; c0 < NCH; c0 += 16) {
            bf16 uu[16]; float dd[16];
#pragma unroll
            for (int i = 0; i < 16; ++i) { uu[i] = up[(size_t)(c0 + i) * (HD * HD)]; dd[i] = dp[(size_t)(c0 + i) * HD]; }
#pragma unroll
            for (int i = 0; i < 16; ++i) { up[(size_t)(c0 + i) * (HD * HD)] = (bf16)(pk(S, 0.f) & 0xffffu); S = dd[i] * S + __uint_as_float((unsigned)uu[i] << 16); }
        }
    }
}

__device__ __forceinline__ void phase_h3(LAS unsigned char* lds, const bf16* qb, const bf16* g, const bf16* vb, const bf16* sob, const bf16* ST, const float* ng, bf16* hg, int G) {
    constexpr int SR = 272;
    int tid = threadIdx.x; asm volatile("" : "+v"(tid));
    const int lane = tid & 63, w = __builtin_amdgcn_readfirstlane(tid >> 6), r16 = lane & 15, q4 = lane >> 4;
    LAS unsigned char* QH = lds; LAS unsigned char* QD = lds + 17408; LAS unsigned char* KD = lds + 34816; LAS unsigned char* KE = lds + 52224; LAS unsigned char* QO = lds + 69632;
    LAS unsigned char* VT = lds + 95744; LAS float* SEG = (LAS float*)(lds + 114176); LAS float* RMS = (LAS float*)(lds + 118272);
    const int bi = w >> 1, odd = w & 1;
    f32x2 gg[8]; unsigned qq[8], vv[8];
    int unit = blockIdx.x;
    if (unit < NUNIT) {
        const int bh = unit >> 7, c = unit & 127, b = bh >> 2, h = bh & 3;
        const size_t m0 = (size_t)b * SEQ + c * CH + 8 * w; const int col = h * HD + 2 * lane;
#pragma unroll
        for (int r = 0; r < 8; ++r) { { const unsigned gw_ = *(const unsigned*)(g + (m0 + r) * HW + col); gg[r] = (f32x2){bflo(gw_), bfhi(gw_)}; } qq[r] = *(const unsigned*)(qb + (m0 + r) * HW + col); vv[r] = *(const unsigned*)(vb + (m0 + r) * HW + col); }
    }
    for (; unit < NUNIT; unit += G) {
        const int bh = unit >> 7, c = unit & 127, b = bh >> 2, h = bh & 3;
        const size_t mu = (size_t)b * SEQ + c * CH;
        const bf16* STu = ST + (size_t)unit * (HD * HD) + (size_t)(64 * odd + r16) * HD + q4 * 8;
        bf16x8 xs[4][4];
#pragma unroll
        for (int ks = 0; ks < 4; ++ks)
#pragma unroll
            for (int nb = 0; nb < 4; ++nb) xs[ks][nb] = *(const bf16x8*)(STu + (size_t)(16 * nb) * HD + ks * 32);
        const size_t row = mu + 16 * bi + r16;
        u32x2 sv[4]; f32x4 ngv[4];
#pragma unroll
        for (int nb = 0; nb < 4; ++nb) { const int v0 = 64 * odd + 16 * nb + 4 * q4; ngv[nb] = *(const f32x4*)(ng + v0); sv[nb] = *(const u32x2*)(sob + row * HW + h * HD + v0); }
        f32x2 cs[8]; cs[0] = gg[0];
#pragma unroll
        for (int r = 1; r < 8; ++r) cs[r] = cs[r - 1] + gg[r];
        *(LAS f32x2*)(SEG + w * 128 + 2 * lane) = cs[7];
        *(LAS u32x4*)(VT + (2 * lane) * 144 + w * 16) = pack_lo8(vv); *(LAS u32x4*)(VT + (2 * lane + 1) * 144 + w * 16) = pack_hi8(vv);
        WG_BAR();
        f32x2 pre = {0.f, 0.f};
        for (int j = 0; j < w; ++j) pre += *(const LAS f32x2*)(SEG + j * 128 + 2 * lane);
        const f32x2 cmid = *(const LAS f32x2*)(SEG + (2 * bi) * 128 + 2 * lane);
        const f32x2 bsum = cmid + *(const LAS f32x2*)(SEG + (2 * bi + 1) * 128 + 2 * lane);
        f32x2 bsm1 = {0.f, 0.f}, bsm2 = {0.f, 0.f};
        if (bi >= 1) bsm1 = *(const LAS f32x2*)(SEG + (2 * bi - 2) * 128 + 2 * lane) + *(const LAS f32x2*)(SEG + (2 * bi - 1) * 128 + 2 * lane);
        if (bi >= 2) bsm2 = bsm1 + *(const LAS f32x2*)(SEG + (2 * bi - 4) * 128 + 2 * lane) + *(const LAS f32x2*)(SEG + (2 * bi - 3) * 128 + 2 * lane);
        const f32x2 cbase = odd ? cmid : (f32x2){0.f, 0.f};
        const int pbase = (bi * (bi - 1)) / 2;
#pragma unroll
        for (int r = 0; r < 8; ++r) {
            const int t = 8 * w + r, tl = 8 * odd + r;
            const f32x2 cl = cbase + cs[r], bf = pre + cs[r];
            const float qx = bflo(qq[r]), qy = bfhi(qq[r]);
            const float kx = 1.f - __expf(gg[r].x), ky = 1.f - __expf(gg[r].y);
            *(LAS unsigned*)(QH + t * SR + 4 * lane) = pk(qx * __expf(bf.x), qy * __expf(bf.y));
            *(LAS unsigned*)(QD + t * SR + 4 * lane) = pk(qx * __expf(fminf(cl.x - cmid.x, 80.f)), qy * __expf(fminf(cl.y - cmid.y, 80.f)));
            *(LAS unsigned*)(KD + t * SR + 4 * lane) = pk(kx * __expf(fminf(cmid.x - cl.x, 80.f)), ky * __expf(fminf(cmid.y - cl.y, 80.f)));
            if (bi < 3) *(LAS unsigned*)(KE + t * SR + 4 * lane) = pk(kx * __expf(bsum.x - cl.x), ky * __expf(bsum.y - cl.y));
            if (bi >= 1) *(LAS unsigned*)(QO + ((pbase + bi - 1) * 16 + tl) * SR + 4 * lane) = pk(qx * __expf(cl.x), qy * __expf(cl.y));
            if (bi >= 2) *(LAS unsigned*)(QO + ((pbase + bi - 2) * 16 + tl) * SR + 4 * lane) = pk(qx * __expf(cl.x + bsm1.x), qy * __expf(cl.y + bsm1.y));
            if (bi >= 3) *(LAS unsigned*)(QO + ((pbase + 0) * 16 + tl) * SR + 4 * lane) = pk(qx * __expf(cl.x + bsm2.x), qy * __expf(cl.y + bsm2.y));
        }
        WG_BAR();
        { const int nu = unit + G;
          if (nu < NUNIT) {
            const int bh2 = nu >> 7, c2 = nu & 127, b2 = bh2 >> 2, h2 = bh2 & 3;
            const size_t m0 = (size_t)b2 * SEQ + c2 * CH + 8 * w; const int col = h2 * HD + 2 * lane;
#pragma unroll
            for (int r = 0; r < 8; ++r) { { const unsigned gw_ = *(const unsigned*)(g + (m0 + r) * HW + col); gg[r] = (f32x2){bflo(gw_), bfhi(gw_)}; } qq[r] = *(const unsigned*)(qb + (m0 + r) * HW + col); vv[r] = *(const unsigned*)(vb + (m0 + r) * HW + col); }
          } }
        const int i = bi, vh = odd;
        f32x4 acc[4];
#pragma unroll
        for (int nb = 0; nb < 4; ++nb) acc[nb] = (f32x4){0.f, 0.f, 0.f, 0.f};
#pragma unroll
        for (int ks = 0; ks < 4; ++ks) {
            const bf16x8 y = *(const LAS bf16x8*)(QH + (16 * i + r16) * SR + ks * 64 + q4 * 16);
#pragma unroll
            for (int nb = 0; nb < 4; ++nb) acc[nb] = __builtin_amdgcn_mfma_f32_16x16x32_bf16(xs[ks][nb], y, acc[nb], 0, 0, 0);
        }
#pragma unroll
        for (int jp = 0; jp < 2; ++jp) {
            if (2 * jp <= i) {
                f32x4 p[2];
#pragma unroll
                for (int jj = 0; jj < 2; ++jj) {
                    const int j = 2 * jp + jj;
                    p[jj] = (f32x4){0.f, 0.f, 0.f, 0.f};
                    if (j <= i) {
                        const LAS unsigned char* Kb = (j == i ? KD : KE) + (16 * j + r16) * SR + q4 * 16;
                        const LAS unsigned char* Qb = (j == i ? QD + (16 * i + r16) * SR : QO + ((pbase + j) * 16 + r16) * SR) + q4 * 16;
#pragma unroll
                        for (int ks = 0; ks < 4; ++ks) { const bf16x8 xk = *(const LAS bf16x8*)(Kb + ks * 64); const bf16x8 yq = *(const LAS bf16x8*)(Qb + ks * 64); p[jj] = __builtin_amdgcn_mfma_f32_16x16x32_bf16(xk, yq, p[jj], 0, 0, 0); }
                        if (j == i) {
#pragma unroll
                            for (int e = 0; e < 4; ++e) if (4 * q4 + e > r16) p[jj][e] = 0.f;
                        }
                    }
                }
                u32x4 ypw; ypw.x = pk(p[0][0], p[0][1]); ypw.y = pk(p[0][2], p[0][3]); ypw.z = pk(p[1][0], p[1][1]); ypw.w = pk(p[1][2], p[1][3]);
                const bf16x8 yp = __builtin_bit_cast(bf16x8, ypw);
#pragma unroll
                for (int nb = 0; nb < 4; ++nb) {
                    const LAS unsigned char* vp = VT + (64 * vh + 16 * nb + r16) * 144 + (32 * jp + 4 * q4) * 2;
                    const u32x2 lo = *(const LAS u32x2*)vp, hi = *(const LAS u32x2*)(vp + 32);
                    const u32x4 xw = {lo.x, lo.y, hi.x, hi.y};
                    acc[nb] = __builtin_amdgcn_mfma_f32_16x16x32_bf16(__builtin_bit_cast(bf16x8, xw), yp, acc[nb], 0, 0, 0);
                }
            }
        }
        float ss = 0.f;
#pragma unroll
        for (int nb = 0; nb < 4; ++nb) ss += (acc[nb][0] * acc[nb][0] + acc[nb][1] * acc[nb][1]) + (acc[nb][2] * acc[nb][2] + acc[nb][3] * acc[nb][3]);
        ss += __shfl_xor(ss, 16); ss += __shfl_xor(ss, 32);
        if (q4 == 0) RMS[(16 * i + r16) * 2 + vh] = ss;
        WG_BAR();
        const float rstd = rsqrtf((RMS[(16 * i + r16) * 2] + RMS[(16 * i + r16) * 2 + 1]) * (1.f / HD) + EPS);
#pragma unroll
        for (int nb = 0; nb < 4; ++nb) {
            const int v0 = 64 * vh + 16 * nb + 4 * q4;
            const f32x4 o = acc[nb] * rstd * ngv[nb];
            *(u32x2*)(hg + row * HW + h * HD + v0) = (u32x2){pk(o[0] * bflo(sv[nb].x), o[1] * bfhi(sv[nb].x)), pk(o[2] * bflo(sv[nb].y), o[3] * bfhi(sv[nb].y))};
        }
        WG_BAR();
    }
}

__device__ __forceinline__ f32x4 bf4(u32x2 v) { return (f32x4){bflo(v.x), bfhi(v.x), bflo(v.y), bfhi(v.y)}; }
__device__ __forceinline__ void ffn_fixup(int pm, const bf16* hbnd, const float* cw, const float* cb, bf16* act) {
    int tid = threadIdx.x; asm volatile("" : "+v"(tid));
    for (int idx = tid; idx < DFF / 4; idx += NTHREADS) {
        const int c4 = idx * 4;
        const f32x4 wv0 = *(const f32x4*)(cw + c4), wv1 = *(const f32x4*)(cw + NUP + c4), wv2 = *(const f32x4*)(cw + 2 * NUP + c4), bv = *(const f32x4*)(cb + c4);
        const f32x4 wg0 = *(const f32x4*)(cw + DFF + c4), wg1 = *(const f32x4*)(cw + NUP + DFF + c4), wg2 = *(const f32x4*)(cw + 2 * NUP + DFF + c4), bg = *(const f32x4*)(cb + DFF + c4);
        u32x2 hv[2][4], hg[2][4];
#pragma unroll
        for (int bb = 0; bb < 2; ++bb) {
            const int blk = 2 * pm + bb; const bool first = (blk & 63) == 0;
#pragma unroll
            for (int k = 0; k < 4; ++k) {
                const int sb = k < 2 ? blk - 1 : blk, slot = k < 2 ? k + 2 : k - 2;
                const bf16* p = hbnd + ((size_t)(sb * 4 + slot) * 2) * DFF + c4;
                if (k < 2 && first) { hv[bb][k] = (u32x2){0u, 0u}; hg[bb][k] = (u32x2){0u, 0u}; }
                else { hv[bb][k] = *(const u32x2*)p; hg[bb][k] = *(const u32x2*)(p + DFF); }
            }
        }
#pragma unroll
        for (int bb = 0; bb < 2; ++bb)
#pragma unroll
            for (int dl = 0; dl < 2; ++dl) {
                const f32x4 vc = wv2 * bf4(hv[bb][2 + dl]) + wv1 * bf4(hv[bb][1 + dl]) + wv0 * bf4(hv[bb][dl]) + bv;
                const f32x4 gc = wg2 * bf4(hg[bb][2 + dl]) + wg1 * bf4(hg[bb][1 + dl]) + wg0 * bf4(hg[bb][dl]) + bg;
                f32x4 a;
#pragma unroll
                for (int e = 0; e < 4; ++e) a[e] = vc[e] * silu(gc[e]);
                *(u32x2*)(act + ((size_t)(2 * pm + bb) * 128 + dl) * DFF + c4) = (u32x2){pk(a[0], a[1]), pk(a[2], a[3])};
            }
    }
}

__device__ __forceinline__ void phase_final(const bf16* xb, float* out, const float* ssq, const float* fg, int G) {
    int tid = threadIdx.x; asm volatile("" : "+v"(tid));
    const int lane = tid & 63, wave = tid >> 6;
    for (int m = blockIdx.x * NWAVES + wave; m < M; m += G * NWAVES) {
        const f32x4* sp = (const f32x4*)(ssq + (size_t)m * 16);
        const f32x4 s = (sp[0] + sp[1]) + (sp[2] + sp[3]);
        const float rstd = rsqrtf(((s[0] + s[1]) + (s[2] + s[3])) * (1.f / D) + EPS);
        const u32x4* xr = (const u32x4*)(xb + (size_t)m * D) + lane; f32x4* orow = (f32x4*)(out + (size_t)m * D) + 2 * lane; const f32x4* gr = (const f32x4*)fg + 2 * lane;
#pragma unroll
        for (int j = 0; j < 2; ++j) { const u32x4 w = xr[64 * j];
            orow[128 * j] = (f32x4){bflo(w.x), bfhi(w.x), bflo(w.y), bfhi(w.y)} * rstd * gr[128 * j];
            orow[128 * j + 1] = (f32x4){bflo(w.z), bfhi(w.z), bflo(w.w), bfhi(w.w)} * rstd * gr[128 * j + 1]; }
    }
}


#ifndef DEBUG_SCAN
#define DEBUG_SCAN 0
#endif
__device__ __forceinline__ void scan_bf16(const bf16* p, size_t n, int* flags, int code, int G) {
    int tid = threadIdx.x; asm volatile("" : "+v"(tid));
    const u32x4* q = (const u32x4*)p; const size_t n16 = n / 8; bool bad = false, huge = false;
    for (size_t i = (size_t)blockIdx.x * NTHREADS + tid; i < n16; i += (size_t)G * NTHREADS) { const u32x4 w = q[i];
#pragma unroll
        for (int e = 0; e < 4; ++e) { const unsigned x = w[e]; if ((x & 0x7f80u) == 0x7f80u || (x & 0x7f800000u) == 0x7f800000u) bad = true; if (fabsf(bflo(x)) > 1e4f || fabsf(bfhi(x)) > 1e4f) huge = true; } }
    if (bad) flags[code] = 1; if (huge) flags[64 + code] = 1;
}
__device__ __forceinline__ void scan_f32(const float* p, size_t n, int* flags, int code, int G) {
    int tid = threadIdx.x; asm volatile("" : "+v"(tid));
    bool bad = false, huge = false;
    for (size_t i = (size_t)blockIdx.x * NTHREADS + tid; i < n; i += (size_t)G * NTHREADS) { const unsigned x = __float_as_uint(p[i]); if ((x & 0x7f800000u) == 0x7f800000u) bad = true; if (fabsf(p[i]) > 1e4f) huge = true; }
    if (bad) flags[code] = 1; if (huge) flags[64 + code] = 1;
}
#define XB_TMO      128
#define XB_XCNT(j)  (256  + 64 * (j))
#define XB_XSUB(j)  (1280 + 64 * (j))
#define XB_XGEN(j)  (2304 + 64 * (j))
#define XB_TOP      3328
#define XB_TOPGEN   3392
#define XCD_BAR_WORDS 3456
#define XB_SPIN_CAP (1u << 18)

__device__ __forceinline__ unsigned xb_ld(unsigned* p)              { return __hip_atomic_load(p, __ATOMIC_RELAXED, __HIP_MEMORY_SCOPE_AGENT); }
__device__ __forceinline__ unsigned xb_add(unsigned* p, unsigned v) { return __hip_atomic_fetch_add(p, v, __ATOMIC_RELAXED, __HIP_MEMORY_SCOPE_AGENT); }
__device__ __forceinline__ unsigned xb_xcc_id() { return (unsigned)__builtin_amdgcn_s_getreg((3 << 11) | 20) & 0xFu; }
#define XB_SPIN(cond, bar) do { unsigned _sp = 0; while (cond) { __builtin_amdgcn_s_sleep(1); \
    if ((++_sp & 255u) == 0u) { if (xb_ld(&(bar)[XB_TMO])) break; if (_sp > XB_SPIN_CAP) { atomicAdd(&(bar)[XB_TMO], 1u); break; } } } } while (0)

struct XcdBarrier {
    unsigned* bar; unsigned x;
    volatile LAS unsigned* st;
};

__device__ __forceinline__ XcdBarrier xcd_barrier_post(unsigned* bar, volatile LAS unsigned* st) {
    XcdBarrier b; b.bar = bar; b.x = xb_xcc_id(); b.st = st;
    if (threadIdx.x == 0) (void)xb_add(&bar[XB_XCNT(b.x)], 1u);
    return b;
}
__device__ __forceinline__ void xcd_barrier_complete(unsigned* bar, unsigned x, unsigned& nloc, unsigned& nx) {
    const unsigned G = gridDim.x * gridDim.y * gridDim.z;
    unsigned sum, cnt, mine, sp = 0u;
    for (;;) {
        sum = 0u; cnt = 0u; mine = 0u;
#pragma unroll
        for (unsigned j = 0; j < 16; ++j) { const unsigned c = xb_ld(&bar[XB_XCNT(j)]); sum += c; cnt += (c > 0u) ? 1u : 0u; mine = (j == x) ? c : mine; }
        if (sum == G) break;
        __builtin_amdgcn_s_sleep(1);
        if ((++sp & 255u) == 0u) { if (xb_ld(&bar[XB_TMO])) break; if (sp > XB_SPIN_CAP) { atomicAdd(&bar[XB_TMO], 1u); break; } }
    }
    nloc = mine > 0u ? mine : 1u; nx = cnt > 0u ? cnt : 1u;
}

__device__ __forceinline__ void xcd_barrier(const XcdBarrier& b) {
    asm volatile("s_waitcnt vmcnt(0)" ::: "memory");
    __syncthreads();
    if (threadIdx.x == 0) {
        unsigned* bar = b.bar;
        __builtin_amdgcn_s_waitcnt(0);
        unsigned nloc = b.st[0], nx = b.st[1];
        if (nloc == 0u) { xcd_barrier_complete(bar, b.x, nloc, nx); b.st[0] = nloc; b.st[1] = nx; }
        const unsigned old = xb_add(&bar[XB_XSUB(b.x)], 1u);
        const unsigned gen = old / nloc;
        if (old + 1u == (gen + 1u) * nloc) {
            __builtin_amdgcn_fence(__ATOMIC_RELEASE, "agent");
            asm volatile("s_waitcnt vmcnt(0)" ::: "memory");
            const unsigned og = xb_add(&bar[XB_TOP], 1u);
            const unsigned tg = og / nx;
            if (og + 1u == (tg + 1u) * nx) xb_add(&bar[XB_TOPGEN], 1u);
            else XB_SPIN(xb_ld(&bar[XB_TOPGEN]) == tg, bar);
            __builtin_amdgcn_fence(__ATOMIC_ACQUIRE, "agent");
            xb_add(&bar[XB_XGEN(b.x)], 1u);
            asm volatile("s_waitcnt vmcnt(0)" ::: "memory");
        } else {
            XB_SPIN(xb_ld(&bar[XB_XGEN(b.x)]) == gen, bar);
            __builtin_amdgcn_fence(__ATOMIC_ACQUIRE, "agent");
            asm volatile("s_waitcnt vmcnt(0)" ::: "memory");
        }
    }
    __syncthreads();
}

#ifndef ONE_LAUNCH
#define ONE_LAUNCH 1
#endif
constexpr int PH_PER_LAYER = 9, N_PHASES = 1 + DEPTH * PH_PER_LAYER + 1;

__global__ void __launch_bounds__(NTHREADS, 2) trunk_fwd(Args args) {
    extern __shared__ __attribute__((aligned(16))) unsigned char lds_raw[];
    LAS unsigned char* lds = (LAS unsigned char*)lds_raw;
    cg::grid_group grid = cg::this_grid();
    const int G = gridDim.x;
    unsigned char* ws = args.ws;
    float* out = args.out;
    const int lo = args.ph_lo, hi = args.ph_hi;
    float* ssq = (float*)(ws + WS_SSQ); float* dec = (float*)(ws + WS_DEC); bf16* hbnd = (bf16*)(ws + WS_HBND); bf16* xb = (bf16*)(ws + WS_XB);
    bf16 *ub = (bf16*)(ws + WS_U), *hgb = (bf16*)(ws + WS_HG), *qb = (bf16*)(ws + WS_Q), *vb = (bf16*)(ws + WS_V), *sob = (bf16*)(ws + WS_SO), *pooled = (bf16*)(ws + WS_POOL);
    bf16 *UT = (bf16*)(ws + WS_UT), *gates = (bf16*)(ws + WS_GATES), *merged = (bf16*)(ws + WS_MERGED), *act = (bf16*)(ws + WS_ACT);
    bf16* gl = (bf16*)(ws + WS_G);
#ifndef PHASE_MASK
#define PHASE_MASK 0xfff
#endif
#define EN(j) (((PHASE_MASK) >> (j)) & 1)
#define IN(k) (lo <= (k) && (k) < hi)
#define SC(k) (DEBUG_SCAN && lo == (k) && hi == (k) - 1)
    volatile LAS unsigned* MISC = (volatile LAS unsigned*)(lds + 131072 + 512);
    { int t_ = threadIdx.x; asm volatile("" : "+v"(t_)); if (t_ < 32) MISC[t_] = 0u; }
    __syncthreads();
    XcdBarrier bar = xcd_barrier_post((unsigned*)(ws + WS_BAR), MISC + 8);
#ifndef PROBE_A
#define PROBE_A -1
#define PROBE_B -1
#endif
    unsigned long long* tsb = (unsigned long long*)(ws + 4096);
#define STAMP(k) do { if (PROBE_A >= 0 && blockIdx.x == 0) { int t_ = threadIdx.x; asm volatile("" : "+v"(t_)); if (t_ == 0) tsb[(k)] = __builtin_amdgcn_s_memrealtime(); } } while (0)
#define SEAM(k) do { if (IN(k) && IN((k) + 1)) { if ((k) == 0) grid.sync(); else xcd_barrier(bar); } STAMP((k) + 1); } while (0)
    STAMP(0);

    int* dbg = (int*)ws;
    static_assert(DEPTH == 2, "the lazy weight-copy schedule below is written for two layers");
    const bool lazy = (G == 256) && lo == 0 && hi == N_PHASES;
    if (EN(9) && IN(0)) { if (DEBUG_SCAN && blockIdx.x == 0) { int t_ = threadIdx.x; asm volatile("" : "+v"(t_)); if (t_ < 128) dbg[t_] = 0; } phase_prologue(args, lds, G, lazy); }
    SEAM(0);
    for (int l = 0; l < DEPTH; ++l) {
        const int pb = 1 + l * PH_PER_LAYER;
        unsigned char* wl = ws + WS_W + (size_t)l * W_LAYER;
        const bf16* Win = (const bf16*)(wl + WO_IN);
        if (EN(0) && IN(pb + 0)) {
            pg8::Gemm g{xb, Win, M, NMIX, D}; pg8::StaticOrder S; S.init(M, NMIX, G, (int)blockIdx.x);
            EpiInMix E{ub, qb, vb, sob, gl, ssq, (const float*)(ws + WS_LB) + l * HW, gates, args.in[3] + l * NGATE, 0};
            pg8::gemm_phase<EpiInMix, pg8::StaticOrder, true, true>(lds, g, S, E);
            if (lazy && l == 0 && blockIdx.x >= 128) {
                convert_items(args, lds, I_IN, I_LAYER, (int)blockIdx.x - 128, 128);
                fold_pool(args, lds, 0, 1, (int)blockIdx.x - 128, 128);
            }
            if (lazy && l == 1 && blockIdx.x >= 128)
                convert_items(args, lds, I_LAYER + I_IN + I_PB + I_O, 2 * I_LAYER, (int)blockIdx.x - 128, 128);
        }
        SEAM(pb + 0);
        if (SC(pb + 1)) { const int cb_ = 20 * l; scan_bf16(ub, (size_t)M * 512, dbg, cb_ + 1, G); scan_bf16(qb, (size_t)M * 512, dbg, cb_ + 2, G); scan_bf16(vb, (size_t)M * 512, dbg, cb_ + 3, G); scan_bf16(sob, (size_t)M * 512, dbg, cb_ + 4, G); scan_bf16(gl, (size_t)M * 512, dbg, cb_ + 5, G); }
        if (EN(1) && IN(pb + 1)) { phase_fir(ub, pooled, G); phase_h1(lds, gl, vb, UT, dec, G); }
        SEAM(pb + 1);
        if (SC(pb + 2)) { const int cb_ = 20 * l; scan_bf16(pooled, (size_t)M * 512, dbg, cb_ + 6, G); scan_bf16(UT, (size_t)NUNIT * 16384, dbg, cb_ + 7, G); scan_f32(dec, (size_t)NUNIT * 128, dbg, cb_ + 8, G); }
        if (EN(2) && IN(pb + 2)) phase_h2(UT, dec, G);
        SEAM(pb + 2);
        if (SC(pb + 3)) { scan_bf16(UT, (size_t)NUNIT * 16384, dbg, 20 * l + 9, G); }
        if (EN(3) && IN(pb + 3)) phase_h3(lds, qb, gl, vb, sob, UT, args.in[7] + l * HD, hgb, G);
        SEAM(pb + 3);
        if (SC(pb + 4)) { scan_bf16(gates, (size_t)M * 2048, dbg, 20 * l + 11, G); }
        if (EN(4) && IN(pb + 4)) {
            pg8::Gemm g{xb, Win + (size_t)NMIX * D, M, NGATE, D}; pg8::StaticOrder S; S.init(M, NGATE, G, (int)blockIdx.x);
            EpiInMix E{ub, qb, vb, sob, gl, ssq, (const float*)(ws + WS_LB) + l * HW, gates, args.in[3] + l * NGATE, 10};
            pg8::gemm_phase<EpiInMix, pg8::StaticOrder, true, true>(lds, g, S, E);
        }
        SEAM(pb + 4);
        if (EN(5) && IN(pb + 5)) {
            { pg8::Gemm g{pooled, (const bf16*)(wl + WO_A), M, D, PW}; pg8::StaticOrder S; S.init(M, D, G, (int)blockIdx.x);
              EpiMerge<false> E{merged, gates};
              pg8::gemm_phase<EpiMerge<false>, pg8::StaticOrder, true, true>(lds, g, S, E); }
            VM_WAIT(); __syncthreads();
            { pg8::Gemm g{hgb, (const bf16*)(wl + WO_PB), M, D, HW}; pg8::StaticOrder S; S.init(M, D, G, (int)blockIdx.x);
              EpiMerge<true> E{merged, gates};
              pg8::gemm_phase<EpiMerge<true>, pg8::StaticOrder, true, true>(lds, g, S, E); }
        }
        SEAM(pb + 5);
        if (SC(pb + 6)) { scan_bf16(merged, (size_t)M * 1024, dbg, 20 * l + 12, G); }
        if (EN(6) && IN(pb + 6)) {
            pg8::Gemm g{merged, (const bf16*)(wl + WO_O), M, D, D}; pg8::StaticOrder S; S.init(M, D, G, (int)blockIdx.x);
            EpiRes<false> E{out, xb, ssq};
            pg8::gemm_phase<EpiRes<false>, pg8::StaticOrder, true, true>(lds, g, S, E);
        }
        SEAM(pb + 6);
        if (SC(pb + 7)) { scan_f32(out, (size_t)M * 1024, dbg, 20 * l + 13, G); scan_bf16(xb, (size_t)M * 1024, dbg, 20 * l + 14, G); scan_f32(ssq, (size_t)M * 16, dbg, 20 * l + 15, G); }
        if (EN(7) && IN(pb + 7)) {
            pg8::Gemm g{xb, (const bf16*)(wl + WO_UP), M, NUP, D}; pg8::StaticOrder S; S.init(M, NUP, G, (int)blockIdx.x);
            EpiUpConv E{act, hbnd, ssq, args.in[13] + (size_t)l * 3 * NUP, args.in[14] + (size_t)l * NUP};
            pg8::gemm_phase<EpiUpConv, pg8::StaticOrder, true, true, true>(lds, g, S, E);
            if (lazy && l == 0 && blockIdx.x >= 128) {
                convert_items(args, lds, I_LAYER, I_LAYER + I_IN + I_PB + I_O, (int)blockIdx.x - 128, 128);
                fold_pool(args, lds, 1, 2, (int)blockIdx.x - 128, 128);
            }
        }
        SEAM(pb + 7);
        if (SC(pb + 8)) { scan_bf16(act, (size_t)M * DFF, dbg, 20 * l + 16, G); scan_bf16(hbnd, (size_t)128 * 4 * 2 * DFF, dbg, 20 * l + 17, G); }
        if (EN(8) && IN(pb + 8)) {
            pg8::StaticOrder S; S.init(M, D, G, (int)blockIdx.x);
            pg8::Unit un;
            for (int i = 0; S.next(i, un); ++i) ffn_fixup(un.pm, hbnd, args.in[13] + (size_t)l * 3 * NUP, args.in[14] + (size_t)l * NUP, act);
            VM_WAIT(); __syncthreads();
            pg8::Gemm g{act, (const bf16*)(wl + WO_DN), M, D, DFF};
            EpiRes<false> E{out, xb, ssq}; pg8::gemm_phase<EpiRes<false>, pg8::StaticOrder, true, true>(lds, g, S, E);
        }
        SEAM(pb + 8);
    }
    if (SC(N_PHASES - 1)) {
        scan_f32(out, (size_t)M * 1024, dbg, 58, G); scan_f32(ssq, (size_t)M * 16, dbg, 59, G);
        __syncthreads();
    }
    if (EN(10) && IN(N_PHASES - 1)) phase_final(xb, out, ssq, args.in[16], G);
    if (DEBUG_SCAN && IN(N_PHASES)) {
        int t_ = threadIdx.x; asm volatile("" : "+v"(t_));
        int c1 = -1, c2 = -1; for (int i = 63; i >= 0; --i) { if (dbg[i]) c1 = i; if (dbg[64 + i]) c2 = i; }
        const float cval = 100.f * (float)(c2 + 2);
        for (size_t i = (size_t)blockIdx.x * NTHREADS + t_; i < (size_t)M * D; i += (size_t)G * NTHREADS) out[i] = (i == 0) ? 1e4f * (float)(c1 + 1) : cval;
    }
    if (PROBE_A >= 0 && blockIdx.x == 0) {
        int t_ = threadIdx.x; asm volatile("" : "+v"(t_));
        if (t_ == 0) {
            STAMP(N_PHASES);
            __builtin_amdgcn_fence(__ATOMIC_ACQ_REL, "agent");
            const unsigned long long da = tsb[PROBE_A + 1] - tsb[PROBE_A], db = PROBE_B >= 0 ? tsb[PROBE_B + 1] - tsb[PROBE_B] : 0ull;
            const unsigned long long spin = 4ull * da + 204800ull * (db / 3200ull);
            const unsigned long long t0 = __builtin_amdgcn_s_memrealtime();
            while (__builtin_amdgcn_s_memrealtime() - t0 < spin) __builtin_amdgcn_s_sleep(32);
        }
    }
#undef IN
#undef SEAM
}

extern "C" void kernel_launch(void* const* d_in, const int* in_sizes, int n_in, void* d_out, int out_size, void* d_ws, size_t ws_size, hipStream_t stream) {
    static int grid = 0;
    if (grid == 0) {
        if (n_in != 17 || in_sizes[0] != M * D || out_size != M * D || ws_size < WS_END) { fprintf(stderr, "kernel_launch: unexpected shapes (n_in %d, in0 %d, out %d, ws %zu)\n", n_in, n_in > 0 ? in_sizes[0] : -1, out_size, ws_size); grid = -1; return; }
        int dev = 0, cus = 0, per_cu = 0;
        hipGetDevice(&dev); hipDeviceGetAttribute(&cus, hipDeviceAttributeMultiprocessorCount, dev);
        if (hipFuncSetAttribute((const void*)trunk_fwd, hipFuncAttributeMaxDynamicSharedMemorySize, LDS_BYTES) != hipSuccess) { fprintf(stderr, "kernel_launch: hipFuncSetAttribute failed\n"); grid = -1; return; }
        if (hipOccupancyMaxActiveBlocksPerMultiprocessor(&per_cu, (const void*)trunk_fwd, NTHREADS, LDS_BYTES) != hipSuccess || per_cu < 1) { fprintf(stderr, "kernel_launch: occupancy query says %d\n", per_cu); per_cu = 1; }
        (void)hipGetLastError();
        grid = cus * 1;
        fprintf(stderr, "kernel_launch: grid %d (cus %d, per_cu %d)\n", grid, cus, per_cu);
    }
    if (grid < 0) return;
    Args a{};
    for (int i = 0; i < 17; ++i) a.in[i] = (const float*)d_in[i];
    a.out = (float*)d_out; a.ws = (unsigned char*)d_ws;
#if ONE_LAUNCH
    if (hipMemsetAsync((char*)d_ws + WS_BAR, 0, BAR_BYTES, stream) != hipSuccess) { fprintf(stderr, "kernel_launch: memset failed\n"); return; }
    a.ph_lo = 0; a.ph_hi = N_PHASES;
    void* kargs[] = {&a};
    hipError_t e = hipLaunchCooperativeKernel((const void*)trunk_fwd, dim3(grid), dim3(NTHREADS), kargs, LDS_BYTES, stream);
    if (e != hipSuccess) fprintf(stderr, "kernel_launch: cooperative launch failed: %s (grid %d)\n", hipGetErrorString(e), grid);
#else
    for (int p = 0; p < N_PHASES + (DEBUG_SCAN ? 1 : 0); ++p) {
        if (DEBUG_SCAN && p > 0 && p < N_PHASES) { a.ph_lo = p; a.ph_hi = p - 1; hipLaunchKernelGGL(trunk_fwd, dim3(grid), dim3(NTHREADS), LDS_BYTES, stream, a); }
        a.ph_lo = p; a.ph_hi = p + 1;
        hipLaunchKernelGGL(trunk_fwd, dim3(grid), dim3(NTHREADS), LDS_BYTES, stream, a);
    }
#endif
}
```

```cpp
#include <hip/hip_runtime.h>
#include <hip/hip_cooperative_groups.h>
#include <cstdio>
#include <cstdint>
namespace cg = cooperative_groups;
namespace pg8 {
#define PG8_LAS __attribute__((address_space(3)))
typedef unsigned short bf16_t;
typedef short bf16x8 __attribute__((ext_vector_type(8)));
typedef float f32x4 __attribute__((ext_vector_type(4)));
typedef unsigned u32x4 __attribute__((ext_vector_type(4)));
constexpr int BM = 256, BK = 64, HALF = 128, HTB = HALF * BK * 2  , STAGE_BYTES = 8 * HTB, NXCD = 8, WGM = 8;

__host__ __device__ __forceinline__ int lds_byte(int r, int c) { const int st = (r >> 4) * 2 + (c >> 5), rr = r & 15, cc = c & 31, ob = rr * 64 + cc * 2; return st * 1024 + (ob ^ (((ob >> 9) & 1) << 5)); }
__host__ __device__ __forceinline__ void stage_rc(int b, int& R, int& C) { const int st = b / 1024, sb = b % 1024, swz = sb ^ (((sb >> 9) & 1) << 5); R = (st >> 1) * 16 + swz / 64; C = (st & 1) * 32 + (swz % 64) / 2; }
__host__ __device__ __forceinline__ int perm32(int rho) { const int n = rho >> 4, i = rho & 15; return 8 * (i >> 2) + 4 * n + (i & 3); }

struct Unit { int pm, pn; };
struct Gemm { const bf16_t* A; const bf16_t* Bt; int M, N, K; };

struct StaticOrder {
    int nM, nN, nwg, G, c;
    __host__ __device__ void init(int M, int N, int G_, int c_) { nM = M / BM; nN = N / BM; nwg = nM * nN; G = G_; c = c_; }
    __host__ __device__ bool next(int i, Unit& u) const {
        const long L = (long)i * G + c; if (L >= nwg) return false;
        int wgid = (int)L; { const int q = nwg / NXCD, r = nwg % NXCD, xcd = wgid % NXCD, off = wgid / NXCD; wgid = (xcd < r ? xcd * (q + 1) : r * (q + 1) + (xcd - r) * q) + off; }
        const int nig = WGM * nN, gid = wgid / nig, fm = gid * WGM, gsz = (nM - fm) < WGM ? (nM - fm) : WGM;
        u.pm = fm + ((wgid % nig) % gsz); u.pn = (wgid % nig) / gsz; return true;
    }
    __device__ __forceinline__ void a_ready(const Unit&) const {}
    __device__ __forceinline__ void done(const Unit&) const {}
};

__device__ __forceinline__ unsigned cvt_pk_bf16(float lo, float hi) { unsigned r; asm volatile("v_cvt_pk_bf16_f32 %0, %1, %2" : "=v"(r) : "v"(lo), "v"(hi)); return r; }
typedef float f32x2 __attribute__((ext_vector_type(2)));
template <class Epi, class Sched, bool ALIGN_EPI = false, bool SP2 = false, bool ROWPERM = false>
__device__ __forceinline__ void gemm_phase(PG8_LAS unsigned char* lds, const Gemm g, const Sched& S, const Epi& E) {
    int tid = threadIdx.x; asm volatile("" : "+v"(tid));
    const int wid = __builtin_amdgcn_readfirstlane(tid >> 6), lane = tid & 63, wr = wid >> 2, wc = wid & 3, fr = lane & 15, fq = lane >> 4;
    const int K = g.K, nt = K / BK;
    unsigned voffA[2], voffB[2];
#pragma unroll
    for (int i = 0; i < 2; ++i) { int R, C; stage_rc(tid * 16 + i * 8192, R, C); const int Rb = Epi::PERM ? ((R & ~31) + perm32(R & 31)) : R;
        const int Ra = ROWPERM ? (128 * (R >> 6) + 8 * (R & 15) + ((R >> 4) & 3)) : R;
        voffA[i] = (unsigned)(Ra * K + C) * 2u; voffB[i] = (unsigned)(Rb * K + C) * 2u; }
    const size_t kstep = (size_t)(BK * 2);
    const size_t hstep = (size_t)HALF * K * 2;
    const size_t hstepA = ROWPERM ? (size_t)4 * K * 2 : hstep;
    const size_t tstep = 2 * hstep;
    const unsigned ldsw = (unsigned)wid * 1024u;
    const int aoff = lds_byte(wr * 64 + fr, fq * 8), boff = lds_byte(wc * 32 + fr, fq * 8);
#define PG8_SA(b, h) (((b) * 2 + (h)) * HTB)
#define PG8_SB(b, h) ((4 + (b) * 2 + (h)) * HTB)
#define PG8_STAGE(bufoff, gbase, voff) do { _Pragma("unroll") for (int _i = 0; _i < 2; ++_i) \
        __builtin_amdgcn_global_load_lds((const unsigned*)((const char*)(gbase) + (voff)[_i]), (PG8_LAS unsigned*)(lds + (bufoff) + ldsw + _i * 8192), 16, 0, 0); } while (0)
#define PG8_LDA(dst, b, h) do { _Pragma("unroll") for (int m = 0; m < 4; ++m) _Pragma("unroll") for (int k = 0; k < 2; ++k) dst[m][k] = *(const PG8_LAS bf16x8*)(lds + PG8_SA(b, h) + aoff + m * 2048 + k * 1024); } while (0)
#define PG8_LDB(dst, b, h) do { _Pragma("unroll") for (int n = 0; n < 2; ++n) _Pragma("unroll") for (int k = 0; k < 2; ++k) dst[n][k] = *(const PG8_LAS bf16x8*)(lds + PG8_SB(b, h) + boff + n * 2048 + k * 1024); } while (0)
#define PG8_MMA(ai, bj, At, Bt) do { __builtin_amdgcn_s_setprio(1); _Pragma("unroll") for (int m = 0; m < 4; ++m) _Pragma("unroll") for (int n = 0; n < 2; ++n) _Pragma("unroll") for (int k = 0; k < 2; ++k) \
        acc[ai][bj][m][n] = __builtin_amdgcn_mfma_f32_16x16x32_bf16(Bt[n][k], At[m][k], acc[ai][bj][m][n], 0, 0, 0); __builtin_amdgcn_s_setprio(0); } while (0)
#define PG8_WAIT_V(n) asm volatile("s_waitcnt vmcnt(" #n ")" ::: "memory")
#define PG8_WAIT_L(n) asm volatile("s_waitcnt lgkmcnt(" #n ")" ::: "memory")
#define PG8_BAR __builtin_amdgcn_s_barrier()
#define PG8_SCHED __builtin_amdgcn_sched_barrier(0)
    Unit cur, nxt; int ui = 0;
    if (!S.next(0, cur)) return;
    f32x4 acc[2][2][4][2];
#pragma unroll
    for (int a = 0; a < 2; ++a)
#pragma unroll
        for (int b = 0; b < 2; ++b)
#pragma unroll
            for (int m = 0; m < 4; ++m)
#pragma unroll
                for (int n = 0; n < 2; ++n) acc[a][b][m][n] = (f32x4){0.f, 0.f, 0.f, 0.f};
    bf16x8 At[4][2], B0[2][2], B1[2][2];
    const char* cA = (const char*)g.A + (size_t)cur.pm * tstep; const char* cB = (const char*)g.Bt + (size_t)cur.pn * tstep;
    S.a_ready(cur);
    if constexpr (SP2) {
        PG8_STAGE(PG8_SB(0, 0), cB, voffB); PG8_STAGE(PG8_SB(0, 1), cB + hstep, voffB); PG8_STAGE(PG8_SA(0, 0), cA, voffA); PG8_STAGE(PG8_SA(0, 1), cA + hstepA, voffA);
        if (wr == 1) PG8_BAR;
        PG8_WAIT_V(2); PG8_BAR;
        PG8_STAGE(PG8_SB(1, 0), cB + kstep, voffB); PG8_STAGE(PG8_SA(1, 0), cA + kstep, voffA); PG8_STAGE(PG8_SB(1, 1), cB + hstep + kstep, voffB);
        PG8_WAIT_V(6); PG8_BAR;
    } else {
        PG8_STAGE(PG8_SB(0, 0), cB, voffB); PG8_STAGE(PG8_SA(0, 0), cA, voffA); PG8_STAGE(PG8_SB(0, 1), cB + hstep, voffB); PG8_STAGE(PG8_SA(0, 1), cA + hstepA, voffA);
        if (wr == 1) PG8_BAR;
        PG8_WAIT_V(4); PG8_BAR;
        PG8_STAGE(PG8_SB(1, 0), cB + kstep, voffB); PG8_STAGE(PG8_SA(1, 0), cA + kstep, voffA); PG8_STAGE(PG8_SB(1, 1), cB + hstep + kstep, voffB);
        PG8_WAIT_V(6); PG8_BAR;
    }
    for (;;) {
        const bool has_next = S.next(ui + 1, nxt);
        const char* nA = has_next ? (const char*)g.A + (size_t)nxt.pm * tstep : cA; const char* nB = has_next ? (const char*)g.Bt + (size_t)nxt.pn * tstep : cB;
        for (int t = 0; t < nt; t += 2) {
            const bool last = (t == nt - 2);
            const char* a1 = cA + (size_t)(t + 1) * kstep;
            const char* a2 = last ? nA : cA + (size_t)(t + 2) * kstep; const char* b2 = last ? nB : cB + (size_t)(t + 2) * kstep;
            const char* a3 = a2 + kstep; const char* b3 = b2 + kstep;
            if (last && has_next) S.a_ready(nxt);
            if constexpr (SP2) {
            PG8_LDB(B0, 0, 0); PG8_LDB(B1, 0, 1); PG8_SCHED; PG8_LDA(At, 0, 0); PG8_STAGE(PG8_SA(1, 1), a1 + hstepA, voffA);
            PG8_WAIT_V(8); PG8_WAIT_L(0); PG8_BAR; PG8_MMA(0, 0, At, B0); PG8_MMA(0, 1, At, B1); PG8_BAR; PG8_SCHED;
            PG8_LDA(At, 0, 1); PG8_STAGE(PG8_SB(0, 0), b2, voffB); PG8_STAGE(PG8_SB(0, 1), b2 + hstep, voffB); PG8_STAGE(PG8_SA(0, 0), a2, voffA);
            PG8_WAIT_V(8); PG8_WAIT_L(0); PG8_BAR; PG8_MMA(1, 0, At, B0); PG8_MMA(1, 1, At, B1); PG8_BAR; PG8_SCHED;
            PG8_LDB(B0, 1, 0); PG8_LDB(B1, 1, 1); PG8_SCHED; PG8_LDA(At, 1, 0); PG8_STAGE(PG8_SA(0, 1), a2 + hstepA, voffA);
            PG8_WAIT_V(8); PG8_WAIT_L(0); PG8_BAR; PG8_MMA(0, 0, At, B0); PG8_MMA(0, 1, At, B1); PG8_BAR; PG8_SCHED;
            PG8_LDA(At, 1, 1); PG8_STAGE(PG8_SB(1, 0), b3, voffB); PG8_STAGE(PG8_SB(1, 1), b3 + hstep, voffB); PG8_STAGE(PG8_SA(1, 0), a3, voffA);
            PG8_WAIT_V(8); PG8_WAIT_L(0); PG8_BAR; PG8_MMA(1, 0, At, B0); PG8_MMA(1, 1, At, B1); PG8_BAR; PG8_SCHED;
            } else {
            PG8_LDB(B0, 0, 0); PG8_SCHED; PG8_LDA(At, 0, 0); PG8_STAGE(PG8_SA(1, 1), a1 + hstepA, voffA);
            PG8_WAIT_L(8); PG8_BAR; PG8_WAIT_L(0); PG8_MMA(0, 0, At, B0); PG8_BAR; PG8_SCHED;
            PG8_LDB(B1, 0, 1); PG8_STAGE(PG8_SB(0, 0), b2, voffB);
            PG8_BAR; PG8_WAIT_L(0); PG8_MMA(0, 1, At, B1); PG8_BAR;
            PG8_LDA(At, 0, 1); PG8_STAGE(PG8_SA(0, 0), a2, voffA);
            PG8_BAR; PG8_WAIT_L(0); PG8_MMA(1, 0, At, B0); PG8_BAR; PG8_SCHED;
            PG8_STAGE(PG8_SB(0, 1), b2 + hstep, voffB);
            PG8_WAIT_V(6); PG8_BAR; PG8_MMA(1, 1, At, B1); PG8_BAR;
            PG8_LDB(B0, 1, 0); PG8_SCHED; PG8_LDA(At, 1, 0); PG8_STAGE(PG8_SA(0, 1), a2 + hstepA, voffA);
            PG8_WAIT_L(8); PG8_BAR; PG8_WAIT_L(0); PG8_MMA(0, 0, At, B0); PG8_BAR; PG8_SCHED;
            PG8_LDB(B1, 1, 1); PG8_STAGE(PG8_SB(1, 0), b3, voffB);
            PG8_BAR; PG8_WAIT_L(0); PG8_MMA(0, 1, At, B1); PG8_BAR;
            PG8_LDA(At, 1, 1); PG8_STAGE(PG8_SA(1, 0), a3, voffA);
            PG8_BAR; PG8_WAIT_L(0); PG8_MMA(1, 0, At, B0); PG8_BAR; PG8_SCHED;
            PG8_STAGE(PG8_SB(1, 1), b3 + hstep, voffB);
            PG8_WAIT_V(6); PG8_BAR; PG8_MMA(1, 1, At, B1); PG8_BAR;
            }
        }
        if constexpr (ALIGN_EPI) { if (wr == 0) PG8_BAR; }
        if constexpr (!Epi::AFTER_DRAIN) { E(acc, cur, wr, wc, fr, fq); S.done(cur); }
        if (!has_next) break;
#pragma unroll
        for (int a = 0; a < 2; ++a)
#pragma unroll
            for (int b = 0; b < 2; ++b)
#pragma unroll
                for (int m = 0; m < 4; ++m)
#pragma unroll
                    for (int n = 0; n < 2; ++n) acc[a][b][m][n] = (f32x4){0.f, 0.f, 0.f, 0.f};
        cur = nxt; cA = nA; cB = nB; ++ui;
        if constexpr (ALIGN_EPI) { if (wr == 1) PG8_BAR; }
    }
    PG8_WAIT_V(0);
    if constexpr (!ALIGN_EPI) { if (wr == 0) PG8_BAR; }
    PG8_BAR;
    if constexpr (Epi::AFTER_DRAIN) { E.fused(acc, cur, wr, wc, fr, fq, lds, wid, lane); S.done(cur); }
#undef PG8_SA
#undef PG8_SB
#undef PG8_STAGE
#undef PG8_LDA
#undef PG8_LDB
#undef PG8_MMA
#undef PG8_WAIT_V
#undef PG8_WAIT_L
#undef PG8_BAR
#undef PG8_SCHED
}
}

constexpr int BATCH = 2, SEQ = 8192, D = 1024, M = BATCH * SEQ, DEPTH = 2;
constexpr int PW = 512, HW = 512, NH = 4, HD = 128, CH = 64, NCH = SEQ / CH, NBH = BATCH * NH, NUNIT = NBH * NCH;
constexpr int IN_COLS = 4608, NMIX = 2560, NGATE = 2048, DFF = 2816, NUP = 2 * DFF;
constexpr float EPS = 1e-6f;
constexpr int NWAVES = 8, NTHREADS = 512;
constexpr int LDS_BYTES = 147456;

constexpr size_t MiB = 1u << 20;
constexpr size_t WS_BAR = 512 * 1024, BAR_BYTES = 16384;
constexpr size_t WS_SSQ = 1 * MiB;
constexpr size_t WS_DEC = 2 * MiB;
constexpr size_t WS_LB = 2 * MiB + 768 * 1024;
constexpr size_t WS_HBND = 3 * MiB;
constexpr size_t WS_W = 9 * MiB, W_LAYER = 29 * MiB + 512 * 1024;
constexpr size_t WO_IN = 0, WO_A = 9 * MiB, WO_PB = 10 * MiB, WO_O = 11 * MiB, WO_UP = 13 * MiB, WO_DN = 24 * MiB;
constexpr size_t WS_XB = 68 * MiB;
constexpr size_t WS_R = 100 * MiB;
constexpr size_t WS_U = WS_R, WS_HG = WS_R, WS_Q = WS_R + 16 * MiB, WS_V = WS_R + 32 * MiB, WS_SO = WS_R + 48 * MiB, WS_G = WS_R + 64 * MiB;
constexpr size_t WS_POOL = WS_R + 96 * MiB, WS_UT = WS_R + 112 * MiB, WS_GATES = WS_R + 16 * MiB, WS_MERGED = WS_R + 112 * MiB, WS_ACT = WS_R;
constexpr size_t WS_XF = WS_R + 88 * MiB;
constexpr size_t WS_END = 256 * MiB;
static_assert(WS_UT + 32 * MiB <= WS_END && WS_ACT + (size_t)M * DFF * 2 <= WS_END && WS_GATES + 64 * MiB <= WS_POOL, "ws map");

#define LAS __attribute__((address_space(3)))
typedef unsigned short bf16;
typedef unsigned u32x4 __attribute__((ext_vector_type(4)));
typedef unsigned u32x2 __attribute__((ext_vector_type(2)));
typedef float f32x4 __attribute__((ext_vector_type(4)));
typedef float f32x2 __attribute__((ext_vector_type(2)));
typedef short bf16x8 __attribute__((ext_vector_type(8)));

__device__ __forceinline__ float bflo(unsigned w) { return __uint_as_float(w << 16); }
__device__ __forceinline__ float bfhi(unsigned w) { return __uint_as_float(w & 0xffff0000u); }
typedef __bf16 bf16x2_t __attribute__((ext_vector_type(2)));
__device__ __forceinline__ unsigned pk(float lo, float hi) { const bf16x2_t v = __builtin_convertvector((f32x2){lo, hi}, bf16x2_t); return __builtin_bit_cast(unsigned, v); }
__device__ __forceinline__ float sigm(float x) { return 1.f / (1.f + __expf(-x)); }
__device__ __forceinline__ float silu(float x) { return x * sigm(x); }
__device__ __forceinline__ float wave_sum(float v) {
#pragma unroll
    for (int o = 1; o < 64; o <<= 1) v += __shfl_xor(v, o);
    return v;
}
__device__ __forceinline__ float dpp_shr1(float x) { return __int_as_float(__builtin_amdgcn_update_dpp(0, __float_as_int(x), 0x111, 0xf, 0xf, true)); }
#define LDS_WAIT() asm volatile("s_waitcnt lgkmcnt(0)" ::: "memory")
#define VM_WAIT() asm volatile("s_waitcnt vmcnt(0)" ::: "memory")

__device__ __forceinline__ float load_rs(const float* ssq, int row0, int lane) {
    const f32x4* p = (const f32x4*)(ssq + (size_t)(row0 + lane) * 16);
    const f32x4 a = p[0], b = p[1], c = p[2], d = p[3];
    const f32x4 s = (a + b) + (c + d);
    return rsqrtf(((s[0] + s[1]) + (s[2] + s[3])) * (1.f / D) + EPS);
}

struct EpiInMix {
    static constexpr bool PERM = true, AFTER_DRAIN = false;
    bf16 *u, *q, *v, *so; bf16* g; const float* ssq; const float* lb; bf16* gates; const float* bgate; int pn_off;
    __device__ __forceinline__ void operator()(const f32x4 (&acc)[2][2][4][2], const pg8::Unit& un0, int wr, int wc, int fr, int fq) const {
        const int lane = fr + 16 * fq;
        pg8::Unit un = un0; un.pn += pn_off;
        float rs[2]; rs[0] = load_rs(ssq, un.pm * 256 + wr * 64, lane); rs[1] = load_rs(ssq, un.pm * 256 + 128 + wr * 64, lane);
        const int sec = un.pn >> 1, colt = (un.pn & 1) * 256 + wc * 32 + 8 * fq, row0 = un.pm * 256 + wr * 64 + fr;
        if (un.pn >= 10) {
            const int col0 = (un.pn - 10) * 256 + wc * 32 + 8 * fq;
            f32x4 bv[2][2];
#pragma unroll
            for (int bj = 0; bj < 2; ++bj)
#pragma unroll
                for (int n = 0; n < 2; ++n) bv[bj][n] = *(const f32x4*)(bgate + col0 + bj * 128 + 4 * n);
#pragma unroll
            for (int ai = 0; ai < 2; ++ai)
#pragma unroll
                for (int m = 0; m < 4; ++m) {
                    const float r = __shfl(rs[ai], 16 * m + fr);
                    bf16* rowp = gates + (size_t)(row0 + ai * 128 + m * 16) * NGATE + col0;
#pragma unroll
                    for (int bj = 0; bj < 2; ++bj) {
                        f32x4 v0 = acc[ai][bj][m][0] * r + bv[bj][0], v1 = acc[ai][bj][m][1] * r + bv[bj][1];
#pragma unroll
                        for (int e = 0; e < 4; ++e) { v0[e] = sigm(v0[e]); v1[e] = sigm(v1[e]); }
                        u32x4 w; w.x = pk(v0[0], v0[1]); w.y = pk(v0[2], v0[3]); w.z = pk(v1[0], v1[1]); w.w = pk(v1[2], v1[3]);
                        *(u32x4*)(rowp + bj * 128) = w;
                    }
                }
        } else if (sec == 2) {
            f32x4 lbv[2][2];
#pragma unroll
            for (int bj = 0; bj < 2; ++bj)
#pragma unroll
                for (int n = 0; n < 2; ++n) lbv[bj][n] = *(const f32x4*)(lb + colt + bj * 128 + 4 * n);
#pragma unroll
            for (int ai = 0; ai < 2; ++ai)
#pragma unroll
                for (int m = 0; m < 4; ++m) {
                    const float r = __shfl(rs[ai], 16 * m + fr);
                    bf16* rowp = g + (size_t)(row0 + ai * 128 + m * 16) * 512 + colt;
#pragma unroll
                    for (int bj = 0; bj < 2; ++bj) {
                        float o[8];
#pragma unroll
                        for (int n = 0; n < 2; ++n) { const f32x4 z = acc[ai][bj][m][n] * r;
#pragma unroll
                            for (int e = 0; e < 4; ++e) { const float l = lbv[bj][n][e]; o[4 * n + e] = __logf(l + (1.f - l) * sigm(z[e])); } }
                        u32x4 w; w.x = pk(o[0], o[1]); w.y = pk(o[2], o[3]); w.z = pk(o[4], o[5]); w.w = pk(o[6], o[7]);
                        *(u32x4*)(rowp + bj * 128) = w;
                    }
                }
        } else {
            bf16* base = sec == 0 ? u : (sec == 1 ? q : (sec == 3 ? v : so));
            const bool act = (sec == 1 || sec == 4);
#pragma unroll
            for (int ai = 0; ai < 2; ++ai)
#pragma unroll
                for (int m = 0; m < 4; ++m) {
                    const float r = __shfl(rs[ai], 16 * m + fr);
                    bf16* rowp = base + (size_t)(row0 + ai * 128 + m * 16) * 512 + colt;
#pragma unroll
                    for (int bj = 0; bj < 2; ++bj) {
                        f32x4 v0 = acc[ai][bj][m][0] * r, v1 = acc[ai][bj][m][1] * r;
                        if (act) {
#pragma unroll
                            for (int e = 0; e < 4; ++e) { v0[e] = silu(v0[e]); v1[e] = silu(v1[e]); }
                        }
                        u32x4 w; w.x = pk(v0[0], v0[1]); w.y = pk(v0[2], v0[3]); w.z = pk(v1[0], v1[1]); w.w = pk(v1[2], v1[3]);
                        *(u32x4*)(rowp + bj * 128) = w;
                    }
                }
        }
    }
};


struct GateOrder {
    pg8::StaticOrder S;
    __device__ bool next(int i, pg8::Unit& u) const { if (!S.next(i >> 1, u)) return false; u.pn += 4 * (i & 1); return true; }
    __device__ __forceinline__ void a_ready(const pg8::Unit&) const {}
    __device__ __forceinline__ void done(const pg8::Unit&) const {}
};
template <bool SECOND> struct EpiMerge {
    static constexpr bool PERM = true, AFTER_DRAIN = false;
    bf16* merged; const bf16* gates;
    __device__ __forceinline__ void operator()(const f32x4 (&acc)[2][2][4][2], const pg8::Unit& un, int wr, int wc, int fr, int fq) const {
        const int col0 = un.pn * 256 + wc * 32 + 8 * fq, row0 = un.pm * 256 + wr * 64 + fr;
#pragma unroll
        for (int ai = 0; ai < 2; ++ai)
#pragma unroll
            for (int m = 0; m < 4; ++m) {
                const size_t row = (size_t)(row0 + ai * 128 + m * 16);
#pragma unroll
                for (int bj = 0; bj < 2; ++bj) {
                    const u32x4 gw = *(const u32x4*)(gates + row * NGATE + (SECOND ? 1024 : 0) + col0 + bj * 128);
                    const f32x4 a0 = acc[ai][bj][m][0], a1 = acc[ai][bj][m][1];
                    float o[8];
                    o[0] = bflo(gw.x) * a0[0]; o[1] = bfhi(gw.x) * a0[1]; o[2] = bflo(gw.y) * a0[2]; o[3] = bfhi(gw.y) * a0[3];
                    o[4] = bflo(gw.z) * a1[0]; o[5] = bfhi(gw.z) * a1[1]; o[6] = bflo(gw.w) * a1[2]; o[7] = bfhi(gw.w) * a1[3];
                    bf16* mp = merged + row * D + col0 + bj * 128;
                    if (SECOND) {
                        const u32x4 ow = *(const u32x4*)mp;
                        o[0] += bflo(ow.x); o[1] += bfhi(ow.x); o[2] += bflo(ow.y); o[3] += bfhi(ow.y);
                        o[4] += bflo(ow.z); o[5] += bfhi(ow.z); o[6] += bflo(ow.w); o[7] += bfhi(ow.w);
                    }
                    u32x4 w; w.x = pk(o[0], o[1]); w.y = pk(o[2], o[3]); w.z = pk(o[4], o[5]); w.w = pk(o[6], o[7]);
                    *(u32x4*)mp = w;
                }
            }
    }
};

template <bool LAST> struct EpiRes {
    static constexpr bool PERM = true, AFTER_DRAIN = false;
    float* out; bf16* xb; float* ssq;
    __device__ __forceinline__ void operator()(const f32x4 (&acc)[2][2][4][2], const pg8::Unit& un, int wr, int wc, int fr, int fq) const {
        const int col0 = un.pn * 256 + wc * 32 + 8 * fq, row0 = un.pm * 256 + wr * 64 + fr;
#pragma unroll
        for (int ai = 0; ai < 2; ++ai)
#pragma unroll
            for (int m = 0; m < 4; ++m) {
                const size_t row = (size_t)(row0 + ai * 128 + m * 16);
                float s = 0.f;
#pragma unroll
                for (int bj = 0; bj < 2; ++bj) {
                    const size_t p = row * D + col0 + bj * 128;
                    const u32x4 bw = *(const u32x4*)(xb + p);
                    const f32x4 x0 = (f32x4){bflo(bw.x), bfhi(bw.x), bflo(bw.y), bfhi(bw.y)} + acc[ai][bj][m][0], x1 = (f32x4){bflo(bw.z), bfhi(bw.z), bflo(bw.w), bfhi(bw.w)} + acc[ai][bj][m][1];
                    s += (x0[0] * x0[0] + x0[1] * x0[1]) + (x0[2] * x0[2] + x0[3] * x0[3]) + (x1[0] * x1[0] + x1[1] * x1[1]) + (x1[2] * x1[2] + x1[3] * x1[3]);
                    if (LAST) { *(f32x4*)(out + p) = x0; *(f32x4*)(out + p + 4) = x1; }
                    else { u32x4 w; w.x = pk(x0[0], x0[1]); w.y = pk(x0[2], x0[3]); w.z = pk(x1[0], x1[1]); w.w = pk(x1[2], x1[3]); *(u32x4*)(xb + p) = w; }
                }
                s += __shfl_xor(s, 16); s += __shfl_xor(s, 32);
                if (fq == 0) ssq[row * 16 + un.pn * 4 + wc] = s;
            }
    }
};

struct EpiUpConv {
    static constexpr bool PERM = false, AFTER_DRAIN = false;
    bf16* act; bf16* hbnd; const float* ssq; const float* cw; const float* cb;
    __device__ __forceinline__ void operator()(f32x4 (&acc)[2][2][4][2], const pg8::Unit& un, int wr, int wc, int fr, int fq) const {
        const int lane = fr + 16 * fq;
        {
            const float rs0 = load_rs(ssq, un.pm * 256 + 128 * wr, lane), rs1 = load_rs(ssq, un.pm * 256 + 128 * wr + 64, lane);
#pragma unroll
            for (int j = 0; j < 8; ++j) { const int src = (8 * fr + j) & 63; const float a = __shfl(rs0, src), b = __shfl(rs1, src); const float r = fr < 8 ? a : b;
#pragma unroll
                for (int bj = 0; bj < 2; ++bj)
#pragma unroll
                    for (int n = 0; n < 2; ++n) acc[j >> 2][bj][j & 3][n] *= r; }
        }
        const size_t tok0 = (size_t)un.pm * 256 + 128 * wr + 8 * fr;
        const int blk = un.pm * 2 + wr;
#pragma unroll
        for (int n = 0; n < 2; ++n) {
            const int ch0 = un.pn * 128 + wc * 32 + 16 * n + 4 * fq;
            if (fr == 15) {
                bf16* hb = hbnd + ((size_t)(blk * 4 + 2) * 2) * DFF + ch0;
                const f32x4 hv6 = acc[1][0][2][n], hv7 = acc[1][0][3][n], hg6 = acc[1][1][2][n], hg7 = acc[1][1][3][n];
                *(u32x2*)(hb) = (u32x2){pk(hv6[0], hv6[1]), pk(hv6[2], hv6[3])}; *(u32x2*)(hb + DFF) = (u32x2){pk(hg6[0], hg6[1]), pk(hg6[2], hg6[3])};
                *(u32x2*)(hb + 2 * DFF) = (u32x2){pk(hv7[0], hv7[1]), pk(hv7[2], hv7[3])}; *(u32x2*)(hb + 3 * DFF) = (u32x2){pk(hg7[0], hg7[1]), pk(hg7[2], hg7[3])};
            }
            if (fr == 0) {
#pragma unroll
                for (int j = 0; j < 2; ++j) { bf16* hb = hbnd + ((size_t)(blk * 4 + j) * 2) * DFF + ch0; const f32x4 hv = acc[0][0][j][n], hg = acc[0][1][j][n];
                    *(u32x2*)(hb) = (u32x2){pk(hv[0], hv[1]), pk(hv[2], hv[3])}; *(u32x2*)(hb + DFF) = (u32x2){pk(hg[0], hg[1]), pk(hg[2], hg[3])}; }
            }
#pragma unroll
            for (int bj = 0; bj < 2; ++bj) {
                const float* cwp = cw + bj * DFF + ch0;
                const f32x4 w0 = *(const f32x4*)(cwp), w1 = *(const f32x4*)(cwp + NUP), w2 = *(const f32x4*)(cwp + 2 * NUP), bb = *(const f32x4*)(cb + bj * DFF + ch0);
                f32x4 m2, m1;
#pragma unroll
                for (int e = 0; e < 4; ++e) { m2[e] = dpp_shr1(acc[1][bj][2][n][e]); m1[e] = dpp_shr1(acc[1][bj][3][n][e]); }
#pragma unroll
                for (int j = 7; j >= 0; --j) {
                    const f32x4 h0 = acc[j >> 2][bj][j & 3][n];
                    const f32x4 hm1 = j >= 1 ? acc[(j - 1 + 8) % 8 >> 2][bj][(j - 1 + 8) % 8 & 3][n] : m1;
                    const f32x4 hm2 = j >= 2 ? acc[(j - 2 + 8) % 8 >> 2][bj][(j - 2 + 8) % 8 & 3][n] : (j == 1 ? m1 : m2);
                    acc[j >> 2][bj][j & 3][n] = w2 * h0 + w1 * hm1 + w0 * hm2 + bb;
                }
            }
#pragma unroll
            for (int j = 0; j < 8; ++j) {
                const f32x4 vc = acc[j >> 2][0][j & 3][n], gc = acc[j >> 2][1][j & 3][n];
                f32x4 a;
#pragma unroll
                for (int e = 0; e < 4; ++e) a[e] = vc[e] * silu(gc[e]);
                if (!(j < 2 && fr == 0)) *(u32x2*)(act + (tok0 + j) * DFF + ch0) = (u32x2){pk(a[0], a[1]), pk(a[2], a[3])};
            }
        }
    }
};

struct Args { const float* in[17]; float* out; unsigned char* ws; int ph_lo, ph_hi; };

struct TrItem { const float* W; const float* rscale; bf16* WT; int K, N, drow0, k0, n0; };
__device__ __forceinline__ void tr_load(const TrItem& t, int lane, float (&wv)[32]) {
#pragma unroll
    for (int i = 0; i < 32; ++i) { const int kk = 2 * i + (lane >> 5); wv[i] = t.W[(size_t)(t.k0 + kk) * t.N + t.n0 + (lane & 31)]; }
    if (t.rscale) {
#pragma unroll
        for (int i = 0; i < 32; ++i) wv[i] *= t.rscale[t.k0 + 2 * i + (lane >> 5)];
    }
}
__device__ __forceinline__ void tr_store(const TrItem& t, int lane, const float (&wv)[32], LAS float* scr) {
#pragma unroll
    for (int i = 0; i < 32; ++i) scr[(2 * i + (lane >> 5)) * 33 + (lane & 31)] = wv[i];
    LDS_WAIT(); asm volatile("" ::: "memory");
    const int c = lane & 7;
#pragma unroll
    for (int j = 0; j < 4; ++j) { const int n = (lane >> 3) + 8 * j; const LAS float* sp = scr + (8 * c) * 33 + n;
        u32x4 o; o.x = pk(sp[0 * 33], sp[1 * 33]); o.y = pk(sp[2 * 33], sp[3 * 33]); o.z = pk(sp[4 * 33], sp[5 * 33]); o.w = pk(sp[6 * 33], sp[7 * 33]);
        *(u32x4*)(t.WT + (size_t)(t.drow0 + n) * t.K + t.k0 + 8 * c) = o; }
    LDS_WAIT(); asm volatile("" ::: "memory");
}
constexpr int I_IN = (D / 64) * (IN_COLS / 32), I_PB = (HW / 64) * (D / 32), I_O = (D / 64) * (D / 32), I_UP = (D / 64) * (NUP / 32), I_DN = (DFF / 64) * (D / 32);
constexpr int I_LAYER = I_IN + I_PB + I_O + I_UP + I_DN;
__device__ __forceinline__ TrItem tr_decode(const Args& a, int it) {
    const int l = it / I_LAYER; int r = it % I_LAYER;
    unsigned char* wl = a.ws + WS_W + (size_t)l * W_LAYER;
    TrItem t;
    if (r < I_IN) { const int nb = IN_COLS / 32; t.k0 = 64 * (r / nb); t.n0 = 32 * (r % nb); t.W = a.in[2] + (size_t)l * D * IN_COLS; t.K = D; t.N = IN_COLS; t.rscale = a.in[1] + l * D; t.WT = (bf16*)(wl + WO_IN); t.drow0 = t.n0; return t; }
    r -= I_IN;
    if (r < I_PB) { const int nb = D / 32; t.k0 = 64 * (r / nb); t.n0 = 32 * (r % nb); t.W = a.in[9] + (size_t)l * HW * D; t.K = HW; t.N = D; t.rscale = nullptr; t.WT = (bf16*)(wl + WO_PB); t.drow0 = t.n0; return t; }
    r -= I_PB;
    if (r < I_O) { const int nb = D / 32; t.k0 = 64 * (r / nb); t.n0 = 32 * (r % nb); t.W = a.in[10] + (size_t)l * D * D; t.K = D; t.N = D; t.rscale = nullptr; t.WT = (bf16*)(wl + WO_O); t.drow0 = t.n0; return t; }
    r -= I_O;
    if (r < I_UP) { const int nb = NUP / 32; t.k0 = 64 * (r / nb); t.n0 = 32 * (r % nb); t.W = a.in[12] + (size_t)l * D * NUP; t.K = D; t.N = NUP; t.rscale = a.in[11] + l * D; t.WT = (bf16*)(wl + WO_UP);
        const int bjs = t.n0 / DFF, rr = t.n0 % DFF; t.drow0 = 256 * (rr / 128) + 128 * bjs + (rr % 128); return t; }
    r -= I_UP;
    { const int nb = D / 32; t.k0 = 64 * (r / nb); t.n0 = 32 * (r % nb); t.W = a.in[15] + (size_t)l * DFF * D; t.K = DFF; t.N = D; t.rscale = nullptr; t.WT = (bf16*)(wl + WO_DN); t.drow0 = t.n0; return t; }
}

__device__ __forceinline__ void convert_items(const Args& a, LAS unsigned char* lds, int it0, int it1, int r, int nr) {
    int tid = threadIdx.x; asm volatile("" : "+v"(tid));
    const int lane = tid & 63, wave = __builtin_amdgcn_readfirstlane(tid >> 6);
    LAS float* scr = (LAS float*)(lds + wave * 16384);
    const int gw = r * NWAVES + wave, NGW = nr * NWAVES;
    for (int it = it0 + gw; it < it1; it += 2 * NGW) {
        const bool two = it + NGW < it1;
        const TrItem t0 = tr_decode(a, it), t1 = tr_decode(a, two ? it + NGW : it);
        float w0[32], w1[32];
        tr_load(t0, lane, w0); if (two) tr_load(t1, lane, w1);
        tr_store(t0, lane, w0, scr); if (two) tr_store(t1, lane, w1, scr);
    }
}
__device__ __forceinline__ void fold_pool(const Args& a, LAS unsigned char* lds, int l0, int l1, int r, int nr) {
    int tid = threadIdx.x; asm volatile("" : "+v"(tid));
    const int lane = tid & 63, wave = __builtin_amdgcn_readfirstlane(tid >> 6);
    unsigned char* ws = a.ws;
    const float *pool_w = a.in[4], *pool_scale = a.in[5], *w_pa = a.in[8];
    LAS float* scr = (LAS float*)(lds + wave * 16384);
    for (int gt = l0 * 65536 + r * NTHREADS + tid; gt < l1 * 65536; gt += nr * NTHREADS) {
        const int l = __builtin_amdgcn_readfirstlane(gt >> 16), rem = gt & 65535, d = rem & 1023, cg8 = __builtin_amdgcn_readfirstlane(rem >> 10), gi = cg8 >> 4, c0 = (cg8 & 15) * 8;
        const float* pw = pool_w + ((size_t)(l * 4 + gi) * 128 + c0) * 128;
        const float* ps = pool_scale + l * PW + gi * 128;
        const float* wp = w_pa + ((size_t)l * PW + gi * 128) * D + d;
        LAS float* pwl = scr;
#pragma unroll
        for (int j = 0; j < 4; ++j) { const int e = j * 256 + lane * 4; const f32x4 v = *(const f32x4*)(pw + e) * *(const f32x4*)(ps + (e & 127)); *(LAS f32x4*)(pwl + e) = v; }
        LDS_WAIT(); asm volatile("" ::: "memory");
        float sacc[8];
#pragma unroll
        for (int i = 0; i < 8; ++i) sacc[i] = 0.f;
#pragma unroll 4
        for (int cp = 0; cp < 128; cp += 4) {
            const float w0 = wp[(size_t)cp * D], w1 = wp[(size_t)(cp + 1) * D], w2 = wp[(size_t)(cp + 2) * D], w3 = wp[(size_t)(cp + 3) * D];
#pragma unroll
            for (int i = 0; i < 8; ++i) { const f32x4 p = *(const LAS f32x4*)(pwl + i * 128 + cp); sacc[i] += (p[0] * w0 + p[1] * w1) + (p[2] * w2 + p[3] * w3); }
        }
        u32x4 o; o.x = pk(sacc[0], sacc[1]); o.y = pk(sacc[2], sacc[3]); o.z = pk(sacc[4], sacc[5]); o.w = pk(sacc[6], sacc[7]);
        *(u32x4*)((bf16*)(ws + WS_W + (size_t)l * W_LAYER + WO_A) + (size_t)d * PW + cg8 * 8) = o;
        LDS_WAIT(); asm volatile("" ::: "memory");
    }
}

__device__ __forceinline__ void phase_prologue(const Args& a, LAS unsigned char* lds, int G, bool lazy) {
    int tid = threadIdx.x; asm volatile("" : "+v"(tid));
    const int lane = tid & 63, wave = __builtin_amdgcn_readfirstlane(tid >> 6);
    unsigned char* ws = a.ws;
    const float *x = a.in[0], *lb_logits = a.in[6];
    const int gw = blockIdx.x * NWAVES + wave, NGW = G * NWAVES;
    convert_items(a, lds, 0, lazy ? I_IN : DEPTH * I_LAYER, (int)blockIdx.x, G);
    if (!lazy) fold_pool(a, lds, 0, DEPTH, (int)blockIdx.x, G);
    if (blockIdx.x == 0) {
        const int chn = tid;
        float mx = -1e30f;
        for (int l = 0; l < DEPTH; ++l) mx = fmaxf(mx, lb_logits[l * HW + chn]);
        float sum = 0.f;
        for (int l = 0; l < DEPTH; ++l) sum += expf(lb_logits[l * HW + chn] - mx);
        float cum = 0.f, c0v = 0.f;
        for (int l = 0; l < DEPTH; ++l) { cum += expf(lb_logits[l * HW + chn] - mx) / sum; if (l == 0) c0v = cum; ((float*)(ws + WS_LB))[l * HW + chn] = cum - c0v; }
    }
    bf16* xb = (bf16*)(ws + WS_XB); float* ssq = (float*)(ws + WS_SSQ);
    for (int m = gw; m < M; m += 4 * NGW) {
        f32x4 v[4][4]; bool ok[4];
#pragma unroll
        for (int q = 0; q < 4; ++q) { const int mq = m + q * NGW; ok[q] = mq < M; const f32x4* xr = (const f32x4*)(x + (size_t)(ok[q] ? mq : m) * D) + lane;
#pragma unroll
            for (int j = 0; j < 4; ++j) v[q][j] = xr[64 * j]; }
#pragma unroll
        for (int q = 0; q < 4; ++q) {
            const int mq = m + q * NGW;
            float sq = 0.f;
#pragma unroll
            for (int j = 0; j < 4; ++j) sq += (v[q][j][0] * v[q][j][0] + v[q][j][1] * v[q][j][1]) + (v[q][j][2] * v[q][j][2] + v[q][j][3] * v[q][j][3]);
            sq = wave_sum(sq);
            if (ok[q]) {
                u32x2* o8 = (u32x2*)(xb + (size_t)mq * D) + lane;
#pragma unroll
                for (int j = 0; j < 4; ++j) o8[64 * j] = (u32x2){pk(v[q][j][0], v[q][j][1]), pk(v[q][j][2], v[q][j][3])};
                if (lane < 16) ssq[(size_t)mq * 16 + lane] = lane == 0 ? sq : 0.f;
            }
        }
    }
}

__device__ __forceinline__ void phase_fir(const bf16* u, bf16* pooled, int G) {
    int tid = threadIdx.x; asm volatile("" : "+v"(tid));
    for (int item = blockIdx.x * NTHREADS + tid; item < (M / 8) * 64; item += G * NTHREADS) {
        const int cgp = item & 63, run = item >> 6, m0 = run * 8, ts = m0 & (SEQ - 1), w = 2 << (cgp >> 4);
        const bf16* up = u + (size_t)m0 * PW + cgp * 8;
        float s[8];
#pragma unroll
        for (int i = 0; i < 8; ++i) s[i] = 0.f;
        for (int d = 1; d < w; ++d) if (ts - d >= 0) {
            const u32x4 x = *(const u32x4*)(up - (size_t)d * PW);
            s[0] += bflo(x.x); s[1] += bfhi(x.x); s[2] += bflo(x.y); s[3] += bfhi(x.y); s[4] += bflo(x.z); s[5] += bfhi(x.z); s[6] += bflo(x.w); s[7] += bfhi(x.w);
        }
#pragma unroll
        for (int r = 0; r < 8; ++r) {
            const u32x4 x = *(const u32x4*)(up + (size_t)r * PW);
            float c[8] = {bflo(x.x), bfhi(x.x), bflo(x.y), bfhi(x.y), bflo(x.z), bfhi(x.z), bflo(x.w), bfhi(x.w)};
#pragma unroll
            for (int i = 0; i < 8; ++i) s[i] += c[i];
            const int cnt = (ts + r + 1) < w ? (ts + r + 1) : w; const float inv = 1.f / (float)cnt;
            u32x4 o; o.x = pk(s[0] * inv - c[0], s[1] * inv - c[1]); o.y = pk(s[2] * inv - c[2], s[3] * inv - c[3]);
            o.z = pk(s[4] * inv - c[4], s[5] * inv - c[5]); o.w = pk(s[6] * inv - c[6], s[7] * inv - c[7]);
            *(u32x4*)(pooled + (size_t)(m0 + r) * PW + cgp * 8) = o;
            if (ts + r - w + 1 >= 0) {
                const u32x4 y = *(const u32x4*)(up + ((ptrdiff_t)r - w + 1) * PW);
                s[0] -= bflo(y.x); s[1] -= bfhi(y.x); s[2] -= bflo(y.y); s[3] -= bfhi(y.y); s[4] -= bflo(y.z); s[5] -= bfhi(y.z); s[6] -= bflo(y.w); s[7] -= bfhi(y.w);
            }
        }
    }
}

__device__ __forceinline__ u32x4 pack_lo8(const unsigned (&v)[8]) { u32x4 o; o.x = (v[0] & 0xffffu) | (v[1] << 16); o.y = (v[2] & 0xffffu) | (v[3] << 16); o.z = (v[4] & 0xffffu) | (v[5] << 16); o.w = (v[6] & 0xffffu) | (v[7] << 16); return o; }
__device__ __forceinline__ u32x4 pack_hi8(const unsigned (&v)[8]) { u32x4 o; o.x = (v[0] >> 16) | (v[1] & 0xffff0000u); o.y = (v[2] >> 16) | (v[3] & 0xffff0000u); o.z = (v[4] >> 16) | (v[5] & 0xffff0000u); o.w = (v[6] >> 16) | (v[7] & 0xffff0000u); return o; }

#define WG_BAR() do { asm volatile("s_waitcnt lgkmcnt(0)" ::: "memory"); __builtin_amdgcn_s_barrier(); asm volatile("" ::: "memory"); } while (0)
__device__ __forceinline__ void phase_h1(LAS unsigned char* lds, const bf16* g, const bf16* vb, bf16* UT, float* dec, int G) {
    int tid = threadIdx.x; asm volatile("" : "+v"(tid));
    const int lane = tid & 63, w = __builtin_amdgcn_readfirstlane(tid >> 6), r16 = lane & 15, q4 = lane >> 4;
    LAS unsigned char* KT = lds; LAS unsigned char* VT = lds + 18432; LAS float* SEG = (LAS float*)(lds + 36864);
    f32x2 gg[8]; unsigned vv[8];
    int unit = blockIdx.x;
    if (unit < NUNIT) {
        const int bh = unit >> 7, c = unit & 127, b = bh >> 2, h = bh & 3;
        const size_t m0 = (size_t)b * SEQ + c * CH + 8 * w; const int col = h * HD + 2 * lane;
#pragma unroll
        for (int r = 0; r < 8; ++r) { { const unsigned gw_ = *(const unsigned*)(g + (m0 + r) * HW + col); gg[r] = (f32x2){bflo(gw_), bfhi(gw_)}; } vv[r] = *(const unsigned*)(vb + (m0 + r) * HW + col); }
    }
    for (; unit < NUNIT; unit += G) {
        f32x2 cs[8]; cs[0] = gg[0];
#pragma unroll
        for (int r = 1; r < 8; ++r) cs[r] = cs[r - 1] + gg[r];
        *(LAS f32x2*)(SEG + w * 128 + 2 * lane) = cs[7];
        *(LAS u32x4*)(VT + (2 * lane) * 144 + w * 16) = pack_lo8(vv); *(LAS u32x4*)(VT + (2 * lane + 1) * 144 + w * 16) = pack_hi8(vv);
        WG_BAR();
        f32x2 pre = {0.f, 0.f}, tot = {0.f, 0.f};
#pragma unroll
        for (int j = 0; j < 8; ++j) { const f32x2 sg = *(const LAS f32x2*)(SEG + j * 128 + 2 * lane); tot += sg; if (j < w) pre += sg; }
        unsigned kt[8];
#pragma unroll
        for (int r = 0; r < 8; ++r) { const f32x2 bb = pre + cs[r];
            kt[r] = pk((1.f - __expf(gg[r].x)) * __expf(tot.x - bb.x), (1.f - __expf(gg[r].y)) * __expf(tot.y - bb.y)); }
        *(LAS u32x4*)(KT + (2 * lane) * 144 + w * 16) = pack_lo8(kt); *(LAS u32x4*)(KT + (2 * lane + 1) * 144 + w * 16) = pack_hi8(kt);
        if (w == 0) *(f32x2*)(dec + (size_t)unit * HD + 2 * lane) = (f32x2){__expf(tot.x), __expf(tot.y)};
        const int nu = unit + G;
        if (nu < NUNIT) {
            const int bh = nu >> 7, c = nu & 127, b = bh >> 2, h = bh & 3;
            const size_t m0 = (size_t)b * SEQ + c * CH + 8 * w; const int col = h * HD + 2 * lane;
#pragma unroll
            for (int r = 0; r < 8; ++r) { { const unsigned gw_ = *(const unsigned*)(g + (m0 + r) * HW + col); gg[r] = (f32x2){bflo(gw_), bfhi(gw_)}; } vv[r] = *(const unsigned*)(vb + (m0 + r) * HW + col); }
        }
        WG_BAR();
        bf16x8 yv[2];
#pragma unroll
        for (int ks = 0; ks < 2; ++ks) yv[ks] = *(const LAS bf16x8*)(VT + (16 * w + r16) * 144 + ks * 64 + q4 * 16);
        bf16* ut = UT + (size_t)unit * (HD * HD) + (size_t)(16 * w + r16) * HD + 4 * q4;
#pragma unroll
        for (int nb = 0; nb < 8; ++nb) {
            f32x4 a = {0.f, 0.f, 0.f, 0.f};
#pragma unroll
            for (int ks = 0; ks < 2; ++ks) { const bf16x8 xk = *(const LAS bf16x8*)(KT + (16 * nb + r16) * 144 + ks * 64 + q4 * 16); a = __builtin_amdgcn_mfma_f32_16x16x32_bf16(xk, yv[ks], a, 0, 0, 0); }
            *(u32x2*)(ut + 16 * nb) = (u32x2){pk(a[0], a[1]), pk(a[2], a[3])};
        }
        WG_BAR();
    }
}

__device__ __forceinline__ void phase_h2(bf16* UT, const float* dec, int G) {
    int tid = threadIdx.x; asm volatile("" : "+v"(tid));
    for (int e = blockIdx.x * NTHREADS + tid; e < NBH * HD * HD; e += G * NTHREADS) {
        const int bh = e >> 14, idx = e & 16383, k = idx & 127;
        bf16* up = UT + (size_t)bh * NCH * (HD * HD) + idx; const float* dp = dec + (size_t)bh * NCH * HD + k;
        float S = 0.f;
        for (int c0 = 0; c0 < NCH; c0 += 16) {
            bf16 uu[16]; float dd[16];
#pragma unroll
            for (int i = 0; i < 16; ++i) { uu[i] = up[(size_t)(c0 + i) * (HD * HD)]; dd[i] = dp[(size_t)(c0 + i) * HD]; }
#pragma unroll
            for (int i = 0; i < 16; ++i) { up[(size_t)(c0 + i) * (HD * HD)] = (bf16)(pk(S, 0.f) & 0xffffu); S = dd[i] * S + __uint_as_float((unsigned)uu[i] << 16); }
        }
    }
}

__device__ __forceinline__ void phase_h3(LAS unsigned char* lds, const bf16* qb, const bf16* g, const bf16* vb, const bf16* sob, const bf16* ST, const float* ng, bf16* hg, int G) {
    constexpr int SR = 272;
    int tid = threadIdx.x; asm volatile("" : "+v"(tid));
    const int lane = tid & 63, w = __builtin_amdgcn_readfirstlane(tid >> 6), r16 = lane & 15, q4 = lane >> 4;
    LAS unsigned char* QH = lds; LAS unsigned char* QD = lds + 17408; LAS unsigned char* KD = lds + 34816; LAS unsigned char* KE = lds + 52224; LAS unsigned char* QO = lds + 69632;
    LAS unsigned char* VT = lds + 95744; LAS float* SEG = (LAS float*)(lds + 114176); LAS float* RMS = (LAS float*)(lds + 118272);
    const int bi = w >> 1, odd = w & 1;
    f32x2 gg[8]; unsigned qq[8], vv[8];
    int unit = blockIdx.x;
    if (unit < NUNIT) {
        const int bh = unit >> 7, c = unit & 127, b = bh >> 2, h = bh & 3;
        const size_t m0 = (size_t)b * SEQ + c * CH + 8 * w; const int col = h * HD + 2 * lane;
#pragma unroll
        for (int r = 0; r < 8; ++r) { { const unsigned gw_ = *(const unsigned*)(g + (m0 + r) * HW + col); gg[r] = (f32x2){bflo(gw_), bfhi(gw_)}; } qq[r] = *(const unsigned*)(qb + (m0 + r) * HW + col); vv[r] = *(const unsigned*)(vb + (m0 + r) * HW + col); }
    }
    for (; unit < NUNIT; unit += G) {
        const int bh = unit >> 7, c = unit & 127, b = bh >> 2, h = bh & 3;
        const size_t mu = (size_t)b * SEQ + c * CH;
        const bf16* STu = ST + (size_t)unit * (HD * HD) + (size_t)(64 * odd + r16) * HD + q4 * 8;
        bf16x8 xs[4][4];
#pragma unroll
        for (int ks = 0; ks < 4; ++ks)
#pragma unroll
            for (int nb = 0; nb < 4; ++nb) xs[ks][nb] = *(const bf16x8*)(STu + (size_t)(16 * nb) * HD + ks * 32);
        const size_t row = mu + 16 * bi + r16;
        u32x2 sv[4]; f32x4 ngv[4];
#pragma unroll
        for (int nb = 0; nb < 4; ++nb) { const int v0 = 64 * odd + 16 * nb + 4 * q4; ngv[nb] = *(const f32x4*)(ng + v0); sv[nb] = *(const u32x2*)(sob + row * HW + h * HD + v0); }
        f32x2 cs[8]; cs[0] = gg[0];
#pragma unroll
        for (int r = 1; r < 8; ++r) cs[r] = cs[r - 1] + gg[r];
        *(LAS f32x2*)(SEG + w * 128 + 2 * lane) = cs[7];
        *(LAS u32x4*)(VT + (2 * lane) * 144 + w * 16) = pack_lo8(vv); *(LAS u32x4*)(VT + (2 * lane + 1) * 144 + w * 16) = pack_hi8(vv);
        WG_BAR();
        f32x2 pre = {0.f, 0.f};
        for (int j = 0; j < w; ++j) pre += *(const LAS f32x2*)(SEG + j * 128 + 2 * lane);
        const f32x2 cmid = *(const LAS f32x2*)(SEG + (2 * bi) * 128 + 2 * lane);
        const f32x2 bsum = cmid + *(const LAS f32x2*)(SEG + (2 * bi + 1) * 128 + 2 * lane);
        f32x2 bsm1 = {0.f, 0.f}, bsm2 = {0.f, 0.f};
        if (bi >= 1) bsm1 = *(const LAS f32x2*)(SEG + (2 * bi - 2) * 128 + 2 * lane) + *(const LAS f32x2*)(SEG + (2 * bi - 1) * 128 + 2 * lane);
        if (bi >= 2) bsm2 = bsm1 + *(const LAS f32x2*)(SEG + (2 * bi - 4) * 128 + 2 * lane) + *(const LAS f32x2*)(SEG + (2 * bi - 3) * 128 + 2 * lane);
        const f32x2 cbase = odd ? cmid : (f32x2){0.f, 0.f};
        const int pbase = (bi * (bi - 1)) / 2;
#pragma unroll
        for (int r = 0; r < 8; ++r) {
            const int t = 8 * w + r, tl = 8 * odd + r;
            const f32x2 cl = cbase + cs[r], bf = pre + cs[r];
            const float qx = bflo(qq[r]), qy = bfhi(qq[r]);
            const float kx = 1.f - __expf(gg[r].x), ky = 1.f - __expf(gg[r].y);
            *(LAS unsigned*)(QH + t * SR + 4 * lane) = pk(qx * __expf(bf.x), qy * __expf(bf.y));
            *(LAS unsigned*)(QD + t * SR + 4 * lane) = pk(qx * __expf(fminf(cl.x - cmid.x, 80.f)), qy * __expf(fminf(cl.y - cmid.y, 80.f)));
            *(LAS unsigned*)(KD + t * SR + 4 * lane) = pk(kx * __expf(fminf(cmid.x - cl.x, 80.f)), ky * __expf(fminf(cmid.y - cl.y, 80.f)));
            if (bi < 3) *(LAS unsigned*)(KE + t * SR + 4 * lane) = pk(kx * __expf(bsum.x - cl.x), ky * __expf(bsum.y - cl.y));
            if (bi >= 1) *(LAS unsigned*)(QO + ((pbase + bi - 1) * 16 + tl) * SR + 4 * lane) = pk(qx * __expf(cl.x), qy * __expf(cl.y));
            if (bi >= 2) *(LAS unsigned*)(QO + ((pbase + bi - 2) * 16 + tl) * SR + 4 * lane) = pk(qx * __expf(cl.x + bsm1.x), qy * __expf(cl.y + bsm1.y));
            if (bi >= 3) *(LAS unsigned*)(QO + ((pbase + 0) * 16 + tl) * SR + 4 * lane) = pk(qx * __expf(cl.x + bsm2.x), qy * __expf(cl.y + bsm2.y));
        }
        WG_BAR();
        { const int nu = unit + G;
          if (nu < NUNIT) {
            const int bh2 = nu >> 7, c2 = nu & 127, b2 = bh2 >> 2, h2 = bh2 & 3;
            const size_t m0 = (size_t)b2 * SEQ + c2 * CH + 8 * w; const int col = h2 * HD + 2 * lane;
#pragma unroll
            for (int r = 0; r < 8; ++r) { { const unsigned gw_ = *(const unsigned*)(g + (m0 + r) * HW + col); gg[r] = (f32x2){bflo(gw_), bfhi(gw_)}; } qq[r] = *(const unsigned*)(qb + (m0 + r) * HW + col); vv[r] = *(const unsigned*)(vb + (m0 + r) * HW + col); }
          } }
        const int i = bi, vh = odd;
        f32x4 acc[4];
#pragma unroll
        for (int nb = 0; nb < 4; ++nb) acc[nb] = (f32x4){0.f, 0.f, 0.f, 0.f};
#pragma unroll
        for (int ks = 0; ks < 4; ++ks) {
            const bf16x8 y = *(const LAS bf16x8*)(QH + (16 * i + r16) * SR + ks * 64 + q4 * 16);
#pragma unroll
            for (int nb = 0; nb < 4; ++nb) acc[nb] = __builtin_amdgcn_mfma_f32_16x16x32_bf16(xs[ks][nb], y, acc[nb], 0, 0, 0);
        }
#pragma unroll
        for (int jp = 0; jp < 2; ++jp) {
            if (2 * jp <= i) {
                f32x4 p[2];
#pragma unroll
                for (int jj = 0; jj < 2; ++jj) {
                    const int j = 2 * jp + jj;
                    p[jj] = (f32x4){0.f, 0.f, 0.f, 0.f};
                    if (j <= i) {
                        const LAS unsigned char* Kb = (j == i ? KD : KE) + (16 * j + r16) * SR + q4 * 16;
                        const LAS unsigned char* Qb = (j == i ? QD + (16 * i + r16) * SR : QO + ((pbase + j) * 16 + r16) * SR) + q4 * 16;
#pragma unroll
                        for (int ks = 0; ks < 4; ++ks) { const bf16x8 xk = *(const LAS bf16x8*)(Kb + ks * 64); const bf16x8 yq = *(const LAS bf16x8*)(Qb + ks * 64); p[jj] = __builtin_amdgcn_mfma_f32_16x16x32_bf16(xk, yq, p[jj], 0, 0, 0); }
                        if (j == i) {
#pragma unroll
                            for (int e = 0; e < 4; ++e) if (4 * q4 + e > r16) p[jj][e] = 0.f;
                        }
                    }
                }
                u32x4 ypw; ypw.x = pk(p[0][0], p[0][1]); ypw.y = pk(p[0][2], p[0][3]); ypw.z = pk(p[1][0], p[1][1]); ypw.w = pk(p[1][2], p[1][3]);
                const bf16x8 yp = __builtin_bit_cast(bf16x8, ypw);
#pragma unroll
                for (int nb = 0; nb < 4; ++nb) {
                    const LAS unsigned char* vp = VT + (64 * vh + 16 * nb + r16) * 144 + (32 * jp + 4 * q4) * 2;
                    const u32x2 lo = *(const LAS u32x2*)vp, hi = *(const LAS u32x2*)(vp + 32);
                    const u32x4 xw = {lo.x, lo.y, hi.x, hi.y};
                    acc[nb] = __builtin_amdgcn_mfma_f32_16x16x32_bf16(__builtin_bit_cast(bf16x8, xw), yp, acc[nb], 0, 0, 0);
                }
            }
        }
        float ss = 0.f;
#pragma unroll
        for (int nb = 0; nb < 4; ++nb) ss += (acc[nb][0] * acc[nb][0] + acc[nb][1] * acc[nb][1]) + (acc[nb][2] * acc[nb][2] + acc[nb][3] * acc[nb][3]);
        ss += __shfl_xor(ss, 16); ss += __shfl_xor(ss, 32);
        if (q4 == 0) RMS[(16 * i + r16) * 2 + vh] = ss;
        WG_BAR();
        const float rstd = rsqrtf((RMS[(16 * i + r16) * 2] + RMS[(16 * i + r16) * 2 + 1]) * (1.f / HD) + EPS);
#pragma unroll
        for (int nb = 0; nb < 4; ++nb) {
            const int v0 = 64 * vh + 16 * nb + 4 * q4;
            const f32x4 o = acc[nb] * rstd * ngv[nb];
            *(u32x2*)(hg + row * HW + h * HD + v0) = (u32x2){pk(o[0] * bflo(sv[nb].x), o[1] * bfhi(sv[nb].x)), pk(o[2] * bflo(sv[nb].y), o[3] * bfhi(sv[nb].y))};
        }
        WG_BAR();
    }
}

__device__ __forceinline__ f32x4 bf4(u32x2 v) { return (f32x4){bflo(v.x), bfhi(v.x), bflo(v.y), bfhi(v.y)}; }
__device__ __forceinline__ void ffn_fixup(int pm, const bf16* hbnd, const float* cw, const float* cb, bf16* act) {
    int tid = threadIdx.x; asm volatile("" : "+v"(tid));
    for (int idx = tid; idx < DFF / 4; idx += NTHREADS) {
        const int c4 = idx * 4;
        const f32x4 wv0 = *(const f32x4*)(cw + c4), wv1 = *(const f32x4*)(cw + NUP + c4), wv2 = *(const f32x4*)(cw + 2 * NUP + c4), bv = *(const f32x4*)(cb + c4);
        const f32x4 wg0 = *(const f32x4*)(cw + DFF + c4), wg1 = *(const f32x4*)(cw + NUP + DFF + c4), wg2 = *(const f32x4*)(cw + 2 * NUP + DFF + c4), bg = *(const f32x4*)(cb + DFF + c4);
        u32x2 hv[2][4], hg[2][4];
#pragma unroll
        for (int bb = 0; bb < 2; ++bb) {
            const int blk = 2 * pm + bb; const bool first = (blk & 63) == 0;
#pragma unroll
            for (int k = 0; k < 4; ++k) {
                const int sb = k < 2 ? blk - 1 : blk, slot = k < 2 ? k + 2 : k - 2;
                const bf16* p = hbnd + ((size_t)(sb * 4 + slot) * 2) * DFF + c4;
                if (k < 2 && first) { hv[bb][k] = (u32x2){0u, 0u}; hg[bb][k] = (u32x2){0u, 0u}; }
                else { hv[bb][k] = *(const u32x2*)p; hg[bb][k] = *(const u32x2*)(p + DFF); }
            }
        }
#pragma unroll
        for (int bb = 0; bb < 2; ++bb)
#pragma unroll
            for (int dl = 0; dl < 2; ++dl) {
                const f32x4 vc = wv2 * bf4(hv[bb][2 + dl]) + wv1 * bf4(hv[bb][1 + dl]) + wv0 * bf4(hv[bb][dl]) + bv;
                const f32x4 gc = wg2 * bf4(hg[bb][2 + dl]) + wg1 * bf4(hg[bb][1 + dl]) + wg0 * bf4(hg[bb][dl]) + bg;
                f32x4 a;
#pragma unroll
                for (int e = 0; e < 4; ++e) a[e] = vc[e] * silu(gc[e]);
                *(u32x2*)(act + ((size_t)(2 * pm + bb) * 128 + dl) * DFF + c4) = (u32x2){pk(a[0], a[1]), pk(a[2], a[3])};
            }
    }
}

__device__ __forceinline__ void phase_final(const bf16* xb, float* out, const float* ssq, const float* fg, int G) {
    int tid = threadIdx.x; asm volatile("" : "+v"(tid));
    const int lane = tid & 63, wave = tid >> 6;
    for (int m = blockIdx.x * NWAVES + wave; m < M; m += G * NWAVES) {
        const f32x4* sp = (const f32x4*)(ssq + (size_t)m * 16);
        const f32x4 s = (sp[0] + sp[1]) + (sp[2] + sp[3]);
        const float rstd = rsqrtf(((s[0] + s[1]) + (s[2] + s[3])) * (1.f / D) + EPS);
        const u32x4* xr = (const u32x4*)(xb + (size_t)m * D) + lane; f32x4* orow = (f32x4*)(out + (size_t)m * D) + 2 * lane; const f32x4* gr = (const f32x4*)fg + 2 * lane;
#pragma unroll
        for (int j = 0; j < 2; ++j) { const u32x4 w = xr[64 * j];
            orow[128 * j] = (f32x4){bflo(w.x), bfhi(w.x), bflo(w.y), bfhi(w.y)} * rstd * gr[128 * j];
            orow[128 * j + 1] = (f32x4){bflo(w.z), bfhi(w.z), bflo(w.w), bfhi(w.w)} * rstd * gr[128 * j + 1]; }
    }
}


#ifndef DEBUG_SCAN
#define DEBUG_SCAN 0
#endif
__device__ __forceinline__ void scan_bf16(const bf16* p, size_t n, int* flags, int code, int G) {
    int tid = threadIdx.x; asm volatile("" : "+v"(tid));
    const u32x4* q = (const u32x4*)p; const size_t n16 = n / 8; bool bad = false, huge = false;
    for (size_t i = (size_t)blockIdx.x * NTHREADS + tid; i < n16; i += (size_t)G * NTHREADS) { const u32x4 w = q[i];
#pragma unroll
        for (int e = 0; e < 4; ++e) { const unsigned x = w[e]; if ((x & 0x7f80u) == 0x7f80u || (x & 0x7f800000u) == 0x7f800000u) bad = true; if (fabsf(bflo(x)) > 1e4f || fabsf(bfhi(x)) > 1e4f) huge = true; } }
    if (bad) flags[code] = 1; if (huge) flags[64 + code] = 1;
}
__device__ __forceinline__ void scan_f32(const float* p, size_t n, int* flags, int code, int G) {
    int tid = threadIdx.x; asm volatile("" : "+v"(tid));
    bool bad = false, huge = false;
    for (size_t i = (size_t)blockIdx.x * NTHREADS + tid; i < n; i += (size_t)G * NTHREADS) { const unsigned x = __float_as_uint(p[i]); if ((x & 0x7f800000u) == 0x7f800000u) bad = true; if (fabsf(p[i]) > 1e4f) huge = true; }
    if (bad) flags[code] = 1; if (huge) flags[64 + code] = 1;
}
#define XB_TMO      128
#define XB_XCNT(j)  (256  + 64 * (j))
#define XB_XSUB(j)  (1280 + 64 * (j))
#define XB_XGEN(j)  (2304 + 64 * (j))
#define XB_TOP      3328
#define XB_TOPGEN   3392
#define XCD_BAR_WORDS 3456
#define XB_SPIN_CAP (1u << 18)

__device__ __forceinline__ unsigned xb_ld(unsigned* p)              { return __hip_atomic_load(p, __ATOMIC_RELAXED, __HIP_MEMORY_SCOPE_AGENT); }
__device__ __forceinline__ unsigned xb_add(unsigned* p, unsigned v) { return __hip_atomic_fetch_add(p, v, __ATOMIC_RELAXED, __HIP_MEMORY_SCOPE_AGENT); }
__device__ __forceinline__ unsigned xb_xcc_id() { return (unsigned)__builtin_amdgcn_s_getreg((3 << 11) | 20) & 0xFu; }
#define XB_SPIN(cond, bar) do { unsigned _sp = 0; while (cond) { __builtin_amdgcn_s_sleep(1); \
    if ((++_sp & 255u) == 0u) { if (xb_ld(&(bar)[XB_TMO])) break; if (_sp > XB_SPIN_CAP) { atomicAdd(&(bar)[XB_TMO], 1u); break; } } } } while (0)

struct XcdBarrier {
    unsigned* bar; unsigned x;
    volatile LAS unsigned* st;
};

__device__ __forceinline__ XcdBarrier xcd_barrier_post(unsigned* bar, volatile LAS unsigned* st) {
    XcdBarrier b; b.bar = bar; b.x = xb_xcc_id(); b.st = st;
    if (threadIdx.x == 0) (void)xb_add(&bar[XB_XCNT(b.x)], 1u);
    return b;
}
__device__ __forceinline__ void xcd_barrier_complete(unsigned* bar, unsigned x, unsigned& nloc, unsigned& nx) {
    const unsigned G = gridDim.x * gridDim.y * gridDim.z;
    unsigned sum, cnt, mine, sp = 0u;
    for (;;) {
        sum = 0u; cnt = 0u; mine = 0u;
#pragma unroll
        for (unsigned j = 0; j < 16; ++j) { const unsigned c = xb_ld(&bar[XB_XCNT(j)]); sum += c; cnt += (c > 0u) ? 1u : 0u; mine = (j == x) ? c : mine; }
        if (sum == G) break;
        __builtin_amdgcn_s_sleep(1);
        if ((++sp & 255u) == 0u) { if (xb_ld(&bar[XB_TMO])) break; if (sp > XB_SPIN_CAP) { atomicAdd(&bar[XB_TMO], 1u); break; } }
    }
    nloc = mine > 0u ? mine : 1u; nx = cnt > 0u ? cnt : 1u;
}

__device__ __forceinline__ void xcd_barrier(const XcdBarrier& b) {
    asm volatile("s_waitcnt vmcnt(0)" ::: "memory");
    __syncthreads();
    if (threadIdx.x == 0) {
        unsigned* bar = b.bar;
        __builtin_amdgcn_s_waitcnt(0);
        unsigned nloc = b.st[0], nx = b.st[1];
        if (nloc == 0u) { xcd_barrier_complete(bar, b.x, nloc, nx); b.st[0] = nloc; b.st[1] = nx; }
        const unsigned old = xb_add(&bar[XB_XSUB(b.x)], 1u);
        const unsigned gen = old / nloc;
        if (old + 1u == (gen + 1u) * nloc) {
            __builtin_amdgcn_fence(__ATOMIC_RELEASE, "agent");
            asm volatile("s_waitcnt vmcnt(0)" ::: "memory");
            const unsigned og = xb_add(&bar[XB_TOP], 1u);
            const unsigned tg = og / nx;
            if (og + 1u == (tg + 1u) * nx) xb_add(&bar[XB_TOPGEN], 1u);
            else XB_SPIN(xb_ld(&bar[XB_TOPGEN]) == tg, bar);
            __builtin_amdgcn_fence(__ATOMIC_ACQUIRE, "agent");
            xb_add(&bar[XB_XGEN(b.x)], 1u);
            asm volatile("s_waitcnt vmcnt(0)" ::: "memory");
        } else {
            XB_SPIN(xb_ld(&bar[XB_XGEN(b.x)]) == gen, bar);
            __builtin_amdgcn_fence(__ATOMIC_ACQUIRE, "agent");
            asm volatile("s_waitcnt vmcnt(0)" ::: "memory");
        }
    }
    __syncthreads();
}

#ifndef ONE_LAUNCH
#define ONE_LAUNCH 1
#endif
constexpr int PH_PER_LAYER = 9, N_PHASES = 1 + DEPTH * PH_PER_LAYER + 1;

__global__ void __launch_bounds__(NTHREADS, 2) trunk_fwd(Args args) {
    extern __shared__ __attribute__((aligned(16))) unsigned char lds_raw[];
    LAS unsigned char* lds = (LAS unsigned char*)lds_raw;
    cg::grid_group grid = cg::this_grid();
    const int G = gridDim.x;
    unsigned char* ws = args.ws;
    float* out = args.out;
    const int lo = args.ph_lo, hi = args.ph_hi;
    float* ssq = (float*)(ws + WS_SSQ); float* dec = (float*)(ws + WS_DEC); bf16* hbnd = (bf16*)(ws + WS_HBND); bf16* xb = (bf16*)(ws + WS_XB);
    bf16 *ub = (bf16*)(ws + WS_U), *hgb = (bf16*)(ws + WS_HG), *qb = (bf16*)(ws + WS_Q), *vb = (bf16*)(ws + WS_V), *sob = (bf16*)(ws + WS_SO), *pooled = (bf16*)(ws + WS_POOL);
    bf16 *UT = (bf16*)(ws + WS_UT), *gates = (bf16*)(ws + WS_GATES), *merged = (bf16*)(ws + WS_MERGED), *act = (bf16*)(ws + WS_ACT);
    bf16* gl = (bf16*)(ws + WS_G);
#ifndef PHASE_MASK
#define PHASE_MASK 0xfff
#endif
#define EN(j) (((PHASE_MASK) >> (j)) & 1)
#define IN(k) (lo <= (k) && (k) < hi)
#define SC(k) (DEBUG_SCAN && lo == (k) && hi == (k) - 1)
    volatile LAS unsigned* MISC = (volatile LAS unsigned*)(lds + 131072 + 512);
    { int t_ = threadIdx.x; asm volatile("" : "+v"(t_)); if (t_ < 32) MISC[t_] = 0u; }
    __syncthreads();
    XcdBarrier bar = xcd_barrier_post((unsigned*)(ws + WS_BAR), MISC + 8);
#ifndef PROBE_A
#define PROBE_A -1
#define PROBE_B -1
#endif
    unsigned long long* tsb = (unsigned long long*)(ws + 4096);
#define STAMP(k) do { if (PROBE_A >= 0 && blockIdx.x == 0) { int t_ = threadIdx.x; asm volatile("" : "+v"(t_)); if (t_ == 0) tsb[(k)] = __builtin_amdgcn_s_memrealtime(); } } while (0)
#define SEAM(k) do { if (IN(k) && IN((k) + 1)) { if (hi > 1000000) grid.sync();   xcd_barrier(bar); } STAMP((k) + 1); } while (0)
    STAMP(0);

    int* dbg = (int*)ws;
    static_assert(DEPTH == 2, "the lazy weight-copy schedule below is written for two layers");
    const bool lazy = (G == 256) && lo == 0 && hi == N_PHASES;
    if (EN(9) && IN(0)) { if (DEBUG_SCAN && blockIdx.x == 0) { int t_ = threadIdx.x; asm volatile("" : "+v"(t_)); if (t_ < 128) dbg[t_] = 0; } phase_prologue(args, lds, G, lazy); }
    SEAM(0);
    for (int l = 0; l < DEPTH; ++l) {
        const int pb = 1 + l * PH_PER_LAYER;
        unsigned char* wl = ws + WS_W + (size_t)l * W_LAYER;
        const bf16* Win = (const bf16*)(wl + WO_IN);
        if (EN(0) && IN(pb + 0)) {
            pg8::Gemm g{xb, Win, M, NMIX, D}; pg8::StaticOrder S; S.init(M, NMIX, G, (int)blockIdx.x);
            EpiInMix E{ub, qb, vb, sob, gl, ssq, (const float*)(ws + WS_LB) + l * HW, gates, args.in[3] + l * NGATE, 0};
            pg8::gemm_phase<EpiInMix, pg8::StaticOrder, true, true>(lds, g, S, E);
            if (lazy && l == 0 && blockIdx.x >= 128) {
                convert_items(args, lds, I_IN, I_LAYER, (int)blockIdx.x - 128, 128);
                fold_pool(args, lds, 0, 1, (int)blockIdx.x - 128, 128);
            }
            if (lazy && l == 1 && blockIdx.x >= 128)
                convert_items(args, lds, I_LAYER + I_IN + I_PB + I_O, 2 * I_LAYER, (int)blockIdx.x - 128, 128);
        }
        SEAM(pb + 0);
        if (SC(pb + 1)) { const int cb_ = 20 * l; scan_bf16(ub, (size_t)M * 512, dbg, cb_ + 1, G); scan_bf16(qb, (size_t)M * 512, dbg, cb_ + 2, G); scan_bf16(vb, (size_t)M * 512, dbg, cb_ + 3, G); scan_bf16(sob, (size_t)M * 512, dbg, cb_ + 4, G); scan_bf16(gl, (size_t)M * 512, dbg, cb_ + 5, G); }
        if (EN(1) && IN(pb + 1)) { phase_fir(ub, pooled, G); phase_h1(lds, gl, vb, UT, dec, G); }
        SEAM(pb + 1);
        if (SC(pb + 2)) { const int cb_ = 20 * l; scan_bf16(pooled, (size_t)M * 512, dbg, cb_ + 6, G); scan_bf16(UT, (size_t)NUNIT * 16384, dbg, cb_ + 7, G); scan_f32(dec, (size_t)NUNIT * 128, dbg, cb_ + 8, G); }
        if (EN(2) && IN(pb + 2)) phase_h2(UT, dec, G);
        SEAM(pb + 2);
        if (SC(pb + 3)) { scan_bf16(UT, (size_t)NUNIT * 16384, dbg, 20 * l + 9, G); }
        if (EN(3) && IN(pb + 3)) phase_h3(lds, qb, gl, vb, sob, UT, args.in[7] + l * HD, hgb, G);
        SEAM(pb + 3);
        if (SC(pb + 4)) { scan_bf16(gates, (size_t)M * 2048, dbg, 20 * l + 11, G); }
        if (EN(4) && IN(pb + 4)) {
            pg8::Gemm g{xb, Win + (size_t)NMIX * D, M, NGATE, D}; GateOrder S; S.S.init(M, D, G, (int)blockIdx.x);
            EpiInMix E{ub, qb, vb, sob, gl, ssq, (const float*)(ws + WS_LB) + l * HW, gates, args.in[3] + l * NGATE, 10};
            pg8::gemm_phase<EpiInMix, GateOrder, true, true>(lds, g, S, E);
            VM_WAIT(); __syncthreads();
        }
        if (IN(pb + 4) != IN(pb + 5)) SEAM(pb + 4);
        if (EN(5) && IN(pb + 5)) {
            { pg8::Gemm g{pooled, (const bf16*)(wl + WO_A), M, D, PW}; pg8::StaticOrder S; S.init(M, D, G, (int)blockIdx.x);
              EpiMerge<false> E{merged, gates};
              pg8::gemm_phase<EpiMerge<false>, pg8::StaticOrder, true, true>(lds, g, S, E); }
            VM_WAIT(); __syncthreads();
            { pg8::Gemm g{hgb, (const bf16*)(wl + WO_PB), M, D, HW}; pg8::StaticOrder S; S.init(M, D, G, (int)blockIdx.x);
              EpiMerge<true> E{merged, gates};
              pg8::gemm_phase<EpiMerge<true>, pg8::StaticOrder, true, true>(lds, g, S, E); }
        }
        SEAM(pb + 5);
        if (SC(pb + 6)) { scan_bf16(merged, (size_t)M * 1024, dbg, 20 * l + 12, G); }
        if (EN(6) && IN(pb + 6)) {
            pg8::Gemm g{merged, (const bf16*)(wl + WO_O), M, D, D}; pg8::StaticOrder S; S.init(M, D, G, (int)blockIdx.x);
            EpiRes<false> E{out, xb, ssq};
            pg8::gemm_phase<EpiRes<false>, pg8::StaticOrder, true, true>(lds, g, S, E);
        }
        SEAM(pb + 6);
        if (SC(pb + 7)) { scan_f32(out, (size_t)M * 1024, dbg, 20 * l + 13, G); scan_bf16(xb, (size_t)M * 1024, dbg, 20 * l + 14, G); scan_f32(ssq, (size_t)M * 16, dbg, 20 * l + 15, G); }
        if (EN(7) && IN(pb + 7)) {
            pg8::Gemm g{xb, (const bf16*)(wl + WO_UP), M, NUP, D}; pg8::StaticOrder S; S.init(M, NUP, G, (int)blockIdx.x);
            EpiUpConv E{act, hbnd, ssq, args.in[13] + (size_t)l * 3 * NUP, args.in[14] + (size_t)l * NUP};
            pg8::gemm_phase<EpiUpConv, pg8::StaticOrder, true, true, true>(lds, g, S, E);
            if (lazy && l == 0 && blockIdx.x >= 128) {
                convert_items(args, lds, I_LAYER, I_LAYER + I_IN + I_PB + I_O, (int)blockIdx.x - 128, 128);
                fold_pool(args, lds, 1, 2, (int)blockIdx.x - 128, 128);
            }
        }
        SEAM(pb + 7);
        if (SC(pb + 8)) { scan_bf16(act, (size_t)M * DFF, dbg, 20 * l + 16, G); scan_bf16(hbnd, (size_t)128 * 4 * 2 * DFF, dbg, 20 * l + 17, G); }
        if (EN(8) && IN(pb + 8)) {
            pg8::StaticOrder S; S.init(M, D, G, (int)blockIdx.x);
            pg8::Unit un;
            for (int i = 0; S.next(i, un); ++i) ffn_fixup(un.pm, hbnd, args.in[13] + (size_t)l * 3 * NUP, args.in[14] + (size_t)l * NUP, act);
            VM_WAIT(); __syncthreads();
            pg8::Gemm g{act, (const bf16*)(wl + WO_DN), M, D, DFF};
            EpiRes<false> E{out, xb, ssq}; pg8::gemm_phase<EpiRes<false>, pg8::StaticOrder, true, true>(lds, g, S, E);
        }
        SEAM(pb + 8);
    }
    if (SC(N_PHASES - 1)) {
        scan_f32(out, (size_t)M * 1024, dbg, 58, G); scan_f32(ssq, (size_t)M * 16, dbg, 59, G);
        __syncthreads();
    }
    if (EN(10) && IN(N_PHASES - 1)) phase_final(xb, out, ssq, args.in[16], G);
    if (DEBUG_SCAN && IN(N_PHASES)) {
        int t_ = threadIdx.x; asm volatile("" : "+v"(t_));
        int c1 = -1, c2 = -1; for (int i = 63; i >= 0; --i) { if (dbg[i]) c1 = i; if (dbg[64 + i]) c2 = i; }
        const float cval = 100.f * (float)(c2 + 2);
        for (size_t i = (size_t)blockIdx.x * NTHREADS + t_; i < (size_t)M * D; i += (size_t)G * NTHREADS) out[i] = (i == 0) ? 1e4f * (float)(c1 + 1) : cval;
    }
    if (PROBE_A >= 0 && blockIdx.x == 0) {
        int t_ = threadIdx.x; asm volatile("" : "+v"(t_));
        if (t_ == 0) {
            STAMP(N_PHASES);
            __builtin_amdgcn_fence(__ATOMIC_ACQ_REL, "agent");
            const unsigned long long da = tsb[PROBE_A + 1] - tsb[PROBE_A], db = PROBE_B >= 0 ? tsb[PROBE_B + 1] - tsb[PROBE_B] : 0ull;
            const unsigned long long spin = 4ull * da + 204800ull * (db / 3200ull);
            const unsigned long long t0 = __builtin_amdgcn_s_memrealtime();
            while (__builtin_amdgcn_s_memrealtime() - t0 < spin) __builtin_amdgcn_s_sleep(32);
        }
    }
#undef IN
#undef SEAM
}

extern "C" void kernel_launch(void* const* d_in, const int* in_sizes, int n_in, void* d_out, int out_size, void* d_ws, size_t ws_size, hipStream_t stream) {
    static int grid = 0;
    if (grid == 0) {
        if (n_in != 17 || in_sizes[0] != M * D || out_size != M * D || ws_size < WS_END) { fprintf(stderr, "kernel_launch: unexpected shapes (n_in %d, in0 %d, out %d, ws %zu)\n", n_in, n_in > 0 ? in_sizes[0] : -1, out_size, ws_size); grid = -1; return; }
        int dev = 0, cus = 0, per_cu = 0;
        hipGetDevice(&dev); hipDeviceGetAttribute(&cus, hipDeviceAttributeMultiprocessorCount, dev);
        if (hipFuncSetAttribute((const void*)trunk_fwd, hipFuncAttributeMaxDynamicSharedMemorySize, LDS_BYTES) != hipSuccess) { fprintf(stderr, "kernel_launch: hipFuncSetAttribute failed\n"); grid = -1; return; }
        if (hipOccupancyMaxActiveBlocksPerMultiprocessor(&per_cu, (const void*)trunk_fwd, NTHREADS, LDS_BYTES) != hipSuccess || per_cu < 1) { fprintf(stderr, "kernel_launch: occupancy query says %d\n", per_cu); per_cu = 1; }
        (void)hipGetLastError();
        grid = cus * 1;
        fprintf(stderr, "kernel_launch: grid %d (cus %d, per_cu %d)\n", grid, cus, per_cu);
    }
    if (grid < 0) return;
    Args a{};
    for (int i = 0; i < 17; ++i) a.in[i] = (const float*)d_in[i];
    a.out = (float*)d_out; a.ws = (unsigned char*)d_ws;
#if ONE_LAUNCH
    if (hipMemsetAsync((char*)d_ws + WS_BAR, 0, BAR_BYTES, stream) != hipSuccess) { fprintf(stderr, "kernel_launch: memset failed\n"); return; }
    a.ph_lo = 0; a.ph_hi = N_PHASES;
    void* kargs[] = {&a};
    hipError_t e = hipLaunchCooperativeKernel((const void*)trunk_fwd, dim3(grid), dim3(NTHREADS), kargs, LDS_BYTES, stream);
    if (e != hipSuccess) fprintf(stderr, "kernel_launch: cooperative launch failed: %s (grid %d)\n", hipGetErrorString(e), grid);
#else
    for (int p = 0; p < N_PHASES + (DEBUG_SCAN ? 1 : 0); ++p) {
        if (DEBUG_SCAN && p > 0 && p < N_PHASES) { a.ph_lo = p; a.ph_hi = p - 1; hipLaunchKernelGGL(trunk_fwd, dim3(grid), dim3(NTHREADS), LDS_BYTES, stream, a); }
        a.ph_lo = p; a.ph_hi = p + 1;
        hipLaunchKernelGGL(trunk_fwd, dim3(grid), dim3(NTHREADS), LDS_BYTES, stream, a);
    }
#endif
}
```

```cpp
#include <hip/hip_runtime.h>
#include <hip/hip_cooperative_groups.h>
#include <cstdio>
#include <cstdint>
namespace cg = cooperative_groups;
namespace pg8 {
#define PG8_LAS __attribute__((address_space(3)))
typedef unsigned short bf16_t;
typedef short bf16x8 __attribute__((ext_vector_type(8)));
typedef float f32x4 __attribute__((ext_vector_type(4)));
typedef unsigned u32x4 __attribute__((ext_vector_type(4)));
constexpr int BM = 256, BK = 64, HALF = 128, HTB = HALF * BK * 2  , STAGE_BYTES = 8 * HTB, NXCD = 8, WGM = 8;

__host__ __device__ __forceinline__ int lds_byte(int r, int c) { const int st = (r >> 4) * 2 + (c >> 5), rr = r & 15, cc = c & 31, ob = rr * 64 + cc * 2; return st * 1024 + (ob ^ (((ob >> 9) & 1) << 5)); }
__host__ __device__ __forceinline__ void stage_rc(int b, int& R, int& C) { const int st = b / 1024, sb = b % 1024, swz = sb ^ (((sb >> 9) & 1) << 5); R = (st >> 1) * 16 + swz / 64; C = (st & 1) * 32 + (swz % 64) / 2; }
__host__ __device__ __forceinline__ int perm32(int rho) { const int n = rho >> 4, i = rho & 15; return 8 * (i >> 2) + 4 * n + (i & 3); }

struct Unit { int pm, pn; };
struct Gemm { const bf16_t* A; const bf16_t* Bt; int M, N, K; };

struct StaticOrder {
    int nM, nN, nwg, G, c;
    __host__ __device__ void init(int M, int N, int G_, int c_) { nM = M / BM; nN = N / BM; nwg = nM * nN; G = G_; c = c_; }
    __host__ __device__ bool next(int i, Unit& u) const {
        const long L = (long)i * G + c; if (L >= nwg) return false;
        int wgid = (int)L; { const int q = nwg / NXCD, r = nwg % NXCD, xcd = wgid % NXCD, off = wgid / NXCD; wgid = (xcd < r ? xcd * (q + 1) : r * (q + 1) + (xcd - r) * q) + off; }
        const int nig = WGM * nN, gid = wgid / nig, fm = gid * WGM, gsz = (nM - fm) < WGM ? (nM - fm) : WGM;
        u.pm = fm + ((wgid % nig) % gsz); u.pn = (wgid % nig) / gsz; return true;
    }
    __device__ __forceinline__ void a_ready(const Unit&) const {}
    __device__ __forceinline__ void done(const Unit&) const {}
};

__device__ __forceinline__ unsigned cvt_pk_bf16(float lo, float hi) { unsigned r; asm volatile("v_cvt_pk_bf16_f32 %0, %1, %2" : "=v"(r) : "v"(lo), "v"(hi)); return r; }
typedef float f32x2 __attribute__((ext_vector_type(2)));
template <class Epi, class Sched, bool ALIGN_EPI = false, bool SP2 = false, bool ROWPERM = false>
__device__ __forceinline__ void gemm_phase(PG8_LAS unsigned char* lds, const Gemm g, const Sched& S, const Epi& E) {
    int tid = threadIdx.x; asm volatile("" : "+v"(tid));
    const int wid = __builtin_amdgcn_readfirstlane(tid >> 6), lane = tid & 63, wr = wid >> 2, wc = wid & 3, fr = lane & 15, fq = lane >> 4;
    const int K = g.K, nt = K / BK;
    unsigned voffA[2], voffB[2];
#pragma unroll
    for (int i = 0; i < 2; ++i) { int R, C; stage_rc(tid * 16 + i * 8192, R, C); const int Rb = Epi::PERM ? ((R & ~31) + perm32(R & 31)) : R;
        const int Ra = ROWPERM ? (128 * (R >> 6) + 8 * (R & 15) + ((R >> 4) & 3)) : R;
        voffA[i] = (unsigned)(Ra * K + C) * 2u; voffB[i] = (unsigned)(Rb * K + C) * 2u; }
    const size_t kstep = (size_t)(BK * 2);
    const size_t hstep = (size_t)HALF * K * 2;
    const size_t hstepA = ROWPERM ? (size_t)4 * K * 2 : hstep;
    const size_t tstep = 2 * hstep;
    const unsigned ldsw = (unsigned)wid * 1024u;
    const int aoff = lds_byte(wr * 64 + fr, fq * 8), boff = lds_byte(wc * 32 + fr, fq * 8);
#define PG8_SA(b, h) (((b) * 2 + (h)) * HTB)
#define PG8_SB(b, h) ((4 + (b) * 2 + (h)) * HTB)
#define PG8_STAGE(bufoff, gbase, voff) do { _Pragma("unroll") for (int _i = 0; _i < 2; ++_i) \
        __builtin_amdgcn_global_load_lds((const unsigned*)((const char*)(gbase) + (voff)[_i]), (PG8_LAS unsigned*)(lds + (bufoff) + ldsw + _i * 8192), 16, 0, 0); } while (0)
#define PG8_LDA(dst, b, h) do { _Pragma("unroll") for (int m = 0; m < 4; ++m) _Pragma("unroll") for (int k = 0; k < 2; ++k) dst[m][k] = *(const PG8_LAS bf16x8*)(lds + PG8_SA(b, h) + aoff + m * 2048 + k * 1024); } while (0)
#define PG8_LDB(dst, b, h) do { _Pragma("unroll") for (int n = 0; n < 2; ++n) _Pragma("unroll") for (int k = 0; k < 2; ++k) dst[n][k] = *(const PG8_LAS bf16x8*)(lds + PG8_SB(b, h) + boff + n * 2048 + k * 1024); } while (0)
#define PG8_MMA(ai, bj, At, Bt) do { __builtin_amdgcn_s_setprio(1); _Pragma("unroll") for (int m = 0; m < 4; ++m) _Pragma("unroll") for (int n = 0; n < 2; ++n) _Pragma("unroll") for (int k = 0; k < 2; ++k) \
        acc[ai][bj][m][n] = __builtin_amdgcn_mfma_f32_16x16x32_bf16(Bt[n][k], At[m][k], acc[ai][bj][m][n], 0, 0, 0); __builtin_amdgcn_s_setprio(0); } while (0)
#define PG8_WAIT_V(n) asm volatile("s_waitcnt vmcnt(" #n ")" ::: "memory")
#define PG8_WAIT_L(n) asm volatile("s_waitcnt lgkmcnt(" #n ")" ::: "memory")
#define PG8_BAR __builtin_amdgcn_s_barrier()
#define PG8_SCHED __builtin_amdgcn_sched_barrier(0)
    Unit cur, nxt; int ui = 0;
    if (!S.next(0, cur)) return;
    f32x4 acc[2][2][4][2];
#pragma unroll
    for (int a = 0; a < 2; ++a)
#pragma unroll
        for (int b = 0; b < 2; ++b)
#pragma unroll
            for (int m = 0; m < 4; ++m)
#pragma unroll
                for (int n = 0; n < 2; ++n) acc[a][b][m][n] = (f32x4){0.f, 0.f, 0.f, 0.f};
    bf16x8 At[4][2], B0[2][2], B1[2][2];
    const char* cA = (const char*)g.A + (size_t)cur.pm * tstep; const char* cB = (const char*)g.Bt + (size_t)cur.pn * tstep;
    S.a_ready(cur);
    if constexpr (SP2) {
        PG8_STAGE(PG8_SB(0, 0), cB, voffB); PG8_STAGE(PG8_SB(0, 1), cB + hstep, voffB); PG8_STAGE(PG8_SA(0, 0), cA, voffA); PG8_STAGE(PG8_SA(0, 1), cA + hstepA, voffA);
        if (wr == 1) PG8_BAR;
        PG8_WAIT_V(2); PG8_BAR;
        PG8_STAGE(PG8_SB(1, 0), cB + kstep, voffB); PG8_STAGE(PG8_SA(1, 0), cA + kstep, voffA); PG8_STAGE(PG8_SB(1, 1), cB + hstep + kstep, voffB);
        PG8_WAIT_V(6); PG8_BAR;
    } else {
        PG8_STAGE(PG8_SB(0, 0), cB, voffB); PG8_STAGE(PG8_SA(0, 0), cA, voffA); PG8_STAGE(PG8_SB(0, 1), cB + hstep, voffB); PG8_STAGE(PG8_SA(0, 1), cA + hstepA, voffA);
        if (wr == 1) PG8_BAR;
        PG8_WAIT_V(4); PG8_BAR;
        PG8_STAGE(PG8_SB(1, 0), cB + kstep, voffB); PG8_STAGE(PG8_SA(1, 0), cA + kstep, voffA); PG8_STAGE(PG8_SB(1, 1), cB + hstep + kstep, voffB);
        PG8_WAIT_V(6); PG8_BAR;
    }
    for (;;) {
        const bool has_next = S.next(ui + 1, nxt);
        const char* nA = has_next ? (const char*)g.A + (size_t)nxt.pm * tstep : cA; const char* nB = has_next ? (const char*)g.Bt + (size_t)nxt.pn * tstep : cB;
        for (int t = 0; t < nt; t += 2) {
            const bool last = (t == nt - 2);
            const char* a1 = cA + (size_t)(t + 1) * kstep;
            const char* a2 = last ? nA : cA + (size_t)(t + 2) * kstep; const char* b2 = last ? nB : cB + (size_t)(t + 2) * kstep;
            const char* a3 = a2 + kstep; const char* b3 = b2 + kstep;
            if (last && has_next) S.a_ready(nxt);
            if constexpr (SP2) {
            PG8_LDB(B0, 0, 0); PG8_LDB(B1, 0, 1); PG8_SCHED; PG8_LDA(At, 0, 0); PG8_STAGE(PG8_SA(1, 1), a1 + hstepA, voffA);
            PG8_WAIT_V(8); PG8_WAIT_L(0); PG8_BAR; PG8_MMA(0, 0, At, B0); PG8_MMA(0, 1, At, B1); PG8_BAR; PG8_SCHED;
            PG8_LDA(At, 0, 1); PG8_STAGE(PG8_SB(0, 0), b2, voffB); PG8_STAGE(PG8_SB(0, 1), b2 + hstep, voffB); PG8_STAGE(PG8_SA(0, 0), a2, voffA);
            PG8_WAIT_V(8); PG8_WAIT_L(0); PG8_BAR; PG8_MMA(1, 0, At, B0); PG8_MMA(1, 1, At, B1); PG8_BAR; PG8_SCHED;
            PG8_LDB(B0, 1, 0); PG8_LDB(B1, 1, 1); PG8_SCHED; PG8_LDA(At, 1, 0); PG8_STAGE(PG8_SA(0, 1), a2 + hstepA, voffA);
            PG8_WAIT_V(8); PG8_WAIT_L(0); PG8_BAR; PG8_MMA(0, 0, At, B0); PG8_MMA(0, 1, At, B1); PG8_BAR; PG8_SCHED;
            PG8_LDA(At, 1, 1); PG8_STAGE(PG8_SB(1, 0), b3, voffB); PG8_STAGE(PG8_SB(1, 1), b3 + hstep, voffB); PG8_STAGE(PG8_SA(1, 0), a3, voffA);
            PG8_WAIT_V(8); PG8_WAIT_L(0); PG8_BAR; PG8_MMA(1, 0, At, B0); PG8_MMA(1, 1, At, B1); PG8_BAR; PG8_SCHED;
            } else {
            PG8_LDB(B0, 0, 0); PG8_SCHED; PG8_LDA(At, 0, 0); PG8_STAGE(PG8_SA(1, 1), a1 + hstepA, voffA);
            PG8_WAIT_L(8); PG8_BAR; PG8_WAIT_L(0); PG8_MMA(0, 0, At, B0); PG8_BAR; PG8_SCHED;
            PG8_LDB(B1, 0, 1); PG8_STAGE(PG8_SB(0, 0), b2, voffB);
            PG8_BAR; PG8_WAIT_L(0); PG8_MMA(0, 1, At, B1); PG8_BAR;
            PG8_LDA(At, 0, 1); PG8_STAGE(PG8_SA(0, 0), a2, voffA);
            PG8_BAR; PG8_WAIT_L(0); PG8_MMA(1, 0, At, B0); PG8_BAR; PG8_SCHED;
            PG8_STAGE(PG8_SB(0, 1), b2 + hstep, voffB);
            PG8_WAIT_V(6); PG8_BAR; PG8_MMA(1, 1, At, B1); PG8_BAR;
            PG8_LDB(B0, 1, 0); PG8_SCHED; PG8_LDA(At, 1, 0); PG8_STAGE(PG8_SA(0, 1), a2 + hstepA, voffA);
            PG8_WAIT_L(8); PG8_BAR; PG8_WAIT_L(0); PG8_MMA(0, 0, At, B0); PG8_BAR; PG8_SCHED;
            PG8_LDB(B1, 1, 1); PG8_STAGE(PG8_SB(1, 0), b3, voffB);
            PG8_BAR; PG8_WAIT_L(0); PG8_MMA(0, 1, At, B1); PG8_BAR;
            PG8_LDA(At, 1, 1); PG8_STAGE(PG8_SA(1, 0), a3, voffA);
            PG8_BAR; PG8_WAIT_L(0); PG8_MMA(1, 0, At, B0); PG8_BAR; PG8_SCHED;
            PG8_STAGE(PG8_SB(1, 1), b3 + hstep, voffB);
            PG8_WAIT_V(6); PG8_BAR; PG8_MMA(1, 1, At, B1); PG8_BAR;
            }
        }
        if constexpr (ALIGN_EPI) { if (wr == 0) PG8_BAR; }
        if constexpr (!Epi::AFTER_DRAIN) { E(acc, cur, wr, wc, fr, fq); S.done(cur); }
        if (!has_next) break;
#pragma unroll
        for (int a = 0; a < 2; ++a)
#pragma unroll
            for (int b = 0; b < 2; ++b)
#pragma unroll
                for (int m = 0; m < 4; ++m)
#pragma unroll
                    for (int n = 0; n < 2; ++n) acc[a][b][m][n] = (f32x4){0.f, 0.f, 0.f, 0.f};
        cur = nxt; cA = nA; cB = nB; ++ui;
        if constexpr (ALIGN_EPI) { if (wr == 1) PG8_BAR; }
    }
    PG8_WAIT_V(0);
    if constexpr (!ALIGN_EPI) { if (wr == 0) PG8_BAR; }
    PG8_BAR;
    if constexpr (Epi::AFTER_DRAIN) { E.fused(acc, cur, wr, wc, fr, fq, lds, wid, lane); S.done(cur); }
#undef PG8_SA
#undef PG8_SB
#undef PG8_STAGE
#undef PG8_LDA
#undef PG8_LDB
#undef PG8_MMA
#undef PG8_WAIT_V
#undef PG8_WAIT_L
#undef PG8_BAR
#undef PG8_SCHED
}
}

constexpr int BATCH = 2, SEQ = 8192, D = 1024, M = BATCH * SEQ, DEPTH = 2;
constexpr int PW = 512, HW = 512, NH = 4, HD = 128, CH = 64, NCH = SEQ / CH, NBH = BATCH * NH, NUNIT = NBH * NCH;
constexpr int IN_COLS = 4608, NMIX = 2560, NGATE = 2048, DFF = 2816, NUP = 2 * DFF;
constexpr float EPS = 1e-6f;
constexpr int NWAVES = 8, NTHREADS = 512;
constexpr int LDS_BYTES = 147456;

constexpr size_t MiB = 1u << 20;
constexpr size_t WS_BAR = 512 * 1024, BAR_BYTES = 16384;
constexpr size_t WS_SSQ = 1 * MiB;
constexpr size_t WS_DEC = 2 * MiB;
constexpr size_t WS_LB = 2 * MiB + 768 * 1024;
constexpr size_t WS_HBND = 3 * MiB;
constexpr size_t WS_W = 9 * MiB, W_LAYER = 29 * MiB + 512 * 1024;
constexpr size_t WO_IN = 0, WO_A = 9 * MiB, WO_PB = 10 * MiB, WO_O = 11 * MiB, WO_UP = 13 * MiB, WO_DN = 24 * MiB;
constexpr size_t WS_XB = 68 * MiB;
constexpr size_t WS_R = 100 * MiB;
constexpr size_t WS_U = WS_R, WS_HG = WS_R, WS_Q = WS_R + 16 * MiB, WS_V = WS_R + 32 * MiB, WS_SO = WS_R + 48 * MiB, WS_G = WS_R + 64 * MiB;
constexpr size_t WS_POOL = WS_R + 96 * MiB, WS_UT = WS_R + 112 * MiB, WS_GATES = WS_R + 16 * MiB, WS_MERGED = WS_R + 112 * MiB, WS_ACT = WS_R;
constexpr size_t WS_XF = WS_R + 88 * MiB;
constexpr size_t WS_END = 256 * MiB;
static_assert(WS_UT + 32 * MiB <= WS_END && WS_ACT + (size_t)M * DFF * 2 <= WS_END && WS_GATES + 64 * MiB <= WS_POOL, "ws map");

#define LAS __attribute__((address_space(3)))
typedef unsigned short bf16;
typedef unsigned u32x4 __attribute__((ext_vector_type(4)));
typedef unsigned u32x2 __attribute__((ext_vector_type(2)));
typedef float f32x4 __attribute__((ext_vector_type(4)));
typedef float f32x2 __attribute__((ext_vector_type(2)));
typedef short bf16x8 __attribute__((ext_vector_type(8)));

__device__ __forceinline__ float bflo(unsigned w) { return __uint_as_float(w << 16); }
__device__ __forceinline__ float bfhi(unsigned w) { return __uint_as_float(w & 0xffff0000u); }
typedef __bf16 bf16x2_t __attribute__((ext_vector_type(2)));
__device__ __forceinline__ unsigned pk(float lo, float hi) { const bf16x2_t v = __builtin_convertvector((f32x2){lo, hi}, bf16x2_t); return __builtin_bit_cast(unsigned, v); }
__device__ __forceinline__ float sigm(float x) { return __builtin_amdgcn_rcpf(1.f + __expf(-x)); }
__device__ __forceinline__ float silu(float x) { return x * sigm(x); }
__device__ __forceinline__ float wave_sum(float v) {
#pragma unroll
    for (int o = 1; o < 64; o <<= 1) v += __shfl_xor(v, o);
    return v;
}
__device__ __forceinline__ float dpp_shr1(float x) { return __int_as_float(__builtin_amdgcn_update_dpp(0, __float_as_int(x), 0x111, 0xf, 0xf, true)); }
#define LDS_WAIT() asm volatile("s_waitcnt lgkmcnt(0)" ::: "memory")
#define VM_WAIT() asm volatile("s_waitcnt vmcnt(0)" ::: "memory")

__device__ __forceinline__ float load_rs(const float* ssq, int row0, int lane) {
    const f32x4* p = (const f32x4*)(ssq + (size_t)(row0 + lane) * 16);
    const f32x4 a = p[0], b = p[1], c = p[2], d = p[3];
    const f32x4 s = (a + b) + (c + d);
    return rsqrtf(((s[0] + s[1]) + (s[2] + s[3])) * (1.f / D) + EPS);
}

struct EpiInMix {
    static constexpr bool PERM = true, AFTER_DRAIN = false;
    bf16 *u, *q, *v, *so; bf16* g; const float* ssq; const float* lb; bf16* gates; const float* bgate; int pn_off;
    __device__ __forceinline__ void operator()(const f32x4 (&acc)[2][2][4][2], const pg8::Unit& un0, int wr, int wc, int fr, int fq) const {
        const int lane = fr + 16 * fq;
        pg8::Unit un = un0; un.pn += pn_off;
        float rs[2]; rs[0] = load_rs(ssq, un.pm * 256 + wr * 64, lane); rs[1] = load_rs(ssq, un.pm * 256 + 128 + wr * 64, lane);
        const int sec = un.pn >> 1, colt = (un.pn & 1) * 256 + wc * 32 + 8 * fq, row0 = un.pm * 256 + wr * 64 + fr;
        if (un.pn >= 10) {
            const int col0 = (un.pn - 10) * 256 + wc * 32 + 8 * fq;
            f32x4 bv[2][2];
#pragma unroll
            for (int bj = 0; bj < 2; ++bj)
#pragma unroll
                for (int n = 0; n < 2; ++n) bv[bj][n] = *(const f32x4*)(bgate + col0 + bj * 128 + 4 * n);
#pragma unroll
            for (int ai = 0; ai < 2; ++ai)
#pragma unroll
                for (int m = 0; m < 4; ++m) {
                    const float r = __shfl(rs[ai], 16 * m + fr);
                    bf16* rowp = gates + (size_t)(row0 + ai * 128 + m * 16) * NGATE + col0;
#pragma unroll
                    for (int bj = 0; bj < 2; ++bj) {
                        f32x4 v0 = acc[ai][bj][m][0] * r + bv[bj][0], v1 = acc[ai][bj][m][1] * r + bv[bj][1];
#pragma unroll
                        for (int e = 0; e < 4; ++e) { v0[e] = sigm(v0[e]); v1[e] = sigm(v1[e]); }
                        u32x4 w; w.x = pk(v0[0], v0[1]); w.y = pk(v0[2], v0[3]); w.z = pk(v1[0], v1[1]); w.w = pk(v1[2], v1[3]);
                        *(u32x4*)(rowp + bj * 128) = w;
                    }
                }
        } else if (sec == 2) {
            f32x4 lbv[2][2];
#pragma unroll
            for (int bj = 0; bj < 2; ++bj)
#pragma unroll
                for (int n = 0; n < 2; ++n) lbv[bj][n] = *(const f32x4*)(lb + colt + bj * 128 + 4 * n);
#pragma unroll
            for (int ai = 0; ai < 2; ++ai)
#pragma unroll
                for (int m = 0; m < 4; ++m) {
                    const float r = __shfl(rs[ai], 16 * m + fr);
                    bf16* rowp = g + (size_t)(row0 + ai * 128 + m * 16) * 512 + colt;
#pragma unroll
                    for (int bj = 0; bj < 2; ++bj) {
                        float o[8];
#pragma unroll
                        for (int n = 0; n < 2; ++n) { const f32x4 z = acc[ai][bj][m][n] * r;
#pragma unroll
                            for (int e = 0; e < 4; ++e) { const float l = lbv[bj][n][e]; o[4 * n + e] = __logf(l + (1.f - l) * sigm(z[e])); } }
                        u32x4 w; w.x = pk(o[0], o[1]); w.y = pk(o[2], o[3]); w.z = pk(o[4], o[5]); w.w = pk(o[6], o[7]);
                        *(u32x4*)(rowp + bj * 128) = w;
                    }
                }
        } else {
            bf16* base = sec == 0 ? u : (sec == 1 ? q : (sec == 3 ? v : so));
            const bool act = (sec == 1 || sec == 4);
#pragma unroll
            for (int ai = 0; ai < 2; ++ai)
#pragma unroll
                for (int m = 0; m < 4; ++m) {
                    const float r = __shfl(rs[ai], 16 * m + fr);
                    bf16* rowp = base + (size_t)(row0 + ai * 128 + m * 16) * 512 + colt;
#pragma unroll
                    for (int bj = 0; bj < 2; ++bj) {
                        f32x4 v0 = acc[ai][bj][m][0] * r, v1 = acc[ai][bj][m][1] * r;
                        if (act) {
#pragma unroll
                            for (int e = 0; e < 4; ++e) { v0[e] = silu(v0[e]); v1[e] = silu(v1[e]); }
                        }
                        u32x4 w; w.x = pk(v0[0], v0[1]); w.y = pk(v0[2], v0[3]); w.z = pk(v1[0], v1[1]); w.w = pk(v1[2], v1[3]);
                        *(u32x4*)(rowp + bj * 128) = w;
                    }
                }
        }
    }
};


struct GateOrder {
    pg8::StaticOrder S;
    __device__ bool next(int i, pg8::Unit& u) const { if (!S.next(i >> 1, u)) return false; u.pn += 4 * (i & 1); return true; }
    __device__ __forceinline__ void a_ready(const pg8::Unit&) const {}
    __device__ __forceinline__ void done(const pg8::Unit&) const {}
};
template <bool SECOND> struct EpiMerge {
    static constexpr bool PERM = true, AFTER_DRAIN = false;
    bf16* merged; const bf16* gates;
    __device__ __forceinline__ void operator()(const f32x4 (&acc)[2][2][4][2], const pg8::Unit& un, int wr, int wc, int fr, int fq) const {
        const int col0 = un.pn * 256 + wc * 32 + 8 * fq, row0 = un.pm * 256 + wr * 64 + fr;
#pragma unroll
        for (int ai = 0; ai < 2; ++ai)
#pragma unroll
            for (int m = 0; m < 4; ++m) {
                const size_t row = (size_t)(row0 + ai * 128 + m * 16);
#pragma unroll
                for (int bj = 0; bj < 2; ++bj) {
                    const u32x4 gw = *(const u32x4*)(gates + row * NGATE + (SECOND ? 1024 : 0) + col0 + bj * 128);
                    const f32x4 a0 = acc[ai][bj][m][0], a1 = acc[ai][bj][m][1];
                    float o[8];
                    o[0] = bflo(gw.x) * a0[0]; o[1] = bfhi(gw.x) * a0[1]; o[2] = bflo(gw.y) * a0[2]; o[3] = bfhi(gw.y) * a0[3];
                    o[4] = bflo(gw.z) * a1[0]; o[5] = bfhi(gw.z) * a1[1]; o[6] = bflo(gw.w) * a1[2]; o[7] = bfhi(gw.w) * a1[3];
                    bf16* mp = merged + row * D + col0 + bj * 128;
                    if (SECOND) {
                        const u32x4 ow = *(const u32x4*)mp;
                        o[0] += bflo(ow.x); o[1] += bfhi(ow.x); o[2] += bflo(ow.y); o[3] += bfhi(ow.y);
                        o[4] += bflo(ow.z); o[5] += bfhi(ow.z); o[6] += bflo(ow.w); o[7] += bfhi(ow.w);
                    }
                    u32x4 w; w.x = pk(o[0], o[1]); w.y = pk(o[2], o[3]); w.z = pk(o[4], o[5]); w.w = pk(o[6], o[7]);
                    *(u32x4*)mp = w;
                }
            }
    }
};

template <bool LAST> struct EpiRes {
    static constexpr bool PERM = true, AFTER_DRAIN = false;
    float* out; bf16* xb; float* ssq;
    __device__ __forceinline__ void operator()(const f32x4 (&acc)[2][2][4][2], const pg8::Unit& un, int wr, int wc, int fr, int fq) const {
        const int col0 = un.pn * 256 + wc * 32 + 8 * fq, row0 = un.pm * 256 + wr * 64 + fr;
#pragma unroll
        for (int ai = 0; ai < 2; ++ai)
#pragma unroll
            for (int m = 0; m < 4; ++m) {
                const size_t row = (size_t)(row0 + ai * 128 + m * 16);
                float s = 0.f;
#pragma unroll
                for (int bj = 0; bj < 2; ++bj) {
                    const size_t p = row * D + col0 + bj * 128;
                    const u32x4 bw = *(const u32x4*)(xb + p);
                    const f32x4 x0 = (f32x4){bflo(bw.x), bfhi(bw.x), bflo(bw.y), bfhi(bw.y)} + acc[ai][bj][m][0], x1 = (f32x4){bflo(bw.z), bfhi(bw.z), bflo(bw.w), bfhi(bw.w)} + acc[ai][bj][m][1];
                    s += (x0[0] * x0[0] + x0[1] * x0[1]) + (x0[2] * x0[2] + x0[3] * x0[3]) + (x1[0] * x1[0] + x1[1] * x1[1]) + (x1[2] * x1[2] + x1[3] * x1[3]);
                    if (LAST) { *(f32x4*)(out + p) = x0; *(f32x4*)(out + p + 4) = x1; }
                    else { u32x4 w; w.x = pk(x0[0], x0[1]); w.y = pk(x0[2], x0[3]); w.z = pk(x1[0], x1[1]); w.w = pk(x1[2], x1[3]); *(u32x4*)(xb + p) = w; }
                }
                s += __shfl_xor(s, 16); s += __shfl_xor(s, 32);
                if (fq == 0) ssq[row * 16 + un.pn * 4 + wc] = s;
            }
    }
};

struct EpiUpConv {
    static constexpr bool PERM = false, AFTER_DRAIN = false;
    bf16* act; bf16* hbnd; const float* ssq; const float* cw; const float* cb;
    __device__ __forceinline__ void operator()(f32x4 (&acc)[2][2][4][2], const pg8::Unit& un, int wr, int wc, int fr, int fq) const {
        const int lane = fr + 16 * fq;
        {
            const float rs0 = load_rs(ssq, un.pm * 256 + 128 * wr, lane), rs1 = load_rs(ssq, un.pm * 256 + 128 * wr + 64, lane);
#pragma unroll
            for (int j = 0; j < 8; ++j) { const int src = (8 * fr + j) & 63; const float a = __shfl(rs0, src), b = __shfl(rs1, src); const float r = fr < 8 ? a : b;
#pragma unroll
                for (int bj = 0; bj < 2; ++bj)
#pragma unroll
                    for (int n = 0; n < 2; ++n) acc[j >> 2][bj][j & 3][n] *= r; }
        }
        const size_t tok0 = (size_t)un.pm * 256 + 128 * wr + 8 * fr;
        const int blk = un.pm * 2 + wr;
#pragma unroll
        for (int n = 0; n < 2; ++n) {
            const int ch0 = un.pn * 128 + wc * 32 + 16 * n + 4 * fq;
            if (fr == 15) {
                bf16* hb = hbnd + ((size_t)(blk * 4 + 2) * 2) * DFF + ch0;
                const f32x4 hv6 = acc[1][0][2][n], hv7 = acc[1][0][3][n], hg6 = acc[1][1][2][n], hg7 = acc[1][1][3][n];
                *(u32x2*)(hb) = (u32x2){pk(hv6[0], hv6[1]), pk(hv6[2], hv6[3])}; *(u32x2*)(hb + DFF) = (u32x2){pk(hg6[0], hg6[1]), pk(hg6[2], hg6[3])};
                *(u32x2*)(hb + 2 * DFF) = (u32x2){pk(hv7[0], hv7[1]), pk(hv7[2], hv7[3])}; *(u32x2*)(hb + 3 * DFF) = (u32x2){pk(hg7[0], hg7[1]), pk(hg7[2], hg7[3])};
            }
            if (fr == 0) {
#pragma unroll
                for (int j = 0; j < 2; ++j) { bf16* hb = hbnd + ((size_t)(blk * 4 + j) * 2) * DFF + ch0; const f32x4 hv = acc[0][0][j][n], hg = acc[0][1][j][n];
                    *(u32x2*)(hb) = (u32x2){pk(hv[0], hv[1]), pk(hv[2], hv[3])}; *(u32x2*)(hb + DFF) = (u32x2){pk(hg[0], hg[1]), pk(hg[2], hg[3])}; }
            }
#pragma unroll
            for (int bj = 0; bj < 2; ++bj) {
                const float* cwp = cw + bj * DFF + ch0;
                const f32x4 w0 = *(const f32x4*)(cwp), w1 = *(const f32x4*)(cwp + NUP), w2 = *(const f32x4*)(cwp + 2 * NUP), bb = *(const f32x4*)(cb + bj * DFF + ch0);
                f32x4 m2, m1;
#pragma unroll
                for (int e = 0; e < 4; ++e) { m2[e] = dpp_shr1(acc[1][bj][2][n][e]); m1[e] = dpp_shr1(acc[1][bj][3][n][e]); }
#pragma unroll
                for (int j = 7; j >= 0; --j) {
                    const f32x4 h0 = acc[j >> 2][bj][j & 3][n];
                    const f32x4 hm1 = j >= 1 ? acc[(j - 1 + 8) % 8 >> 2][bj][(j - 1 + 8) % 8 & 3][n] : m1;
                    const f32x4 hm2 = j >= 2 ? acc[(j - 2 + 8) % 8 >> 2][bj][(j - 2 + 8) % 8 & 3][n] : (j == 1 ? m1 : m2);
                    acc[j >> 2][bj][j & 3][n] = w2 * h0 + w1 * hm1 + w0 * hm2 + bb;
                }
            }
#pragma unroll
            for (int j = 0; j < 8; ++j) {
                const f32x4 vc = acc[j >> 2][0][j & 3][n], gc = acc[j >> 2][1][j & 3][n];
                f32x4 a;
#pragma unroll
                for (int e = 0; e < 4; ++e) a[e] = vc[e] * silu(gc[e]);
                if (!(j < 2 && fr == 0)) *(u32x2*)(act + (tok0 + j) * DFF + ch0) = (u32x2){pk(a[0], a[1]), pk(a[2], a[3])};
            }
        }
    }
};

struct Args { const float* in[17]; float* out; unsigned char* ws; int ph_lo, ph_hi; };

struct TrItem { const float* W; const float* rscale; bf16* WT; int K, N, drow0, k0, n0; };
__device__ __forceinline__ void tr_load(const TrItem& t, int lane, float (&wv)[32]) {
#pragma unroll
    for (int i = 0; i < 32; ++i) { const int kk = 2 * i + (lane >> 5); wv[i] = t.W[(size_t)(t.k0 + kk) * t.N + t.n0 + (lane & 31)]; }
    if (t.rscale) {
#pragma unroll
        for (int i = 0; i < 32; ++i) wv[i] *= t.rscale[t.k0 + 2 * i + (lane >> 5)];
    }
}
__device__ __forceinline__ void tr_store(const TrItem& t, int lane, const float (&wv)[32], LAS float* scr) {
#pragma unroll
    for (int i = 0; i < 32; ++i) scr[(2 * i + (lane >> 5)) * 33 + (lane & 31)] = wv[i];
    LDS_WAIT(); asm volatile("" ::: "memory");
    const int c = lane & 7;
#pragma unroll
    for (int j = 0; j < 4; ++j) { const int n = (lane >> 3) + 8 * j; const LAS float* sp = scr + (8 * c) * 33 + n;
        u32x4 o; o.x = pk(sp[0 * 33], sp[1 * 33]); o.y = pk(sp[2 * 33], sp[3 * 33]); o.z = pk(sp[4 * 33], sp[5 * 33]); o.w = pk(sp[6 * 33], sp[7 * 33]);
        *(u32x4*)(t.WT + (size_t)(t.drow0 + n) * t.K + t.k0 + 8 * c) = o; }
    LDS_WAIT(); asm volatile("" ::: "memory");
}
constexpr int I_IN = (D / 64) * (IN_COLS / 32), I_PB = (HW / 64) * (D / 32), I_O = (D / 64) * (D / 32), I_UP = (D / 64) * (NUP / 32), I_DN = (DFF / 64) * (D / 32);
constexpr int I_LAYER = I_IN + I_PB + I_O + I_UP + I_DN;
__device__ __forceinline__ TrItem tr_decode(const Args& a, int it) {
    const int l = it / I_LAYER; int r = it % I_LAYER;
    unsigned char* wl = a.ws + WS_W + (size_t)l * W_LAYER;
    TrItem t;
    if (r < I_IN) { const int nb = IN_COLS / 32; t.k0 = 64 * (r / nb); t.n0 = 32 * (r % nb); t.W = a.in[2] + (size_t)l * D * IN_COLS; t.K = D; t.N = IN_COLS; t.rscale = a.in[1] + l * D; t.WT = (bf16*)(wl + WO_IN); t.drow0 = t.n0; return t; }
    r -= I_IN;
    if (r < I_PB) { const int nb = D / 32; t.k0 = 64 * (r / nb); t.n0 = 32 * (r % nb); t.W = a.in[9] + (size_t)l * HW * D; t.K = HW; t.N = D; t.rscale = nullptr; t.WT = (bf16*)(wl + WO_PB); t.drow0 = t.n0; return t; }
    r -= I_PB;
    if (r < I_O) { const int nb = D / 32; t.k0 = 64 * (r / nb); t.n0 = 32 * (r % nb); t.W = a.in[10] + (size_t)l * D * D; t.K = D; t.N = D; t.rscale = nullptr; t.WT = (bf16*)(wl + WO_O); t.drow0 = t.n0; return t; }
    r -= I_O;
    if (r < I_UP) { const int nb = NUP / 32; t.k0 = 64 * (r / nb); t.n0 = 32 * (r % nb); t.W = a.in[12] + (size_t)l * D * NUP; t.K = D; t.N = NUP; t.rscale = a.in[11] + l * D; t.WT = (bf16*)(wl + WO_UP);
        const int bjs = t.n0 / DFF, rr = t.n0 % DFF; t.drow0 = 256 * (rr / 128) + 128 * bjs + (rr % 128); return t; }
    r -= I_UP;
    { const int nb = D / 32; t.k0 = 64 * (r / nb); t.n0 = 32 * (r % nb); t.W = a.in[15] + (size_t)l * DFF * D; t.K = DFF; t.N = D; t.rscale = nullptr; t.WT = (bf16*)(wl + WO_DN); t.drow0 = t.n0; return t; }
}

__device__ __forceinline__ void convert_items(const Args& a, LAS unsigned char* lds, int it0, int it1, int r, int nr) {
    int tid = threadIdx.x; asm volatile("" : "+v"(tid));
    const int lane = tid & 63, wave = __builtin_amdgcn_readfirstlane(tid >> 6);
    LAS float* scr = (LAS float*)(lds + wave * 16384);
    const int gw = r * NWAVES + wave, NGW = nr * NWAVES;
    for (int it = it0 + gw; it < it1; it += 2 * NGW) {
        const bool two = it + NGW < it1;
        const TrItem t0 = tr_decode(a, it), t1 = tr_decode(a, two ? it + NGW : it);
        float w0[32], w1[32];
        tr_load(t0, lane, w0); if (two) tr_load(t1, lane, w1);
        tr_store(t0, lane, w0, scr); if (two) tr_store(t1, lane, w1, scr);
    }
}
__device__ __forceinline__ void fold_pool(const Args& a, LAS unsigned char* lds, int l0, int l1, int r, int nr) {
    int tid = threadIdx.x; asm volatile("" : "+v"(tid));
    const int lane = tid & 63, wave = __builtin_amdgcn_readfirstlane(tid >> 6);
    unsigned char* ws = a.ws;
    const float *pool_w = a.in[4], *pool_scale = a.in[5], *w_pa = a.in[8];
    LAS float* scr = (LAS float*)(lds + wave * 16384);
    for (int gt = l0 * 65536 + r * NTHREADS + tid; gt < l1 * 65536; gt += nr * NTHREADS) {
        const int l = __builtin_amdgcn_readfirstlane(gt >> 16), rem = gt & 65535, d = rem & 1023, cg8 = __builtin_amdgcn_readfirstlane(rem >> 10), gi = cg8 >> 4, c0 = (cg8 & 15) * 8;
        const float* pw = pool_w + ((size_t)(l * 4 + gi) * 128 + c0) * 128;
        const float* ps = pool_scale + l * PW + gi * 128;
        const float* wp = w_pa + ((size_t)l * PW + gi * 128) * D + d;
        LAS float* pwl = scr;
#pragma unroll
        for (int j = 0; j < 4; ++j) { const int e = j * 256 + lane * 4; const f32x4 v = *(const f32x4*)(pw + e) * *(const f32x4*)(ps + (e & 127)); *(LAS f32x4*)(pwl + e) = v; }
        LDS_WAIT(); asm volatile("" ::: "memory");
        float sacc[8];
#pragma unroll
        for (int i = 0; i < 8; ++i) sacc[i] = 0.f;
#pragma unroll 4
        for (int cp = 0; cp < 128; cp += 4) {
            const float w0 = wp[(size_t)cp * D], w1 = wp[(size_t)(cp + 1) * D], w2 = wp[(size_t)(cp + 2) * D], w3 = wp[(size_t)(cp + 3) * D];
#pragma unroll
            for (int i = 0; i < 8; ++i) { const f32x4 p = *(const LAS f32x4*)(pwl + i * 128 + cp); sacc[i] += (p[0] * w0 + p[1] * w1) + (p[2] * w2 + p[3] * w3); }
        }
        u32x4 o; o.x = pk(sacc[0], sacc[1]); o.y = pk(sacc[2], sacc[3]); o.z = pk(sacc[4], sacc[5]); o.w = pk(sacc[6], sacc[7]);
        *(u32x4*)((bf16*)(ws + WS_W + (size_t)l * W_LAYER + WO_A) + (size_t)d * PW + cg8 * 8) = o;
        LDS_WAIT(); asm volatile("" ::: "memory");
    }
}

__device__ __forceinline__ void phase_prologue(const Args& a, LAS unsigned char* lds, int G, bool lazy) {
    int tid = threadIdx.x; asm volatile("" : "+v"(tid));
    const int lane = tid & 63, wave = __builtin_amdgcn_readfirstlane(tid >> 6);
    unsigned char* ws = a.ws;
    const float *x = a.in[0], *lb_logits = a.in[6];
    const int gw = blockIdx.x * NWAVES + wave, NGW = G * NWAVES;
    convert_items(a, lds, 0, lazy ? I_IN : DEPTH * I_LAYER, (int)blockIdx.x, G);
    if (!lazy) fold_pool(a, lds, 0, DEPTH, (int)blockIdx.x, G);
    if (blockIdx.x == 0) {
        const int chn = tid;
        float mx = -1e30f;
        for (int l = 0; l < DEPTH; ++l) mx = fmaxf(mx, lb_logits[l * HW + chn]);
        float sum = 0.f;
        for (int l = 0; l < DEPTH; ++l) sum += expf(lb_logits[l * HW + chn] - mx);
        float cum = 0.f, c0v = 0.f;
        for (int l = 0; l < DEPTH; ++l) { cum += expf(lb_logits[l * HW + chn] - mx) / sum; if (l == 0) c0v = cum; ((float*)(ws + WS_LB))[l * HW + chn] = cum - c0v; }
    }
    bf16* xb = (bf16*)(ws + WS_XB); float* ssq = (float*)(ws + WS_SSQ);
    for (int m = gw; m < M; m += 4 * NGW) {
        f32x4 v[4][4]; bool ok[4];
#pragma unroll
        for (int q = 0; q < 4; ++q) { const int mq = m + q * NGW; ok[q] = mq < M; const f32x4* xr = (const f32x4*)(x + (size_t)(ok[q] ? mq : m) * D) + lane;
#pragma unroll
            for (int j = 0; j < 4; ++j) v[q][j] = xr[64 * j]; }
#pragma unroll
        for (int q = 0; q < 4; ++q) {
            const int mq = m + q * NGW;
            float sq = 0.f;
#pragma unroll
            for (int j = 0; j < 4; ++j) sq += (v[q][j][0] * v[q][j][0] + v[q][j][1] * v[q][j][1]) + (v[q][j][2] * v[q][j][2] + v[q][j][3] * v[q][j][3]);
            sq = wave_sum(sq);
            if (ok[q]) {
                u32x2* o8 = (u32x2*)(xb + (size_t)mq * D) + lane;
#pragma unroll
                for (int j = 0; j < 4; ++j) o8[64 * j] = (u32x2){pk(v[q][j][0], v[q][j][1]), pk(v[q][j][2], v[q][j][3])};
                if (lane < 16) ssq[(size_t)mq * 16 + lane] = lane == 0 ? sq : 0.f;
            }
        }
    }
}

__device__ __forceinline__ void phase_fir(const bf16* u, bf16* pooled, int G) {
    int tid = threadIdx.x; asm volatile("" : "+v"(tid));
    for (int item = blockIdx.x * NTHREADS + tid; item < (M / 8) * 64; item += G * NTHREADS) {
        const int cgp = item & 63, run = item >> 6, m0 = run * 8, ts = m0 & (SEQ - 1), w = 2 << (cgp >> 4);
        const bf16* up = u + (size_t)m0 * PW + cgp * 8;
        float s[8];
#pragma unroll
        for (int i = 0; i < 8; ++i) s[i] = 0.f;
        for (int d = 1; d < w; ++d) if (ts - d >= 0) {
            const u32x4 x = *(const u32x4*)(up - (size_t)d * PW);
            s[0] += bflo(x.x); s[1] += bfhi(x.x); s[2] += bflo(x.y); s[3] += bfhi(x.y); s[4] += bflo(x.z); s[5] += bfhi(x.z); s[6] += bflo(x.w); s[7] += bfhi(x.w);
        }
#pragma unroll
        for (int r = 0; r < 8; ++r) {
            const u32x4 x = *(const u32x4*)(up + (size_t)r * PW);
            float c[8] = {bflo(x.x), bfhi(x.x), bflo(x.y), bfhi(x.y), bflo(x.z), bfhi(x.z), bflo(x.w), bfhi(x.w)};
#pragma unroll
            for (int i = 0; i < 8; ++i) s[i] += c[i];
            const int cnt = (ts + r + 1) < w ? (ts + r + 1) : w; const float inv = 1.f / (float)cnt;
            u32x4 o; o.x = pk(s[0] * inv - c[0], s[1] * inv - c[1]); o.y = pk(s[2] * inv - c[2], s[3] * inv - c[3]);
            o.z = pk(s[4] * inv - c[4], s[5] * inv - c[5]); o.w = pk(s[6] * inv - c[6], s[7] * inv - c[7]);
            *(u32x4*)(pooled + (size_t)(m0 + r) * PW + cgp * 8) = o;
            if (ts + r - w + 1 >= 0) {
                const u32x4 y = *(const u32x4*)(up + ((ptrdiff_t)r - w + 1) * PW);
                s[0] -= bflo(y.x); s[1] -= bfhi(y.x); s[2] -= bflo(y.y); s[3] -= bfhi(y.y); s[4] -= bflo(y.z); s[5] -= bfhi(y.z); s[6] -= bflo(y.w); s[7] -= bfhi(y.w);
            }
        }
    }
}

__device__ __forceinline__ u32x4 pack_lo8(const unsigned (&v)[8]) { u32x4 o; o.x = (v[0] & 0xffffu) | (v[1] << 16); o.y = (v[2] & 0xffffu) | (v[3] << 16); o.z = (v[4] & 0xffffu) | (v[5] << 16); o.w = (v[6] & 0xffffu) | (v[7] << 16); return o; }
__device__ __forceinline__ u32x4 pack_hi8(const unsigned (&v)[8]) { u32x4 o; o.x = (v[0] >> 16) | (v[1] & 0xffff0000u); o.y = (v[2] >> 16) | (v[3] & 0xffff0000u); o.z = (v[4] >> 16) | (v[5] & 0xffff0000u); o.w = (v[6] >> 16) | (v[7] & 0xffff0000u); return o; }

#define WG_BAR() do { asm volatile("s_waitcnt lgkmcnt(0)" ::: "memory"); __builtin_amdgcn_s_barrier(); asm volatile("" ::: "memory"); } while (0)
__device__ __forceinline__ void phase_h1(LAS unsigned char* lds, const bf16* g, const bf16* vb, bf16* UT, float* dec, int G) {
    int tid = threadIdx.x; asm volatile("" : "+v"(tid));
    const int lane = tid & 63, w = __builtin_amdgcn_readfirstlane(tid >> 6), r16 = lane & 15, q4 = lane >> 4;
    LAS unsigned char* KT = lds; LAS unsigned char* VT = lds + 18432; LAS float* SEG = (LAS float*)(lds + 36864);
    f32x2 gg[8]; unsigned vv[8];
    int unit = blockIdx.x;
    if (unit < NUNIT) {
        const int bh = unit >> 7, c = unit & 127, b = bh >> 2, h = bh & 3;
        const size_t m0 = (size_t)b * SEQ + c * CH + 8 * w; const int col = h * HD + 2 * lane;
#pragma unroll
        for (int r = 0; r < 8; ++r) { { const unsigned gw_ = *(const unsigned*)(g + (m0 + r) * HW + col); gg[r] = (f32x2){bflo(gw_), bfhi(gw_)}; } vv[r] = *(const unsigned*)(vb + (m0 + r) * HW + col); }
    }
    for (; unit < NUNIT; unit += G) {
        f32x2 cs[8]; cs[0] = gg[0];
#pragma unroll
        for (int r = 1; r < 8; ++r) cs[r] = cs[r - 1] + gg[r];
        *(LAS f32x2*)(SEG + w * 128 + 2 * lane) = cs[7];
        *(LAS u32x4*)(VT + (2 * lane) * 144 + w * 16) = pack_lo8(vv); *(LAS u32x4*)(VT + (2 * lane + 1) * 144 + w * 16) = pack_hi8(vv);
        WG_BAR();
        f32x2 pre = {0.f, 0.f}, tot = {0.f, 0.f};
#pragma unroll
        for (int j = 0; j < 8; ++j) { const f32x2 sg = *(const LAS f32x2*)(SEG + j * 128 + 2 * lane); tot += sg; if (j < w) pre += sg; }
        unsigned kt[8];
#pragma unroll
        for (int r = 0; r < 8; ++r) { const f32x2 bb = pre + cs[r];
            kt[r] = pk((1.f - __expf(gg[r].x)) * __expf(tot.x - bb.x), (1.f - __expf(gg[r].y)) * __expf(tot.y - bb.y)); }
        *(LAS u32x4*)(KT + (2 * lane) * 144 + w * 16) = pack_lo8(kt); *(LAS u32x4*)(KT + (2 * lane + 1) * 144 + w * 16) = pack_hi8(kt);
        if (w == 0) *(f32x2*)(dec + (size_t)unit * HD + 2 * lane) = (f32x2){__expf(tot.x), __expf(tot.y)};
        const int nu = unit + G;
        if (nu < NUNIT) {
            const int bh = nu >> 7, c = nu & 127, b = bh >> 2, h = bh & 3;
            const size_t m0 = (size_t)b * SEQ + c * CH + 8 * w; const int col = h * HD + 2 * lane;
#pragma unroll
            for (int r = 0; r < 8; ++r) { { const unsigned gw_ = *(const unsigned*)(g + (m0 + r) * HW + col); gg[r] = (f32x2){bflo(gw_), bfhi(gw_)}; } vv[r] = *(const unsigned*)(vb + (m0 + r) * HW + col); }
        }
        WG_BAR();
        bf16x8 yv[2];
#pragma unroll
        for (int ks = 0; ks < 2; ++ks) yv[ks] = *(const LAS bf16x8*)(VT + (16 * w + r16) * 144 + ks * 64 + q4 * 16);
        bf16* ut = UT + (size_t)unit * (HD * HD) + (size_t)(16 * w + r16) * HD + 4 * q4;
#pragma unroll
        for (int nb = 0; nb < 8; ++nb) {
            f32x4 a = {0.f, 0.f, 0.f, 0.f};
#pragma unroll
            for (int ks = 0; ks < 2; ++ks) { const bf16x8 xk = *(const LAS bf16x8*)(KT + (16 * nb + r16) * 144 + ks * 64 + q4 * 16); a = __builtin_amdgcn_mfma_f32_16x16x32_bf16(xk, yv[ks], a, 0, 0, 0); }
            *(u32x2*)(ut + 16 * nb) = (u32x2){pk(a[0], a[1]), pk(a[2], a[3])};
        }
        WG_BAR();
    }
}

__device__ __forceinline__ void phase_h2(bf16* UT, const float* dec, int G) {
    int tid = threadIdx.x; asm volatile("" : "+v"(tid));
    for (int e = blockIdx.x * NTHREADS + tid; e < NBH * HD * HD; e += G * NTHREADS) {
        const int bh = e >> 14, idx = e & 16383, k = idx & 127;
        bf16* up = UT + (size_t)bh * NCH * (HD * HD) + idx; const float* dp = dec + (size_t)bh * NCH * HD + k;
        float S = 0.f;
        for (int c0 = 0; c0 < NCH; c0 += 16) {
            bf16 uu[16]; float dd[16];
#pragma unroll
            for (int i = 0; i < 16; ++i) { uu[i] = up[(size_t)(c0 + i) * (HD * HD)]; dd[i] = dp[(size_t)(c0 + i) * HD]; }
#pragma unroll
            for (int i = 0; i < 16; ++i) { up[(size_t)(c0 + i) * (HD * HD)] = (bf16)(pk(S, 0.f) & 0xffffu); S = dd[i] * S + __uint_as_float((unsigned)uu[i] << 16); }
        }
    }
}

__device__ __forceinline__ void phase_h3(LAS unsigned char* lds, const bf16* qb, const bf16* g, const bf16* vb, const bf16* sob, const bf16* ST, const float* ng, bf16* hg, int G) {
    constexpr int SR = 272;
    int tid = threadIdx.x; asm volatile("" : "+v"(tid));
    const int lane = tid & 63, w = __builtin_amdgcn_readfirstlane(tid >> 6), r16 = lane & 15, q4 = lane >> 4;
    LAS unsigned char* QH = lds; LAS unsigned char* QD = lds + 17408; LAS unsigned char* KD = lds + 34816; LAS unsigned char* KE = lds + 52224; LAS unsigned char* QO = lds + 69632;
    LAS unsigned char* VT = lds + 95744; LAS float* SEG = (LAS float*)(lds + 114176); LAS float* RMS = (LAS float*)(lds + 118272);
    const int bi = w >> 1, odd = w & 1;
    f32x2 gg[8]; unsigned qq[8], vv[8];
    int unit = blockIdx.x;
    if (unit < NUNIT) {
        const int bh = unit >> 7, c = unit & 127, b = bh >> 2, h = bh & 3;
        const size_t m0 = (size_t)b * SEQ + c * CH + 8 * w; const int col = h * HD + 2 * lane;
#pragma unroll
        for (int r = 0; r < 8; ++r) { { const unsigned gw_ = *(const unsigned*)(g + (m0 + r) * HW + col); gg[r] = (f32x2){bflo(gw_), bfhi(gw_)}; } qq[r] = *(const unsigned*)(qb + (m0 + r) * HW + col); vv[r] = *(const unsigned*)(vb + (m0 + r) * HW + col); }
    }
    for (; unit < NUNIT; unit += G) {
        const int bh = unit >> 7, c = unit & 127, b = bh >> 2, h = bh & 3;
        const size_t mu = (size_t)b * SEQ + c * CH;
        const bf16* STu = ST + (size_t)unit * (HD * HD) + (size_t)(64 * odd + r16) * HD + q4 * 8;
        bf16x8 xs[4][4];
#pragma unroll
        for (int ks = 0; ks < 4; ++ks)
#pragma unroll
            for (int nb = 0; nb < 4; ++nb) xs[ks][nb] = *(const bf16x8*)(STu + (size_t)(16 * nb) * HD + ks * 32);
        const size_t row = mu + 16 * bi + r16;
        u32x2 sv[4]; f32x4 ngv[4];
#pragma unroll
        for (int nb = 0; nb < 4; ++nb) { const int v0 = 64 * odd + 16 * nb + 4 * q4; ngv[nb] = *(const f32x4*)(ng + v0); sv[nb] = *(const u32x2*)(sob + row * HW + h * HD + v0); }
        f32x2 cs[8]; cs[0] = gg[0];
#pragma unroll
        for (int r = 1; r < 8; ++r) cs[r] = cs[r - 1] + gg[r];
        *(LAS f32x2*)(SEG + w * 128 + 2 * lane) = cs[7];
        *(LAS u32x4*)(VT + (2 * lane) * 144 + w * 16) = pack_lo8(vv); *(LAS u32x4*)(VT + (2 * lane + 1) * 144 + w * 16) = pack_hi8(vv);
        WG_BAR();
        f32x2 pre = {0.f, 0.f};
        for (int j = 0; j < w; ++j) pre += *(const LAS f32x2*)(SEG + j * 128 + 2 * lane);
        const f32x2 cmid = *(const LAS f32x2*)(SEG + (2 * bi) * 128 + 2 * lane);
        const f32x2 bsum = cmid + *(const LAS f32x2*)(SEG + (2 * bi + 1) * 128 + 2 * lane);
        f32x2 bsm1 = {0.f, 0.f}, bsm2 = {0.f, 0.f};
        if (bi >= 1) bsm1 = *(const LAS f32x2*)(SEG + (2 * bi - 2) * 128 + 2 * lane) + *(const LAS f32x2*)(SEG + (2 * bi - 1) * 128 + 2 * lane);
        if (bi >= 2) bsm2 = bsm1 + *(const LAS f32x2*)(SEG + (2 * bi - 4) * 128 + 2 * lane) + *(const LAS f32x2*)(SEG + (2 * bi - 3) * 128 + 2 * lane);
        const f32x2 cbase = odd ? cmid : (f32x2){0.f, 0.f};
        const int pbase = (bi * (bi - 1)) / 2;
#pragma unroll
        for (int r = 0; r < 8; ++r) {
            const int t = 8 * w + r, tl = 8 * odd + r;
            const f32x2 cl = cbase + cs[r], bf = pre + cs[r];
            const float qx = bflo(qq[r]), qy = bfhi(qq[r]);
            const float kx = 1.f - __expf(gg[r].x), ky = 1.f - __expf(gg[r].y);
            *(LAS unsigned*)(QH + t * SR + 4 * lane) = pk(qx * __expf(bf.x), qy * __expf(bf.y));
            *(LAS unsigned*)(QD + t * SR + 4 * lane) = pk(qx * __expf(fminf(cl.x - cmid.x, 80.f)), qy * __expf(fminf(cl.y - cmid.y, 80.f)));
            *(LAS unsigned*)(KD + t * SR + 4 * lane) = pk(kx * __expf(fminf(cmid.x - cl.x, 80.f)), ky * __expf(fminf(cmid.y - cl.y, 80.f)));
            if (bi < 3) *(LAS unsigned*)(KE + t * SR + 4 * lane) = pk(kx * __expf(bsum.x - cl.x), ky * __expf(bsum.y - cl.y));
            if (bi >= 1) *(LAS unsigned*)(QO + ((pbase + bi - 1) * 16 + tl) * SR + 4 * lane) = pk(qx * __expf(cl.x), qy * __expf(cl.y));
            if (bi >= 2) *(LAS unsigned*)(QO + ((pbase + bi - 2) * 16 + tl) * SR + 4 * lane) = pk(qx * __expf(cl.x + bsm1.x), qy * __expf(cl.y + bsm1.y));
            if (bi >= 3) *(LAS unsigned*)(QO + ((pbase + 0) * 16 + tl) * SR + 4 * lane) = pk(qx * __expf(cl.x + bsm2.x), qy * __expf(cl.y + bsm2.y));
        }
        WG_BAR();
        { const int nu = unit + G;
          if (nu < NUNIT) {
            const int bh2 = nu >> 7, c2 = nu & 127, b2 = bh2 >> 2, h2 = bh2 & 3;
            const size_t m0 = (size_t)b2 * SEQ + c2 * CH + 8 * w; const int col = h2 * HD + 2 * lane;
#pragma unroll
            for (int r = 0; r < 8; ++r) { { const unsigned gw_ = *(const unsigned*)(g + (m0 + r) * HW + col); gg[r] = (f32x2){bflo(gw_), bfhi(gw_)}; } qq[r] = *(const unsigned*)(qb + (m0 + r) * HW + col); vv[r] = *(const unsigned*)(vb + (m0 + r) * HW + col); }
          } }
        const int i = bi, vh = odd;
        f32x4 acc[4];
#pragma unroll
        for (int nb = 0; nb < 4; ++nb) acc[nb] = (f32x4){0.f, 0.f, 0.f, 0.f};
#pragma unroll
        for (int ks = 0; ks < 4; ++ks) {
            const bf16x8 y = *(const LAS bf16x8*)(QH + (16 * i + r16) * SR + ks * 64 + q4 * 16);
#pragma unroll
            for (int nb = 0; nb < 4; ++nb) acc[nb] = __builtin_amdgcn_mfma_f32_16x16x32_bf16(xs[ks][nb], y, acc[nb], 0, 0, 0);
        }
#pragma unroll
        for (int jp = 0; jp < 2; ++jp) {
            if (2 * jp <= i) {
                f32x4 p[2];
#pragma unroll
                for (int jj = 0; jj < 2; ++jj) {
                    const int j = 2 * jp + jj;
                    p[jj] = (f32x4){0.f, 0.f, 0.f, 0.f};
                    if (j <= i) {
                        const LAS unsigned char* Kb = (j == i ? KD : KE) + (16 * j + r16) * SR + q4 * 16;
                        const LAS unsigned char* Qb = (j == i ? QD + (16 * i + r16) * SR : QO + ((pbase + j) * 16 + r16) * SR) + q4 * 16;
#pragma unroll
                        for (int ks = 0; ks < 4; ++ks) { const bf16x8 xk = *(const LAS bf16x8*)(Kb + ks * 64); const bf16x8 yq = *(const LAS bf16x8*)(Qb + ks * 64); p[jj] = __builtin_amdgcn_mfma_f32_16x16x32_bf16(xk, yq, p[jj], 0, 0, 0); }
                        if (j == i) {
#pragma unroll
                            for (int e = 0; e < 4; ++e) if (4 * q4 + e > r16) p[jj][e] = 0.f;
                        }
                    }
                }
                u32x4 ypw; ypw.x = pk(p[0][0], p[0][1]); ypw.y = pk(p[0][2], p[0][3]); ypw.z = pk(p[1][0], p[1][1]); ypw.w = pk(p[1][2], p[1][3]);
                const bf16x8 yp = __builtin_bit_cast(bf16x8, ypw);
#pragma unroll
                for (int nb = 0; nb < 4; ++nb) {
                    const LAS unsigned char* vp = VT + (64 * vh + 16 * nb + r16) * 144 + (32 * jp + 4 * q4) * 2;
                    const u32x2 lo = *(const LAS u32x2*)vp, hi = *(const LAS u32x2*)(vp + 32);
                    const u32x4 xw = {lo.x, lo.y, hi.x, hi.y};
                    acc[nb] = __builtin_amdgcn_mfma_f32_16x16x32_bf16(__builtin_bit_cast(bf16x8, xw), yp, acc[nb], 0, 0, 0);
                }
            }
        }
        float ss = 0.f;
#pragma unroll
        for (int nb = 0; nb < 4; ++nb) ss += (acc[nb][0] * acc[nb][0] + acc[nb][1] * acc[nb][1]) + (acc[nb][2] * acc[nb][2] + acc[nb][3] * acc[nb][3]);
        ss += __shfl_xor(ss, 16); ss += __shfl_xor(ss, 32);
        if (q4 == 0) RMS[(16 * i + r16) * 2 + vh] = ss;
        WG_BAR();
        const float rstd = rsqrtf((RMS[(16 * i + r16) * 2] + RMS[(16 * i + r16) * 2 + 1]) * (1.f / HD) + EPS);
#pragma unroll
        for (int nb = 0; nb < 4; ++nb) {
            const int v0 = 64 * vh + 16 * nb + 4 * q4;
            const f32x4 o = acc[nb] * rstd * ngv[nb];
            *(u32x2*)(hg + row * HW + h * HD + v0) = (u32x2){pk(o[0] * bflo(sv[nb].x), o[1] * bfhi(sv[nb].x)), pk(o[2] * bflo(sv[nb].y), o[3] * bfhi(sv[nb].y))};
        }
        WG_BAR();
    }
}

__device__ __forceinline__ f32x4 bf4(u32x2 v) { return (f32x4){bflo(v.x), bfhi(v.x), bflo(v.y), bfhi(v.y)}; }
__device__ __forceinline__ void ffn_fixup(int pm, const bf16* hbnd, const float* cw, const float* cb, bf16* act) {
    int tid = threadIdx.x; asm volatile("" : "+v"(tid));
    for (int idx = tid; idx < DFF / 4; idx += NTHREADS) {
        const int c4 = idx * 4;
        const f32x4 wv0 = *(const f32x4*)(cw + c4), wv1 = *(const f32x4*)(cw + NUP + c4), wv2 = *(const f32x4*)(cw + 2 * NUP + c4), bv = *(const f32x4*)(cb + c4);
        const f32x4 wg0 = *(const f32x4*)(cw + DFF + c4), wg1 = *(const f32x4*)(cw + NUP + DFF + c4), wg2 = *(const f32x4*)(cw + 2 * NUP + DFF + c4), bg = *(const f32x4*)(cb + DFF + c4);
        u32x2 hv[2][4], hg[2][4];
#pragma unroll
        for (int bb = 0; bb < 2; ++bb) {
            const int blk = 2 * pm + bb; const bool first = (blk & 63) == 0;
#pragma unroll
            for (int k = 0; k < 4; ++k) {
                const int sb = k < 2 ? blk - 1 : blk, slot = k < 2 ? k + 2 : k - 2;
                const bf16* p = hbnd + ((size_t)(sb * 4 + slot) * 2) * DFF + c4;
                if (k < 2 && first) { hv[bb][k] = (u32x2){0u, 0u}; hg[bb][k] = (u32x2){0u, 0u}; }
                else { hv[bb][k] = *(const u32x2*)p; hg[bb][k] = *(const u32x2*)(p + DFF); }
            }
        }
#pragma unroll
        for (int bb = 0; bb < 2; ++bb)
#pragma unroll
            for (int dl = 0; dl < 2; ++dl) {
                const f32x4 vc = wv2 * bf4(hv[bb][2 + dl]) + wv1 * bf4(hv[bb][1 + dl]) + wv0 * bf4(hv[bb][dl]) + bv;
                const f32x4 gc = wg2 * bf4(hg[bb][2 + dl]) + wg1 * bf4(hg[bb][1 + dl]) + wg0 * bf4(hg[bb][dl]) + bg;
                f32x4 a;
#pragma unroll
                for (int e = 0; e < 4; ++e) a[e] = vc[e] * silu(gc[e]);
                *(u32x2*)(act + ((size_t)(2 * pm + bb) * 128 + dl) * DFF + c4) = (u32x2){pk(a[0], a[1]), pk(a[2], a[3])};
            }
    }
}

__device__ __forceinline__ void phase_final(const bf16* xb, float* out, const float* ssq, const float* fg, int G) {
    int tid = threadIdx.x; asm volatile("" : "+v"(tid));
    const int lane = tid & 63, wave = tid >> 6;
    for (int m = blockIdx.x * NWAVES + wave; m < M; m += G * NWAVES) {
        const f32x4* sp = (const f32x4*)(ssq + (size_t)m * 16);
        const f32x4 s = (sp[0] + sp[1]) + (sp[2] + sp[3]);
        const float rstd = rsqrtf(((s[0] + s[1]) + (s[2] + s[3])) * (1.f / D) + EPS);
        const u32x4* xr = (const u32x4*)(xb + (size_t)m * D) + lane; f32x4* orow = (f32x4*)(out + (size_t)m * D) + 2 * lane; const f32x4* gr = (const f32x4*)fg + 2 * lane;
#pragma unroll
        for (int j = 0; j < 2; ++j) { const u32x4 w = xr[64 * j];
            orow[128 * j] = (f32x4){bflo(w.x), bfhi(w.x), bflo(w.y), bfhi(w.y)} * rstd * gr[128 * j];
            orow[128 * j + 1] = (f32x4){bflo(w.z), bfhi(w.z), bflo(w.w), bfhi(w.w)} * rstd * gr[128 * j + 1]; }
    }
}


#ifndef DEBUG_SCAN
#define DEBUG_SCAN 0
#endif
__device__ __forceinline__ void scan_bf16(const bf16* p, size_t n, int* flags, int code, int G) {
    int tid = threadIdx.x; asm volatile("" : "+v"(tid));
    const u32x4* q = (const u32x4*)p; const size_t n16 = n / 8; bool bad = false, huge = false;
    for (size_t i = (size_t)blockIdx.x * NTHREADS + tid; i < n16; i += (size_t)G * NTHREADS) { const u32x4 w = q[i];
#pragma unroll
        for (int e = 0; e < 4; ++e) { const unsigned x = w[e]; if ((x & 0x7f80u) == 0x7f80u || (x & 0x7f800000u) == 0x7f800000u) bad = true; if (fabsf(bflo(x)) > 1e4f || fabsf(bfhi(x)) > 1e4f) huge = true; } }
    if (bad) flags[code] = 1; if (huge) flags[64 + code] = 1;
}
__device__ __forceinline__ void scan_f32(const float* p, size_t n, int* flags, int code, int G) {
    int tid = threadIdx.x; asm volatile("" : "+v"(tid));
    bool bad = false, huge = false;
    for (size_t i = (size_t)blockIdx.x * NTHREADS + tid; i < n; i += (size_t)G * NTHREADS) { const unsigned x = __float_as_uint(p[i]); if ((x & 0x7f800000u) == 0x7f800000u) bad = true; if (fabsf(p[i]) > 1e4f) huge = true; }
    if (bad) flags[code] = 1; if (huge) flags[64 + code] = 1;
}
#define XB_TMO      128
#define XB_XCNT(j)  (256  + 64 * (j))
#define XB_XSUB(j)  (1280 + 64 * (j))
#define XB_XGEN(j)  (2304 + 64 * (j))
#define XB_TOP      3328
#define XB_TOPGEN   3392
#define XCD_BAR_WORDS 3456
#define XB_SPIN_CAP (1u << 18)

__device__ __forceinline__ unsigned xb_ld(unsigned* p)              { return __hip_atomic_load(p, __ATOMIC_RELAXED, __HIP_MEMORY_SCOPE_AGENT); }
__device__ __forceinline__ unsigned xb_add(unsigned* p, unsigned v) { return __hip_atomic_fetch_add(p, v, __ATOMIC_RELAXED, __HIP_MEMORY_SCOPE_AGENT); }
__device__ __forceinline__ unsigned xb_xcc_id() { return (unsigned)__builtin_amdgcn_s_getreg((3 << 11) | 20) & 0xFu; }
#define XB_SPIN(cond, bar) do { unsigned _sp = 0; while (cond) { __builtin_amdgcn_s_sleep(1); \
    if ((++_sp & 255u) == 0u) { if (xb_ld(&(bar)[XB_TMO])) break; if (_sp > XB_SPIN_CAP) { atomicAdd(&(bar)[XB_TMO], 1u); break; } } } } while (0)

struct XcdBarrier {
    unsigned* bar; unsigned x;
    volatile LAS unsigned* st;
};

__device__ __forceinline__ XcdBarrier xcd_barrier_post(unsigned* bar, volatile LAS unsigned* st) {
    XcdBarrier b; b.bar = bar; b.x = xb_xcc_id(); b.st = st;
    if (threadIdx.x == 0) (void)xb_add(&bar[XB_XCNT(b.x)], 1u);
    return b;
}
__device__ __forceinline__ void xcd_barrier_complete(unsigned* bar, unsigned x, unsigned& nloc, unsigned& nx) {
    const unsigned G = gridDim.x * gridDim.y * gridDim.z;
    unsigned sum, cnt, mine, sp = 0u;
    for (;;) {
        sum = 0u; cnt = 0u; mine = 0u;
#pragma unroll
        for (unsigned j = 0; j < 16; ++j) { const unsigned c = xb_ld(&bar[XB_XCNT(j)]); sum += c; cnt += (c > 0u) ? 1u : 0u; mine = (j == x) ? c : mine; }
        if (sum == G) break;
        __builtin_amdgcn_s_sleep(1);
        if ((++sp & 255u) == 0u) { if (xb_ld(&bar[XB_TMO])) break; if (sp > XB_SPIN_CAP) { atomicAdd(&bar[XB_TMO], 1u); break; } }
    }
    nloc = mine > 0u ? mine : 1u; nx = cnt > 0u ? cnt : 1u;
}

__device__ __forceinline__ void xcd_barrier(const XcdBarrier& b) {
    asm volatile("s_waitcnt vmcnt(0)" ::: "memory");
    __syncthreads();
    if (threadIdx.x == 0) {
        unsigned* bar = b.bar;
        __builtin_amdgcn_s_waitcnt(0);
        unsigned nloc = b.st[0], nx = b.st[1];
        if (nloc == 0u) { xcd_barrier_complete(bar, b.x, nloc, nx); b.st[0] = nloc; b.st[1] = nx; }
        const unsigned old = xb_add(&bar[XB_XSUB(b.x)], 1u);
        const unsigned gen = old / nloc;
        if (old + 1u == (gen + 1u) * nloc) {
            __builtin_amdgcn_fence(__ATOMIC_RELEASE, "agent");
            asm volatile("s_waitcnt vmcnt(0)" ::: "memory");
            const unsigned og = xb_add(&bar[XB_TOP], 1u);
            const unsigned tg = og / nx;
            if (og + 1u == (tg + 1u) * nx) xb_add(&bar[XB_TOPGEN], 1u);
            else XB_SPIN(xb_ld(&bar[XB_TOPGEN]) == tg, bar);
            __builtin_amdgcn_fence(__ATOMIC_ACQUIRE, "agent");
            xb_add(&bar[XB_XGEN(b.x)], 1u);
            asm volatile("s_waitcnt vmcnt(0)" ::: "memory");
        } else {
            XB_SPIN(xb_ld(&bar[XB_XGEN(b.x)]) == gen, bar);
            __builtin_amdgcn_fence(__ATOMIC_ACQUIRE, "agent");
            asm volatile("s_waitcnt vmcnt(0)" ::: "memory");
        }
    }
    __syncthreads();
}

#ifndef ONE_LAUNCH
#define ONE_LAUNCH 1
#endif
constexpr int PH_PER_LAYER = 9, N_PHASES = 1 + DEPTH * PH_PER_LAYER + 1;

__global__ void __launch_bounds__(NTHREADS, 2) trunk_fwd(Args args) {
    extern __shared__ __attribute__((aligned(16))) unsigned char lds_raw[];
    LAS unsigned char* lds = (LAS unsigned char*)lds_raw;
    cg::grid_group grid = cg::this_grid();
    const int G = gridDim.x;
    unsigned char* ws = args.ws;
    float* out = args.out;
    const int lo = args.ph_lo, hi = args.ph_hi;
    float* ssq = (float*)(ws + WS_SSQ); float* dec = (float*)(ws + WS_DEC); bf16* hbnd = (bf16*)(ws + WS_HBND); bf16* xb = (bf16*)(ws + WS_XB);
    bf16 *ub = (bf16*)(ws + WS_U), *hgb = (bf16*)(ws + WS_HG), *qb = (bf16*)(ws + WS_Q), *vb = (bf16*)(ws + WS_V), *sob = (bf16*)(ws + WS_SO), *pooled = (bf16*)(ws + WS_POOL);
    bf16 *UT = (bf16*)(ws + WS_UT), *gates = (bf16*)(ws + WS_GATES), *merged = (bf16*)(ws + WS_MERGED), *act = (bf16*)(ws + WS_ACT);
    bf16* gl = (bf16*)(ws + WS_G);
#ifndef PHASE_MASK
#define PHASE_MASK 0xfff
#endif
#define EN(j) (((PHASE_MASK) >> (j)) & 1)
#define IN(k) (lo <= (k) && (k) < hi)
#define SC(k) (DEBUG_SCAN && lo == (k) && hi == (k) - 1)
    volatile LAS unsigned* MISC = (volatile LAS unsigned*)(lds + 131072 + 512);
    { int t_ = threadIdx.x; asm volatile("" : "+v"(t_)); if (t_ < 32) MISC[t_] = 0u; }
    __syncthreads();
    XcdBarrier bar = xcd_barrier_post((unsigned*)(ws + WS_BAR), MISC + 8);
#ifndef PROBE_A
#define PROBE_A -1
#define PROBE_B -1
#endif
    unsigned long long* tsb = (unsigned long long*)(ws + 4096);
#define STAMP(k) do { if (PROBE_A >= 0 && blockIdx.x == 0) { int t_ = threadIdx.x; asm volatile("" : "+v"(t_)); if (t_ == 0) tsb[(k)] = __builtin_amdgcn_s_memrealtime(); } } while (0)
#define SEAM(k) do { if (IN(k) && IN((k) + 1)) { if (hi > 1000000) grid.sync();   xcd_barrier(bar); } STAMP((k) + 1); } while (0)
    STAMP(0);

    int* dbg = (int*)ws;
    static_assert(DEPTH == 2, "the lazy weight-copy schedule below is written for two layers");
    const bool lazy = (G == 256) && lo == 0 && hi == N_PHASES;
    if (EN(9) && IN(0)) { if (DEBUG_SCAN && blockIdx.x == 0) { int t_ = threadIdx.x; asm volatile("" : "+v"(t_)); if (t_ < 128) dbg[t_] = 0; } phase_prologue(args, lds, G, lazy); }
    SEAM(0);
    for (int l = 0; l < DEPTH; ++l) {
        const int pb = 1 + l * PH_PER_LAYER;
        unsigned char* wl = ws + WS_W + (size_t)l * W_LAYER;
        const bf16* Win = (const bf16*)(wl + WO_IN);
        if (EN(0) && IN(pb + 0)) {
            pg8::Gemm g{xb, Win, M, NMIX, D}; pg8::StaticOrder S; S.init(M, NMIX, G, (int)blockIdx.x);
            EpiInMix E{ub, qb, vb, sob, gl, ssq, (const float*)(ws + WS_LB) + l * HW, gates, args.in[3] + l * NGATE, 0};
            pg8::gemm_phase<EpiInMix, pg8::StaticOrder, true, true>(lds, g, S, E);
            if (lazy && l == 0 && blockIdx.x >= 128) {
                convert_items(args, lds, I_IN, I_LAYER, (int)blockIdx.x - 128, 128);
                fold_pool(args, lds, 0, 1, (int)blockIdx.x - 128, 128);
            }
            if (lazy && l == 1 && blockIdx.x >= 128)
                convert_items(args, lds, I_LAYER + I_IN + I_PB + I_O, 2 * I_LAYER, (int)blockIdx.x - 128, 128);
        }
        SEAM(pb + 0);
        if (SC(pb + 1)) { const int cb_ = 20 * l; scan_bf16(ub, (size_t)M * 512, dbg, cb_ + 1, G); scan_bf16(qb, (size_t)M * 512, dbg, cb_ + 2, G); scan_bf16(vb, (size_t)M * 512, dbg, cb_ + 3, G); scan_bf16(sob, (size_t)M * 512, dbg, cb_ + 4, G); scan_bf16(gl, (size_t)M * 512, dbg, cb_ + 5, G); }
        if (EN(1) && IN(pb + 1)) { phase_fir(ub, pooled, G); phase_h1(lds, gl, vb, UT, dec, G); }
        SEAM(pb + 1);
        if (SC(pb + 2)) { const int cb_ = 20 * l; scan_bf16(pooled, (size_t)M * 512, dbg, cb_ + 6, G); scan_bf16(UT, (size_t)NUNIT * 16384, dbg, cb_ + 7, G); scan_f32(dec, (size_t)NUNIT * 128, dbg, cb_ + 8, G); }
        if (EN(2) && IN(pb + 2)) phase_h2(UT, dec, G);
        SEAM(pb + 2);
        if (SC(pb + 3)) { scan_bf16(UT, (size_t)NUNIT * 16384, dbg, 20 * l + 9, G); }
        if (EN(3) && IN(pb + 3)) phase_h3(lds, qb, gl, vb, sob, UT, args.in[7] + l * HD, hgb, G);
        SEAM(pb + 3);
        if (SC(pb + 4)) { scan_bf16(gates, (size_t)M * 2048, dbg, 20 * l + 11, G); }
        if (EN(4) && IN(pb + 4)) {
            pg8::Gemm g{xb, Win + (size_t)NMIX * D, M, NGATE, D}; GateOrder S; S.S.init(M, D, G, (int)blockIdx.x);
            EpiInMix E{ub, qb, vb, sob, gl, ssq, (const float*)(ws + WS_LB) + l * HW, gates, args.in[3] + l * NGATE, 10};
            pg8::gemm_phase<EpiInMix, GateOrder, true, true>(lds, g, S, E);
            VM_WAIT(); __syncthreads();
        }
        if (IN(pb + 4) != IN(pb + 5)) SEAM(pb + 4); else STAMP(pb + 5);
        if (EN(5) && IN(pb + 5)) {
            { pg8::Gemm g{pooled, (const bf16*)(wl + WO_A), M, D, PW}; pg8::StaticOrder S; S.init(M, D, G, (int)blockIdx.x);
              EpiMerge<false> E{merged, gates};
              pg8::gemm_phase<EpiMerge<false>, pg8::StaticOrder, true, true>(lds, g, S, E); }
            VM_WAIT(); __syncthreads();
            { pg8::Gemm g{hgb, (const bf16*)(wl + WO_PB), M, D, HW}; pg8::StaticOrder S; S.init(M, D, G, (int)blockIdx.x);
              EpiMerge<true> E{merged, gates};
              pg8::gemm_phase<EpiMerge<true>, pg8::StaticOrder, true, true>(lds, g, S, E); }
        }
        SEAM(pb + 5);
        if (SC(pb + 6)) { scan_bf16(merged, (size_t)M * 1024, dbg, 20 * l + 12, G); }
        if (EN(6) && IN(pb + 6)) {
            pg8::Gemm g{merged, (const bf16*)(wl + WO_O), M, D, D}; pg8::StaticOrder S; S.init(M, D, G, (int)blockIdx.x);
            EpiRes<false> E{out, xb, ssq};
            pg8::gemm_phase<EpiRes<false>, pg8::StaticOrder, true, true>(lds, g, S, E);
        }
        SEAM(pb + 6);
        if (SC(pb + 7)) { scan_f32(out, (size_t)M * 1024, dbg, 20 * l + 13, G); scan_bf16(xb, (size_t)M * 1024, dbg, 20 * l + 14, G); scan_f32(ssq, (size_t)M * 16, dbg, 20 * l + 15, G); }
        if (EN(7) && IN(pb + 7)) {
            pg8::Gemm g{xb, (const bf16*)(wl + WO_UP), M, NUP, D}; pg8::StaticOrder S; S.init(M, NUP, G, (int)blockIdx.x);
            EpiUpConv E{act, hbnd, ssq, args.in[13] + (size_t)l * 3 * NUP, args.in[14] + (size_t)l * NUP};
            pg8::gemm_phase<EpiUpConv, pg8::StaticOrder, true, true, true>(lds, g, S, E);
            if (lazy && l == 0 && blockIdx.x >= 128) {
                convert_items(args, lds, I_LAYER, I_LAYER + I_IN + I_PB + I_O, (int)blockIdx.x - 128, 128);
                fold_pool(args, lds, 1, 2, (int)blockIdx.x - 128, 128);
            }
        }
        SEAM(pb + 7);
        if (SC(pb + 8)) { scan_bf16(act, (size_t)M * DFF, dbg, 20 * l + 16, G); scan_bf16(hbnd, (size_t)128 * 4 * 2 * DFF, dbg, 20 * l + 17, G); }
        if (EN(8) && IN(pb + 8)) {
            pg8::StaticOrder S; S.init(M, D, G, (int)blockIdx.x);
            pg8::Unit un;
            for (int i = 0; S.next(i, un); ++i) ffn_fixup(un.pm, hbnd, args.in[13] + (size_t)l * 3 * NUP, args.in[14] + (size_t)l * NUP, act);
            VM_WAIT(); __syncthreads();
            pg8::Gemm g{act, (const bf16*)(wl + WO_DN), M, D, DFF};
            EpiRes<false> E{out, xb, ssq}; pg8::gemm_phase<EpiRes<false>, pg8::StaticOrder, true, true>(lds, g, S, E);
        }
        SEAM(pb + 8);
    }
    if (SC(N_PHASES - 1)) {
        scan_f32(out, (size_t)M * 1024, dbg, 58, G); scan_f32(ssq, (size_t)M * 16, dbg, 59, G);
        __syncthreads();
    }
    if (EN(10) && IN(N_PHASES - 1)) phase_final(xb, out, ssq, args.in[16], G);
    if (DEBUG_SCAN && IN(N_PHASES)) {
        int t_ = threadIdx.x; asm volatile("" : "+v"(t_));
        int c1 = -1, c2 = -1; for (int i = 63; i >= 0; --i) { if (dbg[i]) c1 = i; if (dbg[64 + i]) c2 = i; }
        const float cval = 100.f * (float)(c2 + 2);
        for (size_t i = (size_t)blockIdx.x * NTHREADS + t_; i < (size_t)M * D; i += (size_t)G * NTHREADS) out[i] = (i == 0) ? 1e4f * (float)(c1 + 1) : cval;
    }
    if (PROBE_A >= 0 && blockIdx.x == 0) {
        int t_ = threadIdx.x; asm volatile("" : "+v"(t_));
        if (t_ == 0) {
            STAMP(N_PHASES);
            __builtin_amdgcn_fence(__ATOMIC_ACQ_REL, "agent");
            const unsigned long long da = tsb[PROBE_A + 1] - tsb[PROBE_A], db = PROBE_B >= 0 ? tsb[PROBE_B + 1] - tsb[PROBE_B] : 0ull;
            const unsigned long long spin = 4ull * da + 204800ull * (db / 3200ull);
            const unsigned long long t0 = __builtin_amdgcn_s_memrealtime();
            while (__builtin_amdgcn_s_memrealtime() - t0 < spin) __builtin_amdgcn_s_sleep(32);
        }
    }
#undef IN
#undef SEAM
}

extern "C" void kernel_launch(void* const* d_in, const int* in_sizes, int n_in, void* d_out, int out_size, void* d_ws, size_t ws_size, hipStream_t stream) {
    static int grid = 0;
    if (grid == 0) {
        if (n_in != 17 || in_sizes[0] != M * D || out_size != M * D || ws_size < WS_END) { fprintf(stderr, "kernel_launch: unexpected shapes (n_in %d, in0 %d, out %d, ws %zu)\n", n_in, n_in > 0 ? in_sizes[0] : -1, out_size, ws_size); grid = -1; return; }
        int dev = 0, cus = 0, per_cu = 0;
        hipGetDevice(&dev); hipDeviceGetAttribute(&cus, hipDeviceAttributeMultiprocessorCount, dev);
        if (hipFuncSetAttribute((const void*)trunk_fwd, hipFuncAttributeMaxDynamicSharedMemorySize, LDS_BYTES) != hipSuccess) { fprintf(stderr, "kernel_launch: hipFuncSetAttribute failed\n"); grid = -1; return; }
        if (hipOccupancyMaxActiveBlocksPerMultiprocessor(&per_cu, (const void*)trunk_fwd, NTHREADS, LDS_BYTES) != hipSuccess || per_cu < 1) { fprintf(stderr, "kernel_launch: occupancy query says %d\n", per_cu); per_cu = 1; }
        (void)hipGetLastError();
        grid = cus * 1;
        fprintf(stderr, "kernel_launch: grid %d (cus %d, per_cu %d)\n", grid, cus, per_cu);
    }
    if (grid < 0) return;
    Args a{};
    for (int i = 0; i < 17; ++i) a.in[i] = (const float*)d_in[i];
    a.out = (float*)d_out; a.ws = (unsigned char*)d_ws;
#if ONE_LAUNCH
    if (hipMemsetAsync((char*)d_ws + WS_BAR, 0, BAR_BYTES, stream) != hipSuccess) { fprintf(stderr, "kernel_launch: memset failed\n"); return; }
    a.ph_lo = 0; a.ph_hi = N_PHASES;
    void* kargs[] = {&a};
    hipError_t e = hipLaunchCooperativeKernel((const void*)trunk_fwd, dim3(grid), dim3(NTHREADS), kargs, LDS_BYTES, stream);
    if (e != hipSuccess) fprintf(stderr, "kernel_launch: cooperative launch failed: %s (grid %d)\n", hipGetErrorString(e), grid);
#else
    for (int p = 0; p < N_PHASES + (DEBUG_SCAN ? 1 : 0); ++p) {
        if (DEBUG_SCAN && p > 0 && p < N_PHASES) { a.ph_lo = p; a.ph_hi = p - 1; hipLaunchKernelGGL(trunk_fwd, dim3(grid), dim3(NTHREADS), LDS_BYTES, stream, a); }
        a.ph_lo = p; a.ph_hi = p + 1;
        hipLaunchKernelGGL(trunk_fwd, dim3(grid), dim3(NTHREADS), LDS_BYTES, stream, a);
    }
#endif
}
```
